# Optimizing an MI355X kernel written in HIP

```python
import math
import jax, jax.numpy as jnp
from jax import lax
import numpy as np

D_MODEL = 1024
BATCH = 2
SEQ = 8192
DEPTH = 1

N_HEADS = 8
HEAD_DIM = 64
V_DIM = 2 * HEAD_DIM
QK_WIDTH = N_HEADS * 2 * HEAD_DIM
ATTN_WIDTH = N_HEADS * V_DIM
Q_BLOCK = 128
SUBLN_EPS = 1e-5
LRU_WIDTH = D_MODEL
LRU_BLOCKS = 16
LRU_BLOCK_W = LRU_WIDTH // LRU_BLOCKS
CONV_WIDTH = 4
LRU_C = 8.0
N_GROUPS = 4
EXPERTS_PER_GROUP = 8
N_EXPERTS = N_GROUPS * EXPERTS_PER_GROUP
TOP_K_INNER = 2
EXPERT_FF = 512
ROUTER_BIAS_SCALE = 0.01
PLE_DIM = 256
NORM_EPS = 1e-6

IN_SIZES = (QK_WIDTH, QK_WIDTH, ATTN_WIDTH, LRU_WIDTH, LRU_WIDTH, D_MODEL, D_MODEL)
IN_COLS = sum(IN_SIZES)
IN_SPLITS = tuple(int(s) for s in np.cumsum(IN_SIZES)[:-1])

kernel_name = "hybrid_diffattn_rglru_hiermoe_ple"


def rmsnorm(x, g, eps=NORM_EPS):
    xf = x.astype(jnp.float32)
    y = xf * lax.rsqrt(jnp.mean(xf * xf, axis=-1, keepdims=True) + eps)
    return (y * g.astype(jnp.float32)).astype(x.dtype)


def diff_attention(q, k, v, lam):
    B, S = q.shape[0], q.shape[1]
    n_blk = S // Q_BLOCK
    scale = HEAD_DIM ** -0.5
    qb = jnp.moveaxis(q.reshape(B, n_blk, Q_BLOCK, N_HEADS, 2, HEAD_DIM), 1, 0)
    kf = k.astype(jnp.float32)
    vf = v.astype(jnp.float32)
    kpos = jnp.arange(S)
    neg = jnp.finfo(jnp.float32).min

    def one_block(args):
        qi, blk = args
        s = jnp.einsum('bqhcd,bkhcd->bhcqk', qi.astype(jnp.float32), kf) * scale
        qpos = blk * Q_BLOCK + jnp.arange(Q_BLOCK)
        causal = kpos[None, :] <= qpos[:, None]
        s = jnp.where(causal, s, neg)
        pr = jax.nn.softmax(s, axis=-1)
        a = pr[:, :, 0] - lam * pr[:, :, 1]
        return jnp.einsum('bhqk,bkhe->bqhe', a, vf)

    o = lax.map(one_block, (qb, jnp.arange(n_blk)))
    return jnp.moveaxis(o, 0, 1).reshape(B, S, N_HEADS, V_DIM).astype(q.dtype)


def causal_depthwise_conv(x, w, b):
    S = x.shape[1]
    xp = jnp.pad(x, ((0, 0), (CONV_WIDTH - 1, 0), (0, 0)))
    y = b
    for j in range(CONV_WIDTH):
        y = y + xp[:, j:j + S] * w[j]
    return y


def rg_lru(x, w_rg, b_rg, w_ig, b_ig, lru_lambda):
    B, S, W = x.shape
    xb = x.reshape(B, S, LRU_BLOCKS, LRU_BLOCK_W)
    r = jax.nn.sigmoid(jnp.einsum('bsnw,nwv->bsnv', xb, w_rg) + b_rg).reshape(B, S, W)
    ig = jax.nn.sigmoid(jnp.einsum('bsnw,nwv->bsnv', xb, w_ig) + b_ig).reshape(B, S, W)
    log_a = -LRU_C * r.astype(jnp.float32) * jax.nn.softplus(-lru_lambda.astype(jnp.float32))
    a = jnp.exp(log_a)
    mult = jnp.sqrt(-jnp.expm1(2.0 * log_a))
    u = mult * (ig * x).astype(jnp.float32)

    def combine(left, right):
        a_l, b_l = left
        a_r, b_r = right
        return a_l * a_r, a_r * b_l + b_r

    _, h = lax.associative_scan(combine, (a, u), axis=1)
    return h.astype(x.dtype)


def hier_moe(h, w_rt_group, b_rt_group, w_rt_expert, b_rt_expert, w_e_gate, w_e_up, w_e_down):
    B, S, D = h.shape
    t = h.reshape(B * S, D)
    grp_logits = (t @ w_rt_group + b_rt_group).astype(jnp.float32)
    grp_prob = jax.nn.softmax(grp_logits, axis=-1)
    g_idx = jnp.argmax(grp_logits, axis=-1)
    g_w = jnp.take_along_axis(grp_prob, g_idx[:, None], axis=1)[:, 0]
    fine = (jnp.einsum('nd,gde->nge', t, w_rt_expert) + b_rt_expert).astype(jnp.float32)
    fine_sel = jnp.take_along_axis(fine, g_idx[:, None, None], axis=1)[:, 0]
    top_logit, top_idx = lax.top_k(fine_sel, TOP_K_INNER)
    top_w = jax.nn.softmax(top_logit, axis=-1)
    expert_id = g_idx[:, None] * EXPERTS_PER_GROUP + top_idx
    weights = g_w[:, None] * top_w
    combine = jnp.sum(jax.nn.one_hot(expert_id, N_EXPERTS, dtype=jnp.float32)
                      * weights[..., None], axis=1)

    def expert_step(acc, params):
        wg, wu, wd, c = params
        hid = jax.nn.silu(t @ wg) * (t @ wu)
        return acc + c[:, None] * (hid @ wd).astype(jnp.float32), None

    acc0 = jnp.zeros((B * S, D), jnp.float32)
    y, _ = lax.scan(expert_step, acc0, (w_e_gate, w_e_up, w_e_down, combine.T))
    return y.reshape(B, S, D).astype(h.dtype)


def setup_inputs(seed: int = 0) -> dict:
    key = jax.random.key(seed)
    ks = jax.random.split(key, 32)
    f32 = jnp.float32
    L, D = DEPTH, D_MODEL

    def nrm(k, shape, fan_in):
        return jax.random.normal(k, shape, f32) * (fan_in ** -0.5)

    def gain(k, shape):
        return 1.0 + 0.05 * jax.random.normal(k, shape, f32)

    u = jax.random.uniform(ks[16], (L, LRU_WIDTH), f32, 0.9, 0.999)
    s = u ** (1.0 / LRU_C)
    lru_lambda = jnp.log(s) - jnp.log1p(-s)
    return {
        "x": jax.random.normal(ks[0], (BATCH, SEQ, D), f32),
        "p": jax.random.normal(ks[1], (L, BATCH, SEQ, PLE_DIM), f32),
        "g_mix": gain(ks[2], (L, D)),
        "w_in": nrm(ks[3], (L, D, IN_COLS), D),
        "lam_q1": 0.1 * jax.random.normal(ks[4], (L, HEAD_DIM), f32),
        "lam_k1": 0.1 * jax.random.normal(ks[5], (L, HEAD_DIM), f32),
        "lam_q2": 0.1 * jax.random.normal(ks[6], (L, HEAD_DIM), f32),
        "lam_k2": 0.1 * jax.random.normal(ks[7], (L, HEAD_DIM), f32),
        "g_subln": gain(ks[8], (L, V_DIM)),
        "w_conv": nrm(ks[9], (L, CONV_WIDTH, LRU_WIDTH), CONV_WIDTH),
        "b_conv": 0.02 * jax.random.normal(ks[10], (L, LRU_WIDTH), f32),
        "w_rg": nrm(ks[11], (L, LRU_BLOCKS, LRU_BLOCK_W, LRU_BLOCK_W), LRU_BLOCK_W),
        "b_rg": 0.02 * jax.random.normal(ks[12], (L, LRU_BLOCKS, LRU_BLOCK_W), f32),
        "w_ig": nrm(ks[13], (L, LRU_BLOCKS, LRU_BLOCK_W, LRU_BLOCK_W), LRU_BLOCK_W),
        "b_ig": 0.02 * jax.random.normal(ks[14], (L, LRU_BLOCKS, LRU_BLOCK_W), f32),
        "lru_lambda": lru_lambda,
        "w_attn_br": nrm(ks[17], (L, ATTN_WIDTH, D), ATTN_WIDTH),
        "w_lru_br": nrm(ks[18], (L, LRU_WIDTH, D), LRU_WIDTH),
        "w_out": nrm(ks[19], (L, D, D), D),
        "g_moe": gain(ks[20], (L, D)),
        "w_rt_group": nrm(ks[21], (L, D, N_GROUPS), D),
        "b_rt_group": ROUTER_BIAS_SCALE * jax.random.normal(ks[22], (L, N_GROUPS), f32),
        "w_rt_expert": nrm(ks[23], (L, N_GROUPS, D, EXPERTS_PER_GROUP), D),
        "b_rt_expert": ROUTER_BIAS_SCALE * jax.random.normal(ks[24], (L, N_GROUPS, EXPERTS_PER_GROUP), f32),
        "w_e_gate": nrm(ks[25], (L, N_EXPERTS, D, EXPERT_FF), D),
        "w_e_up": nrm(ks[26], (L, N_EXPERTS, D, EXPERT_FF), D),
        "w_e_down": nrm(ks[27], (L, N_EXPERTS, EXPERT_FF, D), EXPERT_FF),
        "g_ple": gain(ks[28], (L, D)),
        "w_ple_gate": nrm(ks[29], (L, D, D), D),
        "w_ple_proj": nrm(ks[30], (L, PLE_DIM, D), PLE_DIM),
        "g_final": gain(ks[31], (D,)),
    }


def reference(x, p, g_mix, w_in, lam_q1, lam_k1, lam_q2, lam_k2, g_subln, w_conv, b_conv,
              w_rg, b_rg, w_ig, b_ig, lru_lambda, w_attn_br, w_lru_br, w_out, g_moe,
              w_rt_group, b_rt_group, w_rt_expert, b_rt_expert, w_e_gate, w_e_up, w_e_down,
              g_ple, w_ple_gate, w_ple_proj, g_final):
    B, S = x.shape[0], x.shape[1]
    for i in range(DEPTH):
        lam_init = 0.8 - 0.6 * math.exp(-0.3 * i)
        h = rmsnorm(x, g_mix[i])
        z = h @ w_in[i]
        q, k, v, xr, gr, ga, gb = jnp.split(z, IN_SPLITS, axis=-1)
        q = q.reshape(B, S, N_HEADS, 2, HEAD_DIM)
        k = k.reshape(B, S, N_HEADS, 2, HEAD_DIM)
        v = v.reshape(B, S, N_HEADS, V_DIM)
        lam = (jnp.exp(jnp.sum(lam_q1[i].astype(jnp.float32) * lam_k1[i].astype(jnp.float32)))
               - jnp.exp(jnp.sum(lam_q2[i].astype(jnp.float32) * lam_k2[i].astype(jnp.float32)))
               + lam_init)
        o = diff_attention(q, k, v, lam)
        o = rmsnorm(o, g_subln[i], SUBLN_EPS) * (1.0 - lam_init)
        attn_branch = o.reshape(B, S, ATTN_WIDTH) @ w_attn_br[i]
        xc = causal_depthwise_conv(xr, w_conv[i], b_conv[i])
        hr = rg_lru(xc, w_rg[i], b_rg[i], w_ig[i], b_ig[i], lru_lambda[i])
        lru_branch = (hr * jax.nn.gelu(gr)) @ w_lru_br[i]
        mixed = jax.nn.sigmoid(ga) * attn_branch + jax.nn.sigmoid(gb) * lru_branch
        x = x + mixed @ w_out[i]
        x = x + hier_moe(rmsnorm(x, g_moe[i]), w_rt_group[i], b_rt_group[i], w_rt_expert[i],
                         b_rt_expert[i], w_e_gate[i], w_e_up[i], w_e_down[i])
        gate = jax.nn.sigmoid(rmsnorm(x, g_ple[i]) @ w_ple_gate[i])
        x = x + gate * (p[i] @ w_ple_proj[i])
    return rmsnorm(x, g_final)
```

```cpp
#include <hip/hip_runtime.h>
#include <hip/hip_bf16.h>
#include <cstdio>
#include <cstdint>
#include <cmath>

#define LAS __attribute__((address_space(3)))
#define GAS __attribute__((address_space(1)))
typedef unsigned short bf16;
typedef short bf16x8 __attribute__((ext_vector_type(8)));
typedef float f32x4 __attribute__((ext_vector_type(4)));
typedef float f32x2 __attribute__((ext_vector_type(2)));
typedef float f32x16 __attribute__((ext_vector_type(16)));
typedef unsigned u32x4 __attribute__((ext_vector_type(4)));
typedef unsigned u32x2 __attribute__((ext_vector_type(2)));
typedef int i32x4 __attribute__((ext_vector_type(4)));
typedef GAS unsigned gu32;

constexpr int M = 16384, D = 1024, SEQ = 8192, NBATCH = 2, NIN = 7168, PLE = 256, NEXP = 32, FF = 512, CAP = 16384;
constexpr float C2 = 0.125f * 1.4426950408889634f;
constexpr float LAM_INIT = 0.2f;

constexpr size_t MiB = 1u << 20;
constexpr size_t WS_CTL = 0, CTL_ZERO_BYTES = 64 * 1024;
constexpr size_t WS_RSTD0 = 1 * MiB, WS_RSTD2 = 1 * MiB + 65536, WS_TOKINFO = 1 * MiB + 131072;
constexpr size_t WS_WR = 2 * MiB, WS_WLRU = 2 * MiB + 262144;
constexpr size_t WS_LIST = 4 * MiB;
constexpr size_t WS_WIN = 8 * MiB, WS_WA = 22 * MiB, WS_WL = 24 * MiB, WS_WO = 26 * MiB, WS_WPG = 28 * MiB, WS_WPP = 30 * MiB;
constexpr size_t WS_U0 = 32 * MiB, USZ = 32 * MiB;
constexpr size_t WS_WGU = WS_U0 + 1 * USZ, WS_WD = WS_U0 + 3 * USZ;
constexpr size_t WS_Y = WS_U0 + 4 * USZ;
constexpr size_t WS_HID = 246 * MiB, WS_PROJ = 246 * MiB;
constexpr size_t WS_PB = 288 * MiB, WS_END = 296 * MiB;
constexpr int CW_TMO = 0, CW_CODE = 1, CW_BAR = 1024, CW_CNT = 8192;

constexpr int RING_OFF = 0, RING_BYTES = 131072, AUX_OFF = 131072, CTLL_OFF = 147456, LDS_BYTES = 149504;
constexpr int NWAVES = 8;

#define RLX_AGENT __ATOMIC_RELAXED, __HIP_MEMORY_SCOPE_AGENT
#define LDS_WAIT() asm volatile("s_waitcnt lgkmcnt(0)" ::: "memory")
#define VM_WAIT() asm volatile("s_waitcnt vmcnt(0)" ::: "memory")
__device__ __forceinline__ unsigned f2bf(float f) { unsigned u = __builtin_bit_cast(unsigned, f); return (u + 0x7fffu + ((u >> 16) & 1u)) >> 16; }
__device__ __forceinline__ unsigned pk2(float lo, float hi) { return f2bf(lo) | (f2bf(hi) << 16); }
__device__ __forceinline__ float bflo(unsigned w) { return __uint_as_float(w << 16); }
__device__ __forceinline__ float bfhi(unsigned w) { return __uint_as_float(w & 0xffff0000u); }
__device__ __forceinline__ float sigmoidf_(float v) { return __builtin_amdgcn_rcpf(1.0f + __builtin_amdgcn_exp2f(-1.4426950408889634f * v)); }
__device__ __forceinline__ float gelu_tanh(float v) { return v * __builtin_amdgcn_rcpf(1.0f + __builtin_amdgcn_exp2f(-2.3022082f * v * (1.0f + 0.044715f * v * v))); }
__device__ __forceinline__ float wave_sum(float v) {
#pragma unroll
    for (int o = 1; o < 64; o <<= 1) v += __shfl_xor(v, o);
    return v;
}
__device__ __forceinline__ int crow16(int r, int hi) { return (r & 3) + 8 * (r >> 2) + 4 * hi; }

namespace pg8 {
constexpr int BM = 256, BK = 64, HALF = 128, HTB = HALF * BK * 2, NXCD = 8, WGM = 8;
__host__ __device__ __forceinline__ int lds_byte(int r, int c) { const int st = (r >> 4) * 2 + (c >> 5), rr = r & 15, cc = c & 31, ob = rr * 64 + cc * 2; return st * 1024 + (ob ^ (((ob >> 9) & 1) << 5)); }
__host__ __device__ __forceinline__ void stage_rc(int b, int& R, int& C) { const int st = b / 1024, sb = b % 1024, swz = sb ^ (((sb >> 9) & 1) << 5); R = (st >> 1) * 16 + swz / 64; C = (st & 1) * 32 + (swz % 64) / 2; }
__host__ __device__ __forceinline__ int perm32(int rho) { const int n = rho >> 4, i = rho & 15; return 8 * (i >> 2) + 4 * n + (i & 3); }

struct Unit { int pm, pn, e, nv, r0; const char* a; const char* b; };

struct DenseOrder {
    const char* A; const char* Bt; int K, nM, nN, nwg, G, c;
    __device__ __forceinline__ void init(const void* A_, const void* Bt_, int M_, int N_, int K_, int G_, int c_) { A = (const char*)A_; Bt = (const char*)Bt_; K = K_; nM = M_ / BM; nN = N_ / BM; nwg = nM * nN; G = G_; c = c_; }
    __device__ __forceinline__ bool next(int i, Unit& u) const {
        const long L = (long)i * G + c; if (L >= nwg) return false;
        int wgid = (int)L; { const int q = nwg / NXCD, r = nwg % NXCD, xcd = wgid % NXCD, off = wgid / NXCD; wgid = (xcd < r ? xcd * (q + 1) : r * (q + 1) + (xcd - r) * q) + off; }
        const int nig = WGM * nN, gid = wgid / nig, fm = gid * WGM, gsz = (nM - fm) < WGM ? (nM - fm) : WGM;
        u.pm = fm + ((wgid % nig) % gsz); u.pn = (wgid % nig) / gsz; u.e = 0; u.nv = BM; u.r0 = 0;
        u.a = A + (size_t)u.pm * BM * K * 2; u.b = Bt + (size_t)u.pn * BM * K * 2; return true;
    }
    __device__ __forceinline__ void rows(const Unit&, const int (&R)[2], const int (&C)[2], unsigned (&ra)[2][2]) const {
#pragma unroll
        for (int h = 0; h < 2; ++h)
#pragma unroll
            for (int i = 0; i < 2; ++i) ra[h][i] = (unsigned)(((h * HALF + R[i]) * K + C[i]) * 2);
    }
};
template <bool GATHER> struct MoeOrder {
    const char* A; const char* Bt; size_t bstride; int K, G, c; const LAS int* tp; const LAS int* cnt; const int* list;
    __device__ __forceinline__ bool next(int i, Unit& u) const {
        const int L = i * G + c; const int T = __builtin_amdgcn_readfirstlane(tp[NEXP]) * 4; if (L >= T) return false;
        const int rt = L >> 2; int e = 0;
        while (e < NEXP - 1 && __builtin_amdgcn_readfirstlane(tp[e + 1]) <= rt) ++e;
        const int lt = rt - __builtin_amdgcn_readfirstlane(tp[e]); const int rem = __builtin_amdgcn_readfirstlane(cnt[e]) - lt * BM;
        u.pm = rt; u.pn = L & 3; u.e = e; u.nv = rem < BM ? rem : BM; u.r0 = lt * BM;
        u.a = GATHER ? A : A + (size_t)rt * BM * K * 2; u.b = Bt + (size_t)e * bstride + (size_t)u.pn * BM * K * 2; return true;
    }
    __device__ __forceinline__ void rows(const Unit& u, const int (&R)[2], const int (&C)[2], unsigned (&ra)[2][2]) const {
#pragma unroll
        for (int h = 0; h < 2; ++h)
#pragma unroll
            for (int i = 0; i < 2; ++i) {
                if (GATHER) { const int lr = h * HALF + R[i]; const int tok = list[(size_t)u.e * CAP + u.r0 + (lr < u.nv ? lr : 0)]; ra[h][i] = (unsigned)((tok * K + C[i]) * 2); }
                else ra[h][i] = (unsigned)(((h * HALF + R[i]) * K + C[i]) * 2);
            }
    }
};

template <int K, class Epi, class Sched, bool GATHER, bool ALIGN_EPI>
__device__ __forceinline__ void gemm_phase(LAS unsigned char* lds, const Sched& S, const Epi& E) {
    const int tid = threadIdx.x, wid = __builtin_amdgcn_readfirstlane(tid >> 6), lane = tid & 63, wr = wid >> 2, wc = wid & 3, fr = lane & 15, fq = lane >> 4;
    constexpr int nt = K / BK;
    int R[2], C[2]; unsigned voffB[2];
#pragma unroll
    for (int i = 0; i < 2; ++i) { stage_rc(tid * 16 + i * 8192, R[i], C[i]); const int Rb = Epi::PERM ? ((R[i] & ~31) + perm32(R[i] & 31)) : R[i]; voffB[i] = (unsigned)(Rb * K + C[i]) * 2u; }
    constexpr size_t kstep = (size_t)(BK * 2);
    constexpr size_t hstepB = (size_t)HALF * K * 2;
    const unsigned ldsw = (unsigned)wid * 1024u;
    const int aoff = lds_byte(wr * 64 + fr, fq * 8), boff = lds_byte(wc * 32 + fr, fq * 8);
#define PG8_SA(b, h) (((b) * 2 + (h)) * HTB)
#define PG8_SB(b, h) ((4 + (b) * 2 + (h)) * HTB)
#define PG8_STAGE_B(bufoff, gbase) do { _Pragma("unroll") for (int _i = 0; _i < 2; ++_i) \
        __builtin_amdgcn_global_load_lds((const unsigned*)((const char*)(gbase) + voffB[_i]), (LAS unsigned*)(lds + (bufoff) + ldsw + _i * 8192), 16, 0, 0); } while (0)
#define PG8_STAGE_A(bufoff, gbase, va, h) do { _Pragma("unroll") for (int _i = 0; _i < 2; ++_i) \
        __builtin_amdgcn_global_load_lds((const unsigned*)((const char*)(gbase) + (va)[h][_i]), (LAS unsigned*)(lds + (bufoff) + ldsw + _i * 8192), 16, 0, 0); } while (0)
#define PG8_LDA(dst, b, h) do { _Pragma("unroll") for (int m = 0; m < 4; ++m) _Pragma("unroll") for (int k = 0; k < 2; ++k) dst[m][k] = *(const LAS bf16x8*)(lds + PG8_SA(b, h) + aoff + m * 2048 + k * 1024); } while (0)
#define PG8_LDB(dst, b, h) do { _Pragma("unroll") for (int n = 0; n < 2; ++n) _Pragma("unroll") for (int k = 0; k < 2; ++k) dst[n][k] = *(const LAS bf16x8*)(lds + PG8_SB(b, h) + boff + n * 2048 + k * 1024); } while (0)
#define PG8_MMA(ai, bj, At, Bt) do { __builtin_amdgcn_s_setprio(1); _Pragma("unroll") for (int m = 0; m < 4; ++m) _Pragma("unroll") for (int n = 0; n < 2; ++n) _Pragma("unroll") for (int k = 0; k < 2; ++k) \
        acc[ai][bj][m][n] = __builtin_amdgcn_mfma_f32_16x16x32_bf16(Bt[n][k], At[m][k], acc[ai][bj][m][n], 0, 0, 0); __builtin_amdgcn_s_setprio(0); } while (0)
#define PG8_WAIT_V(n) asm volatile("s_waitcnt vmcnt(" #n ")" ::: "memory")
#define PG8_WAIT_L(n) asm volatile("s_waitcnt lgkmcnt(" #n ")" ::: "memory")
#define PG8_BAR __builtin_amdgcn_s_barrier()
#define PG8_SCHED __builtin_amdgcn_sched_barrier(0)
    Unit cur, nxt; int ui = 0;
    if (!S.next(0, cur)) return;
    unsigned vAc[2][2], vAn[2][2];
    S.rows(cur, R, C, vAc);
    f32x4 acc[2][2][4][2];
#pragma unroll
    for (int a = 0; a < 2; ++a)
#pragma unroll
        for (int b = 0; b < 2; ++b)
#pragma unroll
            for (int m = 0; m < 4; ++m)
#pragma unroll
                for (int n = 0; n < 2; ++n) acc[a][b][m][n] = (f32x4){0.f, 0.f, 0.f, 0.f};
    bf16x8 At[4][2], B0[2][2], B1[2][2];
    const char* cA = cur.a; const char* cB = cur.b;
    PG8_STAGE_B(PG8_SB(0, 0), cB); PG8_STAGE_B(PG8_SB(0, 1), cB + hstepB); PG8_STAGE_A(PG8_SA(0, 0), cA, vAc, 0); PG8_STAGE_A(PG8_SA(0, 1), cA, vAc, 1);
    if (wr == 1) PG8_BAR;
    PG8_WAIT_V(2); PG8_BAR;
    PG8_STAGE_B(PG8_SB(1, 0), cB + kstep); PG8_STAGE_A(PG8_SA(1, 0), cA + kstep, vAc, 0); PG8_STAGE_B(PG8_SB(1, 1), cB + hstepB + kstep);
    PG8_WAIT_V(6); PG8_BAR;
    for (;;) {
        const bool has_next = S.next(ui + 1, nxt);
        if (GATHER) { if (has_next) S.rows(nxt, R, C, vAn); else {
#pragma unroll
            for (int h = 0; h < 2; ++h)
#pragma unroll
                for (int i = 0; i < 2; ++i) vAn[h][i] = vAc[h][i]; } }
        const char* nA = has_next ? nxt.a : cA; const char* nB = has_next ? nxt.b : cB;
        for (int t = 0; t < nt; t += 2) {
            const bool last = (t == nt - 2);
            const char* a1 = cA + (size_t)(t + 1) * kstep;
            const char* a2 = last ? nA : cA + (size_t)(t + 2) * kstep; const char* b2 = last ? nB : cB + (size_t)(t + 2) * kstep;
            const char* a3 = a2 + kstep; const char* b3 = b2 + kstep;
            unsigned va2[2][2];
#pragma unroll
            for (int h = 0; h < 2; ++h)
#pragma unroll
                for (int i = 0; i < 2; ++i) va2[h][i] = (GATHER && last) ? vAn[h][i] : vAc[h][i];
            PG8_LDB(B0, 0, 0); PG8_LDB(B1, 0, 1); PG8_SCHED; PG8_LDA(At, 0, 0); PG8_STAGE_A(PG8_SA(1, 1), a1, vAc, 1);
            PG8_WAIT_V(8); PG8_WAIT_L(0); PG8_BAR; PG8_MMA(0, 0, At, B0); PG8_MMA(0, 1, At, B1); PG8_BAR; PG8_SCHED;
            PG8_LDA(At, 0, 1); PG8_STAGE_B(PG8_SB(0, 0), b2); PG8_STAGE_B(PG8_SB(0, 1), b2 + hstepB); PG8_STAGE_A(PG8_SA(0, 0), a2, va2, 0);
            PG8_WAIT_V(8); PG8_WAIT_L(0); PG8_BAR; PG8_MMA(1, 0, At, B0); PG8_MMA(1, 1, At, B1); PG8_BAR; PG8_SCHED;
            PG8_LDB(B0, 1, 0); PG8_LDB(B1, 1, 1); PG8_SCHED; PG8_LDA(At, 1, 0); PG8_STAGE_A(PG8_SA(0, 1), a2, va2, 1);
            PG8_WAIT_V(8); PG8_WAIT_L(0); PG8_BAR; PG8_MMA(0, 0, At, B0); PG8_MMA(0, 1, At, B1); PG8_BAR; PG8_SCHED;
            PG8_LDA(At, 1, 1); PG8_STAGE_B(PG8_SB(1, 0), b3); PG8_STAGE_B(PG8_SB(1, 1), b3 + hstepB); PG8_STAGE_A(PG8_SA(1, 0), a3, va2, 0);
            PG8_WAIT_V(8); PG8_WAIT_L(0); PG8_BAR; PG8_MMA(1, 0, At, B0); PG8_MMA(1, 1, At, B1); PG8_BAR; PG8_SCHED;
        }
        if constexpr (ALIGN_EPI) { if (wr == 0) PG8_BAR; }
        E(acc, cur, wr, wc, fr, fq);
        if (!has_next) break;
#pragma unroll
        for (int a = 0; a < 2; ++a)
#pragma unroll
            for (int b = 0; b < 2; ++b)
#pragma unroll
                for (int m = 0; m < 4; ++m)
#pragma unroll
                    for (int n = 0; n < 2; ++n) acc[a][b][m][n] = (f32x4){0.f, 0.f, 0.f, 0.f};
        cur = nxt; cA = nA; cB = nB; ++ui;
        if (GATHER) {
#pragma unroll
            for (int h = 0; h < 2; ++h)
#pragma unroll
                for (int i = 0; i < 2; ++i) vAc[h][i] = vAn[h][i]; }
        if constexpr (ALIGN_EPI) { if (wr == 1) PG8_BAR; }
    }
    PG8_WAIT_V(0);
    if constexpr (!ALIGN_EPI) { if (wr == 0) PG8_BAR; }
    PG8_BAR;
#undef PG8_SA
#undef PG8_SB
#undef PG8_STAGE_A
#undef PG8_STAGE_B
#undef PG8_LDA
#undef PG8_LDB
#undef PG8_MMA
#undef PG8_WAIT_V
#undef PG8_WAIT_L
#undef PG8_BAR
#undef PG8_SCHED
}

__device__ __forceinline__ unsigned cvt_pk_bf16(float lo, float hi) { unsigned r; asm volatile("v_cvt_pk_bf16_f32 %0, %1, %2" : "=v"(r) : "v"(lo), "v"(hi)); return r; }
__device__ __forceinline__ u32x4 pack8(const f32x4& v0, const f32x4& v1) { u32x4 w; w.x = cvt_pk_bf16(v0[0], v0[1]); w.y = cvt_pk_bf16(v0[2], v0[3]); w.z = cvt_pk_bf16(v1[0], v1[1]); w.w = cvt_pk_bf16(v1[2], v1[3]); return w; }
__device__ __forceinline__ void unpack8(const u32x4& w, f32x4& v0, f32x4& v1) { v0 = (f32x4){bflo(w.x), bfhi(w.x), bflo(w.y), bfhi(w.y)}; v1 = (f32x4){bflo(w.z), bfhi(w.z), bflo(w.w), bfhi(w.w)}; }
__device__ __forceinline__ u32x4 ld16_sc1(const void* p) { u32x4 v; asm volatile("global_load_dwordx4 %0, %1, off sc1\n\ts_waitcnt vmcnt(0)" : "=v"(v) : "v"(p) : "memory"); return v; }

struct EpiIn {
    static constexpr bool PERM = true;
    bf16* base; const float* rstd;
    __device__ __forceinline__ void operator()(const f32x4 (&acc)[2][2][4][2], const Unit& u, int wr, int wc, int fr, int fq) const {
        const int t = u.pn >> 2; bf16* O = base + (size_t)t * M * 1024;
        const int row0 = u.pm * BM + wr * 64 + fr, col0 = (u.pn & 3) * BM + wc * 32 + 8 * fq;
        float rs[2][4];
#pragma unroll
        for (int ai = 0; ai < 2; ++ai)
#pragma unroll
            for (int m = 0; m < 4; ++m) rs[ai][m] = rstd[row0 + ai * HALF + m * 16] * (t == 0 ? C2 : 1.0f);
#pragma unroll
        for (int ai = 0; ai < 2; ++ai)
#pragma unroll
            for (int m = 0; m < 4; ++m) { bf16* rowp = O + (size_t)(row0 + ai * HALF + m * 16) * 1024 + col0;
#pragma unroll
                for (int bj = 0; bj < 2; ++bj) { f32x4 v0 = acc[ai][bj][m][0] * rs[ai][m], v1 = acc[ai][bj][m][1] * rs[ai][m];
                    if (t == 4) {
#pragma unroll
                        for (int q = 0; q < 4; ++q) { v0[q] = gelu_tanh(v0[q]); v1[q] = gelu_tanh(v1[q]); } }
                    else if (t >= 5) {
#pragma unroll
                        for (int q = 0; q < 4; ++q) { v0[q] = sigmoidf_(v0[q]); v1[q] = sigmoidf_(v1[q]); } }
                    *(u32x4*)(rowp + bj * HALF) = pack8(v0, v1); } }
    }
};
struct EpiBf {
    static constexpr bool PERM = true;
    bf16* O; int ldc;
    __device__ __forceinline__ void operator()(const f32x4 (&acc)[2][2][4][2], const Unit& u, int wr, int wc, int fr, int fq) const {
        const int row0 = u.pm * BM + wr * 64 + fr, col0 = u.pn * BM + wc * 32 + 8 * fq;
#pragma unroll
        for (int ai = 0; ai < 2; ++ai)
#pragma unroll
            for (int m = 0; m < 4; ++m) { bf16* rowp = O + (size_t)(row0 + ai * HALF + m * 16) * ldc + col0;
#pragma unroll
                for (int bj = 0; bj < 2; ++bj) *(u32x4*)(rowp + bj * HALF) = pack8(acc[ai][bj][m][0], acc[ai][bj][m][1]); }
    }
};
template <bool FIRST> struct EpiMix {
    static constexpr bool PERM = true;
    bf16* mixed; const bf16* gate;
    __device__ __forceinline__ void operator()(const f32x4 (&acc)[2][2][4][2], const Unit& u, int wr, int wc, int fr, int fq) const {
        const int row0 = u.pm * BM + wr * 64 + fr, col0 = u.pn * BM + wc * 32 + 8 * fq;
#pragma unroll
        for (int ai = 0; ai < 2; ++ai)
#pragma unroll
            for (int m = 0; m < 4; ++m) { const size_t ro = (size_t)(row0 + ai * HALF + m * 16) * 1024 + col0;
#pragma unroll
                for (int bj = 0; bj < 2; ++bj) { const u32x4 gw = *(const u32x4*)(gate + ro + bj * HALF); f32x4 g0, g1; unpack8(gw, g0, g1);
                    f32x4 v0 = acc[ai][bj][m][0] * g0, v1 = acc[ai][bj][m][1] * g1;
                    if (!FIRST) { const u32x4 pw = ld16_sc1(mixed + ro + bj * HALF); f32x4 p0, p1; unpack8(pw, p0, p1); v0 += p0; v1 += p1; }
                    *(u32x4*)(mixed + ro + bj * HALF) = pack8(v0, v1); } }
    }
};
struct EpiOut {
    static constexpr bool PERM = true;
    const float* x; float* out; bf16* xb;
    __device__ __forceinline__ void operator()(const f32x4 (&acc)[2][2][4][2], const Unit& u, int wr, int wc, int fr, int fq) const {
        const int row0 = u.pm * BM + wr * 64 + fr, col0 = u.pn * BM + wc * 32 + 8 * fq;
#pragma unroll
        for (int ai = 0; ai < 2; ++ai)
#pragma unroll
            for (int m = 0; m < 4; ++m) { const size_t ro = (size_t)(row0 + ai * HALF + m * 16) * 1024 + col0;
#pragma unroll
                for (int bj = 0; bj < 2; ++bj) { const f32x4 x0 = *(const f32x4*)(x + ro + bj * HALF), x1 = *(const f32x4*)(x + ro + bj * HALF + 4);
                    const f32x4 v0 = acc[ai][bj][m][0] + x0, v1 = acc[ai][bj][m][1] + x1;
                    *(f32x4*)(out + ro + bj * HALF) = v0; *(f32x4*)(out + ro + bj * HALF + 4) = v1;
                    *(u32x4*)(xb + ro + bj * HALF) = pack8(v0, v1); } }
    }
};
struct EpiGU {
    static constexpr bool PERM = true;
    bf16* hid; const int* list; const i32x4* tokinfo;
    __device__ __forceinline__ void operator()(const f32x4 (&acc)[2][2][4][2], const Unit& u, int wr, int wc, int fr, int fq) const {
        const int lr0 = wr * 64 + fr, col0 = u.pn * HALF + wc * 32 + 8 * fq;
#pragma unroll
        for (int ai = 0; ai < 2; ++ai)
#pragma unroll
            for (int m = 0; m < 4; ++m) { const int lr = lr0 + ai * HALF + m * 16; const bool valid = lr < u.nv;
                const int tok = list[(size_t)u.e * CAP + u.r0 + (valid ? lr : 0)];
                const i32x4 t0 = tokinfo[tok * 2], t1 = tokinfo[tok * 2 + 1];
                const float cw = (t0.x == u.e) ? __int_as_float(t1.x) : __int_as_float(t1.y), rs = __int_as_float(t1.z);
                f32x4 h0, h1;
#pragma unroll
                for (int q = 0; q < 4; ++q) { const float g0 = acc[ai][0][m][0][q] * rs, u0 = acc[ai][1][m][0][q] * rs, g1 = acc[ai][0][m][1][q] * rs, u1 = acc[ai][1][m][1][q] * rs;
                    h0[q] = cw * g0 * sigmoidf_(g0) * u0; h1[q] = cw * g1 * sigmoidf_(g1) * u1; }
                if (valid) *(u32x4*)(hid + (size_t)(u.pm * BM + lr) * FF + col0) = pack8(h0, h1); }
    }
};
struct EpiPle {
    static constexpr bool PERM = true;
    float* out; const bf16* proj; const float* rstd;
    __device__ __forceinline__ void operator()(const f32x4 (&acc)[2][2][4][2], const Unit& u, int wr, int wc, int fr, int fq) const {
        const int row0 = u.pm * BM + wr * 64 + fr, col0 = u.pn * BM + wc * 32 + 8 * fq;
#pragma unroll
        for (int ai = 0; ai < 2; ++ai)
#pragma unroll
            for (int m = 0; m < 4; ++m) { const int row = row0 + ai * HALF + m * 16; const size_t ro = (size_t)row * 1024 + col0; const float rs = rstd[row];
#pragma unroll
                for (int bj = 0; bj < 2; ++bj) { const u32x4 pw = ld16_sc1(proj + ro + bj * HALF); f32x4 p0, p1; unpack8(pw, p0, p1);
                    const f32x4 x0 = *(const f32x4*)(out + ro + bj * HALF), x1 = *(const f32x4*)(out + ro + bj * HALF + 4);
                    f32x4 v0, v1;
#pragma unroll
                    for (int q = 0; q < 4; ++q) { v0[q] = x0[q] + sigmoidf_(acc[ai][bj][m][0][q] * rs) * p0[q]; v1[q] = x1[q] + sigmoidf_(acc[ai][bj][m][1][q] * rs) * p1[q]; }
                    *(f32x4*)(out + ro + bj * HALF) = v0; *(f32x4*)(out + ro + bj * HALF + 4) = v1; } }
    }
};
}

namespace attn_body {
using bf16=__hip_bfloat16;
using bf16x8=__attribute__((ext_vector_type(8)))short;
using s16x4=__attribute__((ext_vector_type(4)))short;
using f32x16=__attribute__((ext_vector_type(16)))float;
using u32x4=__attribute__((ext_vector_type(4)))unsigned;
constexpr int BATCH=2,NHEAD=16,SEQ=8192,D=64,DM=NHEAD*D;
constexpr int NW=8,QBLK=32,QB=QBLK*NW,KVBLK=64,NQB=SEQ/QB;
constexpr int ATTN_PITCH=DM, ATTN_UNIT_ROWS=QB;
__device__ __forceinline__ int crow(int r,int hi){return (r&3)+8*(r>>2)+4*hi;}
#define SBAR() __builtin_amdgcn_sched_barrier(0)
__device__ __forceinline__ void cmask(f32x16&p0,f32x16&p1,int jb,int qrel,int hi){
  const float NEG=-INFINITY; int kb=64*jb+4*hi;
  #pragma unroll
  for(int r=0;r<16;++r){int kv=kb+(r&3)+8*(r>>2); if(kv>qrel)p0[r]=NEG; if(kv+32>qrel)p1[r]=NEG;}
}

constexpr int NSLOT=3, SLOTB=8192;
constexpr int LDS_K=0, LDS_V=NSLOT*SLOTB, LDS_WS=2*NSLOT*SLOTB, LDS_OST=LDS_WS+NW*64*4, LDS_BYTES=LDS_OST+NW*4096;
constexpr float C2=0.125f*1.4426950408889634f;
__device__ __forceinline__ void glds16(const void*gsrc,unsigned lds_dst){unsigned keep;
  asm volatile("s_mov_b32 %0, m0\n\ts_mov_b32 m0, %2\n\ts_nop 0\n\tglobal_load_lds_dwordx4 %1, off\n\ts_mov_b32 m0, %0":"=&s"(keep):"v"(gsrc),"s"(lds_dst):"memory");}
__device__ __forceinline__ float max3f(float a,float b,float c){float r;asm("v_max3_f32 %0, %1, %2, %3":"=v"(r):"v"(a),"v"(b),"v"(c));return r;}
__device__ __forceinline__ float max2f(float a,float b){float r;asm("v_max_f32_e32 %0, %1, %2":"=v"(r):"v"(a),"v"(b));return r;}
__device__ __forceinline__ float fadd_s(float a,float b){float r;asm("v_add_f32_e32 %0, %1, %2":"=v"(r):"v"(a),"v"(b));return r;}
__device__ __forceinline__ float fsub_s(float a,float b){float r;asm("v_sub_f32_e32 %0, %1, %2":"=v"(r):"v"(a),"v"(b));return r;}
typedef float f32x2_t __attribute__((ext_vector_type(2))); typedef __bf16 bf16x2_t __attribute__((ext_vector_type(2)));
__device__ __forceinline__ unsigned cvtpk_s(float lo,float hi){f32x2_t v={lo,hi};bf16x2_t b=__builtin_convertvector(v,bf16x2_t);return __builtin_bit_cast(unsigned,b);}
#define WAIT_BAR(N) asm volatile("s_waitcnt vmcnt(" #N ") lgkmcnt(0)\n\ts_barrier":::"memory")

__device__ __forceinline__ void qkt(f32x16&p0,f32x16&p1,const char*Kslot,const bf16x8*qr,const f32x16&negm,int r32,int hi){
  const char*kb=Kslot+hi*1024+r32*16;
  #pragma unroll
  for(int d0=0;d0<4;++d0){
    const bf16x8 b0=*reinterpret_cast<const bf16x8*>(kb+d0*2048);
    const bf16x8 b1=*reinterpret_cast<const bf16x8*>(kb+d0*2048+512);
    if(d0==0){p0=__builtin_amdgcn_mfma_f32_32x32x16_bf16(b0,qr[0],negm,0,0,0);p1=__builtin_amdgcn_mfma_f32_32x32x16_bf16(b1,qr[0],negm,0,0,0);}
    else{p0=__builtin_amdgcn_mfma_f32_32x32x16_bf16(b0,qr[d0],p0,0,0,0);p1=__builtin_amdgcn_mfma_f32_32x32x16_bf16(b1,qr[d0],p1,0,0,0);}}
}
typedef __attribute__((address_space(3))) const char* lds_cptr;
typedef short v4i16_t __attribute__((ext_vector_type(4)));
__device__ __forceinline__ void kload8(bf16x8*kf,lds_cptr kp){
  kf[0]=*(const __attribute__((address_space(3))) bf16x8*)(kp);      kf[1]=*(const __attribute__((address_space(3))) bf16x8*)(kp+512);
  kf[2]=*(const __attribute__((address_space(3))) bf16x8*)(kp+2048); kf[3]=*(const __attribute__((address_space(3))) bf16x8*)(kp+2560);
  kf[4]=*(const __attribute__((address_space(3))) bf16x8*)(kp+4096); kf[5]=*(const __attribute__((address_space(3))) bf16x8*)(kp+4608);
  kf[6]=*(const __attribute__((address_space(3))) bf16x8*)(kp+6144); kf[7]=*(const __attribute__((address_space(3))) bf16x8*)(kp+6656);
}
__device__ __forceinline__ void kload2(bf16x8*kf,lds_cptr kp,int j){ kf[2*j]=*(const __attribute__((address_space(3))) bf16x8*)(kp+j*2048); kf[2*j+1]=*(const __attribute__((address_space(3))) bf16x8*)(kp+j*2048+512); }
__device__ __forceinline__ s16x4 vtr(lds_cptr p){ return __builtin_bit_cast(s16x4,__builtin_amdgcn_ds_read_tr16_b64_v4i16((__attribute__((address_space(3))) v4i16_t*)p)); }
__device__ __forceinline__ float rowmax(const f32x16&p0,const f32x16&p1){
  float a=max3f(p0[0],p0[1],p1[0]),b=max3f(p0[2],p0[3],p1[1]);a=max3f(a,p1[2],p1[3]);
  #pragma unroll
  for(int r=4;r<16;r+=4){a=max3f(a,p0[r],p0[r+1]);b=max3f(b,p0[r+2],p0[r+3]);a=max3f(a,p1[r],p1[r+1]);b=max3f(b,p1[r+2],p1[r+3]);}
  const float m=max2f(a,b);
  auto rr=__builtin_amdgcn_permlane32_swap(__float_as_uint(m),__float_as_uint(m),false,false);
  return max2f(__uint_as_float(rr[0]),__uint_as_float(rr[1]));
}
__device__ __forceinline__ void pv(f32x16*o,int vb,bf16x8 pa0,bf16x8 pa1,bf16x8 pa2,bf16x8 pa3){
  #pragma unroll
  for(int d0=0;d0<2;++d0){s16x4 lo[4],hi[4];
    #pragma unroll
    for(int ks=0;ks<4;++ks){
      asm volatile("ds_read_b64_tr_b16 %0,%1 offset:%c2":"=&v"(lo[ks]):"v"(vb),"i"(d0*4096+ks*1024):"memory");
      asm volatile("ds_read_b64_tr_b16 %0,%1 offset:%c2":"=&v"(hi[ks]):"v"(vb),"i"(d0*4096+ks*1024+512):"memory");}
    asm volatile("s_waitcnt lgkmcnt(0)":::"memory");SBAR();
    #define PK(k) (bf16x8){lo[k][0],lo[k][1],lo[k][2],lo[k][3],hi[k][0],hi[k][1],hi[k][2],hi[k][3]}
    o[d0]=__builtin_amdgcn_mfma_f32_32x32x16_bf16(pa0,PK(0),o[d0],0,0,0);
    o[d0]=__builtin_amdgcn_mfma_f32_32x32x16_bf16(pa1,PK(1),o[d0],0,0,0);
    o[d0]=__builtin_amdgcn_mfma_f32_32x32x16_bf16(pa2,PK(2),o[d0],0,0,0);
    o[d0]=__builtin_amdgcn_mfma_f32_32x32x16_bf16(pa3,PK(3),o[d0],0,0,0);
    #undef PK
  }
}

#ifndef ATTN_STORE16
#define ATTN_STORE16(p,v) (*(u32x4*)(p)=(v))
#endif
template<int THRL> __device__ __forceinline__ void attn_unit(int b,int h,int qb,const bf16*Q,const bf16*__restrict__ K,const bf16*__restrict__ V,bf16*O,char*shm){
  const int tid=threadIdx.x,lane=tid&63,r32=lane&31,hi=lane>>5; const int wid=__builtin_amdgcn_readfirstlane(tid>>6);
  const long rowbase=(long)b*SEQ; const int q0=qb*QB;
  const bf16*Qw=Q+(rowbase+q0+wid*QBLK)*DM+h*D;
  const bf16*Kh=K+rowbase*DM+h*D,*Vh=V+rowbase*DM+h*D;
  const unsigned lds0=(unsigned)(uintptr_t)shm;
  float*wsf=(float*)(shm+LDS_WS)+wid*64;
  const bf16*ksrc=Kh+(long)lane*DM+wid*8;
  const bf16*vsrc=Vh+(long)(16*(wid&3)+(lane>>2))*DM+(wid>>2)*32+(lane&3)*8;
  const unsigned kdst=lds0+LDS_K+wid*1024, vdst=lds0+LDS_V+wid*1024;
  #define DMA_K(t,slot) glds16(ksrc+(long)(t)*KVBLK*DM,(unsigned)__builtin_amdgcn_readfirstlane(kdst+(slot)))
  #define DMA_V(t,slot) glds16(vsrc+(long)(t)*KVBLK*DM,(unsigned)__builtin_amdgcn_readfirstlane(vdst+(slot)))
  const int vb0=(int)(lds0+LDS_V)+((lane>>4)&1)*32+(lane&3)*8+(4*hi+((lane&15)>>2))*64;
  const char*Kbase=shm+LDS_K; bf16x8 kf[8];
  const lds_cptr shm3=(lds_cptr)shm; const lds_cptr kp0=shm3+LDS_K+hi*1024+r32*16; const lds_cptr vp0=shm3+LDS_V+((lane>>4)&1)*32+(lane&3)*8+(4*hi+((lane&15)>>2))*64;
  const int NT=(q0+QB)/KVBLK;
  DMA_K(0,0);DMA_V(0,0);DMA_K(1,SLOTB);
  bf16x8 qr[4];
  #pragma unroll
  for(int d0=0;d0<4;++d0)qr[d0]=*reinterpret_cast<const bf16x8*>(&Qw[(long)r32*DM+d0*16+hi*8]);
  float mhat=0.f,l_reg=0.f;float zz_;asm volatile("v_mov_b32 %0, 0":"=v"(zz_));f32x16 o[2];
  _Pragma("unroll") for(int r=0;r<16;++r){o[0][r]=zz_;o[1][r]=zz_;}
  f32x16 negm;_Pragma("unroll") for(int r=0;r<16;++r)negm[r]=zz_;asm volatile("":"+v"(negm));
  const int qrel=wid*QBLK+r32;
  #define CMASK(P0,P1,t) do{int jb_=(t)-(NT-4); if(jb_>=0)cmask(P0,P1,jb_,qrel,hi);}while(0)
  bool resc=false;
  #define START(P0,P1) do{ const float rm=rowmax(P0,P1); resc=false; \
    { const float dl=rm; mhat=fadd_s(mhat,dl); \
      _Pragma("unroll") for(int r=0;r<16;++r){P0[r]=fsub_s(P0[r],dl);P1[r]=fsub_s(P1[r],dl);} \
      _Pragma("unroll") for(int r=0;r<16;++r)negm[r]=-mhat; asm volatile("":"+v"(negm)); } \
    _Pragma("unroll") for(int r=0;r<16;++r)P0[r]=__builtin_amdgcn_exp2f(P0[r]); }while(0)
  #define RESC() do{ if(resc){ asm volatile("s_waitcnt lgkmcnt(0)":::"memory"); \
      _Pragma("unroll") for(int d_=0;d_<2;++d_) _Pragma("unroll") for(int r=0;r<16;++r)o[d_][r]*=wsf[crow(r,hi)]; } }while(0)
  f32x16 pA0,pA1,pB0,pB1;
  int sl_prev=0,sl_cur=0,sl_next=SLOTB;
  #define ROT() do{sl_prev=sl_cur;sl_cur=sl_next;sl_next=(sl_next==(NSLOT-1)*SLOTB)?0:sl_next+SLOTB;}while(0)
  DMA_K(2,2*SLOTB);
  WAIT_BAR(3);
  qkt(pA0,pA1,Kbase,qr,negm,r32,hi);asm volatile("s_nop 15\n\ts_nop 7":"+v"(pA0),"+v"(pA1));CMASK(pA0,pA1,0);
  START(pA0,pA1);
  _Pragma("unroll") for(int r=0;r<16;++r)pA1[r]=__builtin_amdgcn_exp2f(pA1[r]);
  WAIT_BAR(0);
  DMA_K(3,0);DMA_V(1,SLOTB);
  ROT();
  kload8(kf,kp0+sl_cur);
  WAIT_BAR(2);
  s16x4 vlo[8],vhi[8]; u32x4 pw0,pw1,pw2,pw3;
  #define PKW(P,B) cvtpk_s(P[B],P[B+1])
  #define PAF(k) __builtin_bit_cast(bf16x8,pw##k)
  #define VFR(i) (bf16x8){vlo[i][0],vlo[i][1],vlo[i][2],vlo[i][3],vhi[i][0],vhi[i][1],vhi[i][2],vhi[i][3]}
  #define PIN(x) asm volatile("":"+v"(x))
  #define MX3(a,b,c) __builtin_fmaxf(__builtin_fmaxf((a),(b)),(c))
  #define GAPA(MF,A0,A1,A2,A3,W0,W1,PW) do{ MF; sacc+=A0; sacc+=A1; sacc+=A2; sacc+=A3; PIN(sacc); W0; W1; PIN(PW); SBAR(); }while(0)
  #define EX(v) __builtin_amdgcn_exp2f(v)
  #define GAPB(MF,X,B) do{ MF; X[B]=EX(X[B]); X[B+1]=EX(X[B+1]); X[B+2]=EX(X[B+2]); X[B+3]=EX(X[B+3]); PIN(X); SBAR(); }while(0)
  #define VRD(i) do{ vlo[i]=vtr(vp_+(((i)>>2)*4096+((i)&3)*1024)); vhi[i]=vtr(vp_+(((i)>>2)*4096+((i)&3)*1024+512)); }while(0)
  #define KRD(G,j) do{ if(G){ kload2(kf,kp0+sl_next,j); SBAR(); } }while(0)
  #define STEP(C0,C1,P0,P1,t,GK,GV,GL) do{ SBAR(); \
    const lds_cptr vp_=vp0+sl_prev; \
    VRD(0); SBAR(); float sacc=(P0[0]+P0[1]); \
    GAPA(C0=__builtin_amdgcn_mfma_f32_32x32x16_bf16(kf[0],qr[0],negm,0,0,0), P0[2],P0[3],P0[4],P0[5],     pw0[0]=PKW(P0,0), pw0[1]=PKW(P0,2), pw0); \
    VRD(4); SBAR(); GAPA(C1=__builtin_amdgcn_mfma_f32_32x32x16_bf16(kf[1],qr[0],negm,0,0,0), P0[6],P0[7],P0[8],P0[9],     pw0[2]=PKW(P0,4), pw0[3]=PKW(P0,6), pw0); \
    VRD(1); SBAR(); GAPA(C0=__builtin_amdgcn_mfma_f32_32x32x16_bf16(kf[2],qr[1],C0,0,0,0),   P0[10],P0[11],P0[12],P0[13], pw1[0]=PKW(P0,8), pw1[1]=PKW(P0,10), pw1); \
    VRD(5); SBAR(); GAPA(C1=__builtin_amdgcn_mfma_f32_32x32x16_bf16(kf[3],qr[1],C1,0,0,0),   P0[14],P0[15],P1[0],P1[1],   pw1[2]=PKW(P0,12),pw1[3]=PKW(P0,14), pw1); \
    VRD(2); SBAR(); GAPA(C0=__builtin_amdgcn_mfma_f32_32x32x16_bf16(kf[4],qr[2],C0,0,0,0),   P1[2],P1[3],P1[4],P1[5],     pw2[0]=PKW(P1,0), pw2[1]=PKW(P1,2), pw2); \
    VRD(6); SBAR(); GAPA(C1=__builtin_amdgcn_mfma_f32_32x32x16_bf16(kf[5],qr[2],C1,0,0,0),   P1[6],P1[7],P1[8],P1[9],     pw2[2]=PKW(P1,4), pw2[3]=PKW(P1,6), pw2); \
    VRD(3); SBAR(); GAPA(C0=__builtin_amdgcn_mfma_f32_32x32x16_bf16(kf[6],qr[3],C0,0,0,0),   P1[10],P1[11],P1[12],P1[13], pw3[0]=PKW(P1,8), pw3[1]=PKW(P1,10), pw3); \
    VRD(7); SBAR(); GAPA(C1=__builtin_amdgcn_mfma_f32_32x32x16_bf16(kf[7],qr[3],C1,0,0,0),   P1[14],P1[15],0.f,0.f,       pw3[2]=PKW(P1,12),pw3[3]=PKW(P1,14), pw3); \
    l_reg+=sacc; \
    if(GK){DMA_K((t)+3,sl_cur);} if(GV){DMA_V((t)+1,sl_next);} \
    CMASK(C0,C1,t); \
    { float a=MX3(C0[0],C0[1],C1[0]),b=MX3(C0[2],C0[3],C1[1]); a=MX3(a,C1[2],C1[3]); \
      _Pragma("unroll") for(int r=4;r<16;r+=4){a=MX3(a,C0[r],C0[r+1]);b=MX3(b,C0[r+2],C0[r+3]);a=MX3(a,C1[r],C1[r+1]);b=MX3(b,C1[r+2],C1[r+3]);} \
      float rm=__builtin_fmaxf(a,b); { auto rr=__builtin_amdgcn_permlane32_swap(__float_as_uint(rm),__float_as_uint(rm),false,false); rm=__builtin_fmaxf(__uint_as_float(rr[0]),__uint_as_float(rr[1])); } \
      resc=false; \
      if(__builtin_expect(__any(rm>(float)THRL),0)){ const float dl=__builtin_fmaxf(rm,0.f); mhat+=dl; \
        _Pragma("unroll") for(int r=0;r<16;++r){C0[r]-=dl;C1[r]-=dl;} \
        _Pragma("unroll") for(int r=0;r<16;++r)negm[r]=-mhat; asm volatile("":"+v"(negm)); \
        const float f=__builtin_amdgcn_exp2f(-dl); l_reg*=f; if(hi==0)wsf[r32]=f; resc=true; } } \
    SBAR(); \
    GAPB(o[0]=__builtin_amdgcn_mfma_f32_32x32x16_bf16(PAF(0),VFR(0),o[0],0,0,0), C0,0); \
    GAPB(o[1]=__builtin_amdgcn_mfma_f32_32x32x16_bf16(PAF(0),VFR(4),o[1],0,0,0), C0,4); \
    KRD(GL,0); GAPB(o[0]=__builtin_amdgcn_mfma_f32_32x32x16_bf16(PAF(1),VFR(1),o[0],0,0,0), C0,8); \
    KRD(GL,1); GAPB(o[1]=__builtin_amdgcn_mfma_f32_32x32x16_bf16(PAF(1),VFR(5),o[1],0,0,0), C0,12); \
    KRD(GL,2); GAPB(o[0]=__builtin_amdgcn_mfma_f32_32x32x16_bf16(PAF(2),VFR(2),o[0],0,0,0), C1,0); \
    KRD(GL,3); GAPB(o[1]=__builtin_amdgcn_mfma_f32_32x32x16_bf16(PAF(2),VFR(6),o[1],0,0,0), C1,4); \
    GAPB(o[0]=__builtin_amdgcn_mfma_f32_32x32x16_bf16(PAF(3),VFR(3),o[0],0,0,0), C1,8); \
    GAPB(o[1]=__builtin_amdgcn_mfma_f32_32x32x16_bf16(PAF(3),VFR(7),o[1],0,0,0), C1,12); \
    }while(0)
  int t=1;
  #undef CMASK
  #define CMASK(P0,P1,t) do{}while(0)
  for(;t+5<NT;t+=2){
    STEP(pB0,pB1,pA0,pA1,t,true,true,true);     WAIT_BAR(2); RESC(); ROT();
    STEP(pA0,pA1,pB0,pB1,t+1,true,true,true);   WAIT_BAR(2); RESC(); ROT();
  }
  #undef CMASK
  #define CMASK(P0,P1,t) do{int jb_=(t)-(NT-4); if(jb_>=0)cmask(P0,P1,jb_,qrel,hi);}while(0)
  #define ENDW(tt) do{ if((tt)+3<NT){WAIT_BAR(2);} else if((tt)+2<NT){WAIT_BAR(1);} else {WAIT_BAR(0);} }while(0)
  for(;t+1<NT;t+=2){
    STEP(pB0,pB1,pA0,pA1,t,(t+3<NT),(t+1<NT),(t+1<NT));       ENDW(t);   RESC(); ROT();
    STEP(pA0,pA1,pB0,pB1,t+1,(t+4<NT),(t+2<NT),(t+2<NT));     ENDW(t+1); RESC(); ROT();
  }
  STEP(pB0,pB1,pA0,pA1,NT-1,false,false,false); RESC();
  { float sacc=pB0[0]+pB0[1]; _Pragma("unroll") for(int r=2;r<16;++r)sacc+=pB0[r]; _Pragma("unroll") for(int r=0;r<16;++r)sacc+=pB1[r]; l_reg+=sacc;
    pw0=(u32x4){PKW(pB0,0),PKW(pB0,2),PKW(pB0,4),PKW(pB0,6)};pw1=(u32x4){PKW(pB0,8),PKW(pB0,10),PKW(pB0,12),PKW(pB0,14)};pw2=(u32x4){PKW(pB1,0),PKW(pB1,2),PKW(pB1,4),PKW(pB1,6)};pw3=(u32x4){PKW(pB1,8),PKW(pB1,10),PKW(pB1,12),PKW(pB1,14)};
    SBAR(); pv(o,vb0+sl_cur,PAF(0),PAF(1),PAF(2),PAF(3)); }
  #undef PKW
  #undef PAF
  #undef VFR
  #undef PIN
  #undef MX3
  #undef GAPA
  #undef GAPB
  #undef EX
  #undef VRD
  #undef KRD
  #undef STEP
  #undef ENDW
  {auto rr=__builtin_amdgcn_permlane32_swap(__float_as_uint(l_reg),__float_as_uint(l_reg),false,false);l_reg=__uint_as_float(rr[0])+__uint_as_float(rr[1]);}
  if(hi==0)wsf[32+r32]=l_reg;asm volatile("s_waitcnt lgkmcnt(0)":::"memory");
  float rli[16];
  #pragma unroll
  for(int r=0;r<16;++r)rli[r]=__builtin_amdgcn_rcpf(wsf[32+crow(r,hi)]);
  bf16*Ow=O+(rowbase+q0+wid*QBLK)*DM+h*D;
  { bf16*stg=(bf16*)(shm+LDS_OST)+wid*2048;
    #pragma unroll
    for(int r=0;r<16;++r){const int orow=crow(r,hi);
      #pragma unroll
      for(int d0=0;d0<2;++d0)stg[orow*64+d0*32+r32]=__float2bfloat16(o[d0][r]*rli[r]);}
    asm volatile("s_waitcnt lgkmcnt(0)":::"memory");
    #pragma unroll
    for(int i=0;i<4;++i){const int row=i*8+(lane>>3),ch=lane&7; const u32x4 v=*(const u32x4*)(stg+row*64+ch*8); ATTN_STORE16(Ow+(long)row*DM+ch*8,v);} }
  asm volatile("s_waitcnt lgkmcnt(0)\n\ts_barrier":::"memory");
  #undef DMA_K
  #undef DMA_V
  #undef CMASK
  #undef START
  #undef RESC
  #undef ROT
}
constexpr int ATTN_LDS_BYTES=LDS_BYTES;
struct AttnTensors { const bf16* Q; const bf16* K; const bf16* V; bf16* O; };
struct AttnUnit { int bh; int qb; };
struct StaticOrder {
  int vcu;
  __device__ __forceinline__ explicit StaticOrder(int grid,int block):vcu((block%8)*(grid/8)+block/8){}
  __device__ __forceinline__ bool next(int i,AttnUnit&u)const{ if(i>=4)return false; const int s=vcu&7; u.bh=vcu>>3; u.qb=(i==0)?s:(i==1)?15-s:(i==2)?16+s:31-s; return true; }
  __device__ __forceinline__ void a_ready(const AttnUnit&)const{}
  __device__ __forceinline__ void done(const AttnUnit&)const{}
};
template<class Sched,int THRL=8> __device__ __forceinline__ void attn_phase(char*lds,const AttnTensors&T,const Sched&S){
  AttnUnit u;
  for(int i=0;S.next(i,u);++i){ S.a_ready(u); attn_unit<THRL>(u.bh/NHEAD,u.bh%NHEAD,u.qb,T.Q,T.K,T.V,T.O,lds); S.done(u); }
}
#undef SBAR
#undef WAIT_BAR
}
#define XB_TMO      128
#define XB_XCNT(j)  (256  + 64 * (j))
#define XB_XSUB(j)  (1280 + 64 * (j))
#define XB_XGEN(j)  (2304 + 64 * (j))
#define XB_TOP      3328
#define XB_TOPGEN   3392
#define XCD_BAR_WORDS 3456
#define XB_SPIN_CAP (1u << 18)

__device__ __forceinline__ unsigned xb_ld(unsigned* p)              { return __hip_atomic_load(p, __ATOMIC_RELAXED, __HIP_MEMORY_SCOPE_AGENT); }
__device__ __forceinline__ unsigned xb_add(unsigned* p, unsigned v) { return __hip_atomic_fetch_add(p, v, __ATOMIC_RELAXED, __HIP_MEMORY_SCOPE_AGENT); }
__device__ __forceinline__ unsigned xb_xcc_id() { return (unsigned)__builtin_amdgcn_s_getreg((3 << 11) | 20) & 0xFu; }
#define XB_SPIN(cond, bar) do { unsigned _sp = 0; while (cond) { __builtin_amdgcn_s_sleep(1); \
    if ((++_sp & 255u) == 0u) { if (xb_ld(&(bar)[XB_TMO])) break; if (_sp > XB_SPIN_CAP) { atomicAdd(&(bar)[XB_TMO], 1u); break; } } } } while (0)

struct XcdBarrier {
    unsigned* bar; unsigned x;
    volatile LAS unsigned* st;
};

__device__ __forceinline__ XcdBarrier xcd_barrier_post(unsigned* bar, volatile LAS unsigned* st) {
    XcdBarrier b; b.bar = bar; b.x = xb_xcc_id(); b.st = st;
    if (threadIdx.x == 0) (void)xb_add(&bar[XB_XCNT(b.x)], 1u);
    return b;
}
__device__ __forceinline__ void xcd_barrier_complete(unsigned* bar, unsigned x, unsigned& nloc, unsigned& nx) {
    const unsigned G = gridDim.x * gridDim.y * gridDim.z;
    unsigned sum, cnt, mine, sp = 0u;
    for (;;) {
        sum = 0u; cnt = 0u; mine = 0u;
#pragma unroll
        for (unsigned j = 0; j < 16; ++j) { const unsigned c = xb_ld(&bar[XB_XCNT(j)]); sum += c; cnt += (c > 0u) ? 1u : 0u; mine = (j == x) ? c : mine; }
        if (sum == G) break;
        __builtin_amdgcn_s_sleep(1);
        if ((++sp & 255u) == 0u) { if (xb_ld(&bar[XB_TMO])) break; if (sp > XB_SPIN_CAP) { atomicAdd(&bar[XB_TMO], 1u); break; } }
    }
    nloc = mine > 0u ? mine : 1u; nx = cnt > 0u ? cnt : 1u;
}

__device__ __forceinline__ void xcd_barrier(const XcdBarrier& b) {
    asm volatile("s_waitcnt vmcnt(0)" ::: "memory");
    __syncthreads();
    if (threadIdx.x == 0) {
        unsigned* bar = b.bar;
        __builtin_amdgcn_s_waitcnt(0);
        unsigned nloc = b.st[0], nx = b.st[1];
        if (nloc == 0u) { xcd_barrier_complete(bar, b.x, nloc, nx); b.st[0] = nloc; b.st[1] = nx; }
        const unsigned old = xb_add(&bar[XB_XSUB(b.x)], 1u);
        const unsigned gen = old / nloc;
        if (old + 1u == (gen + 1u) * nloc) {
            __builtin_amdgcn_fence(__ATOMIC_RELEASE, "agent");
            asm volatile("s_waitcnt vmcnt(0)" ::: "memory");
            const unsigned og = xb_add(&bar[XB_TOP], 1u);
            const unsigned tg = og / nx;
            if (og + 1u == (tg + 1u) * nx) xb_add(&bar[XB_TOPGEN], 1u);
            else XB_SPIN(xb_ld(&bar[XB_TOPGEN]) == tg, bar);
            __builtin_amdgcn_fence(__ATOMIC_ACQUIRE, "agent");
            xb_add(&bar[XB_XGEN(b.x)], 1u);
            asm volatile("s_waitcnt vmcnt(0)" ::: "memory");
        } else {
            XB_SPIN(xb_ld(&bar[XB_XGEN(b.x)]) == gen, bar);
            __builtin_amdgcn_fence(__ATOMIC_ACQUIRE, "agent");
            asm volatile("s_waitcnt vmcnt(0)" ::: "memory");
        }
    }
    __syncthreads();
}

struct Ctx {
    LAS unsigned char* lds; int tid, lane, wave, vcu, G, gw, NGW;
};

__device__ __forceinline__ void tr_item(const float* W, int K, int N, bf16* WT, const float* ksc, int kmask, float kmul, int mode, LAS float* scr, int item, int lane) {
    const int nblk = N / 32, kb = item / nblk, nb = item % nblk, k0 = 64 * kb, n0 = 32 * nb;
#pragma unroll 8
    for (int i = 0; i < 32; ++i) { const int kk = 2 * i + (lane >> 5); const float s = ksc ? ksc[(k0 + kk) & kmask] * kmul : 1.0f; scr[kk * 33 + (lane & 31)] = W[(size_t)(k0 + kk) * N + n0 + (lane & 31)] * s; }
    LDS_WAIT(); asm volatile("" ::: "memory");
    const int c = lane & 7;
#pragma unroll
    for (int j = 0; j < 4; ++j) { const int n = (lane >> 3) + 8 * j; const LAS float* s = scr + (8 * c) * 33 + n;
        u32x4 o; o.x = pk2(s[0 * 33], s[1 * 33]); o.y = pk2(s[2 * 33], s[3 * 33]); o.z = pk2(s[4 * 33], s[5 * 33]); o.w = pk2(s[6 * 33], s[7 * 33]);
        const int nn = n0 + n; const int dr = mode == 0 ? nn : ((nn >> 7) * 256 + (nn & 127) + (mode == 2 ? 128 : 0));
        *(GAS u32x4*)(WT + (size_t)dr * K + k0 + 8 * c) = o; }
    LDS_WAIT(); asm volatile("" ::: "memory");
}

struct Args { const float* in[31]; float* out; unsigned char* ws; int ph_lo, ph_hi; };

__device__ __forceinline__ void p0_prologue(const Ctx& F, const Args& a) {
    unsigned char* ws = a.ws;
    LAS float* scr = (LAS float*)(F.lds + RING_OFF + F.wave * 16384);
    constexpr int I_IN = (D / 64) * (NIN / 32), I_SQ = (D / 64) * (D / 32), I_PP = (PLE / 64) * (D / 32);
    constexpr int NITEMS = I_IN + 4 * I_SQ + I_PP;
    for (int it = F.gw; it < NITEMS; it += F.NGW) {
        int r = it;
        if (r < I_IN) { tr_item(a.in[3], D, NIN, (bf16*)(ws + WS_WIN), a.in[2], 1023, 1.0f, 0, scr, r, F.lane); continue; } r -= I_IN;
        if (r < I_SQ) { tr_item(a.in[16], D, D, (bf16*)(ws + WS_WA), a.in[8], 127, 1.0f - LAM_INIT, 0, scr, r, F.lane); continue; } r -= I_SQ;
        if (r < I_SQ) { tr_item(a.in[17], D, D, (bf16*)(ws + WS_WL), nullptr, 0, 1.0f, 0, scr, r, F.lane); continue; } r -= I_SQ;
        if (r < I_SQ) { tr_item(a.in[18], D, D, (bf16*)(ws + WS_WO), nullptr, 0, 1.0f, 0, scr, r, F.lane); continue; } r -= I_SQ;
        if (r < I_SQ) { tr_item(a.in[28], D, D, (bf16*)(ws + WS_WPG), a.in[27], 1023, 1.0f, 0, scr, r, F.lane); continue; } r -= I_SQ;
        tr_item(a.in[29], PLE, D, (bf16*)(ws + WS_WPP), nullptr, 0, 1.0f, 0, scr, r, F.lane);
    }
    const int gt = F.gw * 64 + F.lane, NGT = F.NGW * 64;
    { float* Wr = (float*)(ws + WS_WR); const float* gm = a.in[19];
      for (int i = gt; i < 36 * 1024; i += NGT) { const int j = i >> 10, k = i & 1023; const float w = j < 32 ? a.in[22][(size_t)((j >> 3) * 1024 + k) * 8 + (j & 7)] : a.in[20][k * 4 + (j - 32)]; Wr[i] = w * gm[k]; } }
    { bf16* Wl = (bf16*)(ws + WS_WLRU);
      for (int i = gt; i < 2 * 65536; i += NGT) { const int gate = i >> 16, n = (i >> 12) & 15, v = (i >> 6) & 63, w = i & 63; const float* src = gate ? a.in[13] : a.in[11]; Wl[i] = (bf16)f2bf(src[(n * 64 + w) * 64 + v]); } }
    { const float* x = a.in[0]; bf16* xb = (bf16*)(ws + WS_U0); float* rstd0 = (float*)(ws + WS_RSTD0);
      for (int m = F.gw; m < M; m += F.NGW) { const GAS f32x4* xr = (const GAS f32x4*)(x + (size_t)m * D) + F.lane; f32x4 v[4]; float s = 0.f;
#pragma unroll
          for (int j = 0; j < 4; ++j) { v[j] = xr[64 * j]; s += (v[j].x * v[j].x + v[j].y * v[j].y) + (v[j].z * v[j].z + v[j].w * v[j].w); }
          s = wave_sum(s); if (F.lane == 0) rstd0[m] = 1.0f / sqrtf(s * (1.0f / D) + 1e-6f);
          GAS u32x2* o8 = (GAS u32x2*)(xb + (size_t)m * D) + F.lane;
#pragma unroll
          for (int j = 0; j < 4; ++j) o8[64 * j] = (u32x2){pk2(v[j].x, v[j].y), pk2(v[j].z, v[j].w)}; } }
    { const f32x4* p4 = (const f32x4*)a.in[1]; u32x2* pb = (u32x2*)(ws + WS_PB);
      for (int i = gt; i < M * PLE / 4; i += NGT) { const f32x4 v = p4[i]; pb[i] = (u32x2){pk2(v.x, v.y), pk2(v.z, v.w)}; } }
}

__device__ __forceinline__ void lru_phase(const Ctx& F, const bf16* xr, bf16* gl, const bf16* Wlru, const float* w_conv, const float* b_conv, const float* b_rg, const float* b_ig, const float* lam, int unit) {
    const int tid = F.tid, lane = F.lane, wave = F.wave, r32 = lane & 31, hi = lane >> 5;
    const int b = unit >> 5, n = (unit >> 1) & 15, half = unit & 1;
    constexpr int XRS = 144;
    LAS unsigned char* XR = F.lds; LAS unsigned char* XC = F.lds + 37376; LAS float* WCV = (LAS float*)(F.lds + 74240); LAS float* WS = (LAS float*)(F.lds + 75776);
    if (tid < 320) { const int j = tid >> 6, c = tid & 63; WCV[tid] = (j < 4) ? w_conv[j * 1024 + 64 * n + c] : b_conv[64 * n + c]; }
    const int oc = 64 * n + 32 * half + r32;
    const float brg = b_rg[oc], big = b_ig[oc];
    const float cdec = -8.0f * log1pf(expf(-lam[oc])) * 1.4426950408889634f;
    bf16x8 BwR[4], BwI[4];
#pragma unroll
    for (int ks = 0; ks < 4; ++ks) { BwR[ks] = *(const bf16x8*)(Wlru + ((size_t)(0 * 16 + n) * 64 + 32 * half + r32) * 64 + 16 * ks + 8 * hi);
                                     BwI[ks] = *(const bf16x8*)(Wlru + ((size_t)(1 * 16 + n) * 64 + 32 * half + r32) * 64 + 16 * ks + 8 * hi); }
    float hc = 0.f;
    const size_t rowb = (size_t)b * SEQ;
    for (int c = 0; c < SEQ / 256; ++c) {
        const int t0 = c * 256;
        for (int idx = tid; idx < 259 * 8; idx += 512) { const int row = idx >> 3, pc = idx & 7, t = t0 - 3 + row; u32x4 v = (u32x4){0u, 0u, 0u, 0u};
            if (t >= 0) v = *(const u32x4*)(xr + (rowb + t) * 1024 + 64 * n + 8 * pc);
            *(LAS u32x4*)(XR + row * XRS + pc * 16) = v; }
        bf16* gp = gl + (rowb + t0 + 32 * wave) * 1024 + oc;
        unsigned short gv[16];
#pragma unroll
        for (int r = 0; r < 16; ++r) gv[r] = gp[(size_t)crow16(r, hi) * 1024];
        __syncthreads();
        const int trow = 32 * wave + r32;
        bf16x8 av8[4];
#pragma unroll
        for (int ks = 0; ks < 4; ++ks) { const int c8 = 16 * ks + 8 * hi;
            f32x4 x0 = *(const LAS f32x4*)(WCV + 256 + c8), x1 = *(const LAS f32x4*)(WCV + 256 + c8 + 4);
#pragma unroll
            for (int j = 0; j < 4; ++j) { const u32x4 xv = *(const LAS u32x4*)(XR + (trow + j) * XRS + c8 * 2);
                const f32x4 w0 = *(const LAS f32x4*)(WCV + j * 64 + c8), w1 = *(const LAS f32x4*)(WCV + j * 64 + c8 + 4);
                x0 += w0 * (f32x4){bflo(xv.x), bfhi(xv.x), bflo(xv.y), bfhi(xv.y)}; x1 += w1 * (f32x4){bflo(xv.z), bfhi(xv.z), bflo(xv.w), bfhi(xv.w)}; }
            const u32x4 pk = (u32x4){pk2(x0[0], x0[1]), pk2(x0[2], x0[3]), pk2(x1[0], x1[1]), pk2(x1[2], x1[3])};
            av8[ks] = __builtin_bit_cast(bf16x8, pk);
            *(LAS u32x4*)(XC + trow * XRS + c8 * 2) = pk; }
        f32x16 aR = {}, aI = {};
#pragma unroll
        for (int ks = 0; ks < 4; ++ks) { aR = __builtin_amdgcn_mfma_f32_32x32x16_bf16(av8[ks], BwR[ks], aR, 0, 0, 0); aI = __builtin_amdgcn_mfma_f32_32x32x16_bf16(av8[ks], BwI[ks], aI, 0, 0, 0); }
        float av[16], uv[16];
#pragma unroll
        for (int r = 0; r < 16; ++r) { const int row = 32 * wave + crow16(r, hi);
            const float xcv = __uint_as_float((unsigned)(*(const LAS unsigned short*)(XC + row * XRS + (32 * half + r32) * 2)) << 16);
            const float rg = sigmoidf_(aR[r] + brg), ig = sigmoidf_(aI[r] + big);
            const float a_ = __builtin_amdgcn_exp2f(cdec * rg); const float mult = sqrtf(fmaxf(1.0f - a_ * a_, 0.f));
            av[r] = a_; uv[r] = mult * ig * xcv; }
        float gA[4], gB[4], pA[4], pB[4];
#pragma unroll
        for (int j = 0; j < 4; ++j) { float A = 1.f, B = 0.f;
#pragma unroll
            for (int i = 0; i < 4; ++i) { B = av[4 * j + i] * B + uv[4 * j + i]; A *= av[4 * j + i]; }
            gA[j] = A; gB[j] = B; pA[j] = __shfl_xor(A, 32); pB[j] = __shfl_xor(B, 32); }
        float AW = 1.f, BW = 0.f;
#pragma unroll
        for (int j = 0; j < 4; ++j) { const float fA = hi ? pA[j] : gA[j], fB = hi ? pB[j] : gB[j], sA = hi ? gA[j] : pA[j], sB = hi ? gB[j] : pB[j];
            BW = fA * BW + fB; AW *= fA; BW = sA * BW + sB; AW *= sA; }
        if (hi == 0) { WS[(wave * 32 + r32) * 2] = AW; WS[(wave * 32 + r32) * 2 + 1] = BW; }
        __syncthreads();
        float h = hc, hin = hc;
#pragma unroll
        for (int w = 0; w < 8; ++w) { const float A = WS[(w * 32 + r32) * 2], B = WS[(w * 32 + r32) * 2 + 1]; h = A * h + B; if (w + 1 == wave) hin = h; }
        hc = h;
        h = hin;
#pragma unroll
        for (int j = 0; j < 4; ++j) { float hh = hi ? pA[j] * h + pB[j] : h;
#pragma unroll
            for (int i = 0; i < 4; ++i) { hh = av[4 * j + i] * hh + uv[4 * j + i]; uv[4 * j + i] = hh; }
            h = hi ? hh : pA[j] * hh + pB[j]; }
#pragma unroll
        for (int r = 0; r < 16; ++r) gp[(size_t)crow16(r, hi) * 1024] = (bf16)f2bf(uv[r] * __uint_as_float((unsigned)gv[r] << 16));
        __syncthreads();
    }
}

__device__ __forceinline__ void p4_combine(const Ctx& F, const Args& a) {
    unsigned char* ws = a.ws;
    float lam;
    { const float s1 = wave_sum(a.in[4][F.lane] * a.in[5][F.lane]), s2 = wave_sum(a.in[6][F.lane] * a.in[7][F.lane]); lam = expf(s1) - expf(s2) + LAM_INIT; }
    bf16* O1 = (bf16*)(ws + WS_U0); const bf16* O2 = (const bf16*)(ws + WS_U0 + 4 * USZ);
    for (int m = F.gw; m < M; m += F.NGW) {
        const u32x4* p1 = (const u32x4*)(O1 + (size_t)m * D) + 2 * F.lane; const u32x4* p2 = (const u32x4*)(O2 + (size_t)m * D) + 2 * F.lane;
        const u32x4 a0 = p1[0], a1 = p1[1], b0 = p2[0], b1 = p2[1];
        f32x4 o[4], q[4]; pg8::unpack8(a0, o[0], o[1]); pg8::unpack8(a1, o[2], o[3]); pg8::unpack8(b0, q[0], q[1]); pg8::unpack8(b1, q[2], q[3]);
        float ss = 0.f;
#pragma unroll
        for (int j = 0; j < 4; ++j) { o[j] = o[j] - lam * q[j]; ss += (o[j].x * o[j].x + o[j].y * o[j].y) + (o[j].z * o[j].z + o[j].w * o[j].w); }
        ss += __shfl_xor(ss, 1); ss += __shfl_xor(ss, 2); ss += __shfl_xor(ss, 4);
        const float rs = 1.0f / sqrtf(ss * (1.0f / 128.0f) + 1e-5f);
        u32x4 w0, w1; w0 = (u32x4){pk2(o[0].x * rs, o[0].y * rs), pk2(o[0].z * rs, o[0].w * rs), pk2(o[1].x * rs, o[1].y * rs), pk2(o[1].z * rs, o[1].w * rs)};
        w1 = (u32x4){pk2(o[2].x * rs, o[2].y * rs), pk2(o[2].z * rs, o[2].w * rs), pk2(o[3].x * rs, o[3].y * rs), pk2(o[3].z * rs, o[3].w * rs)};
        u32x4* po = (u32x4*)(O1 + (size_t)m * D) + 2 * F.lane; po[0] = w0; po[1] = w1;
    }
    LAS float* scr = (LAS float*)(F.lds + RING_OFF + F.wave * 16384);
    constexpr int I_GU = (D / 64) * (FF / 32), I_DN = (FF / 64) * (D / 32);
    for (int it = F.gw; it < NEXP * (2 * I_GU + I_DN); it += F.NGW) {
        const int e = it / (2 * I_GU + I_DN); int r = it % (2 * I_GU + I_DN);
        if (r < I_GU) { tr_item(a.in[24] + (size_t)e * D * FF, D, FF, (bf16*)(ws + WS_WGU) + (size_t)e * 1024 * 1024, a.in[19], 1023, 1.0f, 1, scr, r, F.lane); continue; } r -= I_GU;
        if (r < I_GU) { tr_item(a.in[25] + (size_t)e * D * FF, D, FF, (bf16*)(ws + WS_WGU) + (size_t)e * 1024 * 1024, a.in[19], 1023, 1.0f, 2, scr, r, F.lane); continue; } r -= I_GU;
        tr_item(a.in[26] + (size_t)e * FF * D, FF, D, (bf16*)(ws + WS_WD) + (size_t)e * 1024 * 512, nullptr, 0, 1.0f, 0, scr, r, F.lane);
    }
}

__device__ __forceinline__ void p7_router(const Ctx& F, const Args& a) {
    unsigned char* ws = a.ws;
    const float* x1 = a.out; const float* Wr = (const float*)(ws + WS_WR);
    LAS float* WL = (LAS float*)F.lds;
    for (int i = F.tid; i < 36 * 256; i += NWAVES * 64) ((LAS f32x4*)WL)[i] = ((const f32x4*)Wr)[i];
    __syncthreads();
    int* list = (int*)(ws + WS_LIST); unsigned* cnt = (unsigned*)(ws + WS_CTL) + CW_CNT; i32x4* tokinfo = (i32x4*)(ws + WS_TOKINFO);
    const float* bg = a.in[21]; const float* bfe = a.in[23];
    for (int m = F.gw; m < M; m += F.NGW) {
        const GAS f32x4* xr = (const GAS f32x4*)(x1 + (size_t)m * D) + F.lane; f32x4 v[4]; float s = 0.f;
#pragma unroll
        for (int j = 0; j < 4; ++j) { v[j] = xr[64 * j]; s += (v[j].x * v[j].x + v[j].y * v[j].y) + (v[j].z * v[j].z + v[j].w * v[j].w); }
        const float rstd = 1.0f / sqrtf(wave_sum(s) * (1.0f / D) + 1e-6f);
        float gl[4];
#pragma unroll
        for (int g = 0; g < 4; ++g) { float d = 0.f;
#pragma unroll
            for (int j = 0; j < 4; ++j) { const f32x4 w = *(const LAS f32x4*)(WL + (32 + g) * 1024 + 4 * F.lane + 256 * j); d += (v[j].x * w.x + v[j].y * w.y) + (v[j].z * w.z + v[j].w * w.w); }
            gl[g] = wave_sum(d) * rstd + bg[g]; }
        int gi = 0; float gmax = gl[0];
#pragma unroll
        for (int g = 1; g < 4; ++g) if (gl[g] > gmax) { gmax = gl[g]; gi = g; }
        float gs = 0.f;
#pragma unroll
        for (int g = 0; g < 4; ++g) gs += expf(gl[g] - gmax);
        const float gw = 1.0f / gs;
        gi = __builtin_amdgcn_readfirstlane(gi);
        float fl[8];
#pragma unroll
        for (int e = 0; e < 8; ++e) { float d = 0.f;
#pragma unroll
            for (int j = 0; j < 4; ++j) { const f32x4 w = *(const LAS f32x4*)(WL + (gi * 8 + e) * 1024 + 4 * F.lane + 256 * j); d += (v[j].x * w.x + v[j].y * w.y) + (v[j].z * w.z + v[j].w * w.w); }
            fl[e] = wave_sum(d) * rstd + bfe[gi * 8 + e]; }
        int i0 = 0; float l0 = fl[0];
#pragma unroll
        for (int e = 1; e < 8; ++e) if (fl[e] > l0) { l0 = fl[e]; i0 = e; }
        int i1 = -1; float l1 = -INFINITY;
#pragma unroll
        for (int e = 0; e < 8; ++e) if (e != i0 && fl[e] > l1) { l1 = fl[e]; i1 = e; }
        const float ex = expf(l1 - l0), w0 = 1.0f / (1.0f + ex), w1 = ex * w0;
        if (F.lane == 0) { const int e0 = gi * 8 + i0, e1 = gi * 8 + i1;
            const int p0 = (int)atomicAdd(cnt + e0, 1u), p1 = (int)atomicAdd(cnt + e1, 1u);
            list[(size_t)e0 * CAP + p0] = m; list[(size_t)e1 * CAP + p1] = m;
            tokinfo[m * 2] = (i32x4){e0, e1, p0, p1}; tokinfo[m * 2 + 1] = (i32x4){__float_as_int(gw * w0), __float_as_int(gw * w1), __float_as_int(rstd), 0}; }
    }
}

__device__ __forceinline__ void moe_tables(const Ctx& F, const unsigned* cnt) {
    LAS int* tp = (LAS int*)(F.lds + CTLL_OFF + 64); LAS int* cn = (LAS int*)(F.lds + CTLL_OFF + 256);
    if (F.tid == 0) { int acc = 0; for (int e = 0; e < NEXP; ++e) { const int c = (int)__hip_atomic_load(cnt + e, RLX_AGENT); cn[e] = c; tp[e] = acc; acc += (c + 255) >> 8; } tp[NEXP] = acc; }
    __syncthreads();
}

__device__ __forceinline__ void p10_combine(const Ctx& F, const Args& a) {
    unsigned char* ws = a.ws;
    const LAS int* tp = (const LAS int*)(F.lds + CTLL_OFF + 64);
    const i32x4* tokinfo = (const i32x4*)(ws + WS_TOKINFO); const bf16* Y = (const bf16*)(ws + WS_Y); bf16* x2b = (bf16*)(ws + WS_U0); float* rstd2 = (float*)(ws + WS_RSTD2);
    for (int m = F.gw; m < M; m += F.NGW) {
        const i32x4 t0 = tokinfo[m * 2];
        const int s0 = tp[t0.x] * 256 + t0.z, s1 = tp[t0.y] * 256 + t0.w;
        GAS f32x4* xr = (GAS f32x4*)(a.out + (size_t)m * D) + F.lane; const u32x2* y0 = (const u32x2*)(Y + (size_t)s0 * D) + F.lane; const u32x2* y1 = (const u32x2*)(Y + (size_t)s1 * D) + F.lane;
        f32x4 v[4]; float s = 0.f;
#pragma unroll
        for (int j = 0; j < 4; ++j) { const u32x2 p = y0[64 * j], q = y1[64 * j]; v[j] = xr[64 * j];
            v[j].x += bflo(p.x) + bflo(q.x); v[j].y += bfhi(p.x) + bfhi(q.x); v[j].z += bflo(p.y) + bflo(q.y); v[j].w += bfhi(p.y) + bfhi(q.y);
            s += (v[j].x * v[j].x + v[j].y * v[j].y) + (v[j].z * v[j].z + v[j].w * v[j].w); }
        s = wave_sum(s); if (F.lane == 0) rstd2[m] = 1.0f / sqrtf(s * (1.0f / D) + 1e-6f);
        GAS u32x2* o8 = (GAS u32x2*)(x2b + (size_t)m * D) + F.lane;
#pragma unroll
        for (int j = 0; j < 4; ++j) { xr[64 * j] = v[j]; o8[64 * j] = (u32x2){pk2(v[j].x, v[j].y), pk2(v[j].z, v[j].w)}; }
    }
}

__device__ __forceinline__ void p12_final(const Ctx& F, const Args& a) {
    const f32x4* g4 = (const f32x4*)a.in[30];
    for (int m = F.gw; m < M; m += F.NGW) {
        GAS f32x4* xr = (GAS f32x4*)(a.out + (size_t)m * D) + F.lane; f32x4 v[4]; float s = 0.f;
#pragma unroll
        for (int j = 0; j < 4; ++j) { v[j] = xr[64 * j]; s += (v[j].x * v[j].x + v[j].y * v[j].y) + (v[j].z * v[j].z + v[j].w * v[j].w); }
        const float rs = 1.0f / sqrtf(wave_sum(s) * (1.0f / D) + 1e-6f);
#pragma unroll
        for (int j = 0; j < 4; ++j) xr[64 * j] = v[j] * rs * g4[F.lane + 64 * j];
    }
}

#ifndef MK_N_LAUNCHES
#define MK_N_LAUNCHES 13
#endif
constexpr int NPH = 13;
constexpr int N_LAUNCHES = MK_N_LAUNCHES;

__global__ void __launch_bounds__(NWAVES * 64, 2) mega_fwd(Args args) {
    extern __shared__ __attribute__((aligned(16))) unsigned char lds[];
    Ctx F;
    F.lds = (LAS unsigned char*)lds;
    F.tid = threadIdx.x; F.lane = F.tid & 63; F.wave = __builtin_amdgcn_readfirstlane(F.tid >> 6);
    F.G = gridDim.x; { const int bx = blockIdx.x; F.vcu = (F.G % 8 == 0) ? (bx % 8) * (F.G / 8) + bx / 8 : bx; }
    F.gw = F.vcu * NWAVES + F.wave; F.NGW = F.G * NWAVES;
    unsigned char* ws = args.ws;
    gu32* ctl = (gu32*)(ws + WS_CTL);
    for (int u = F.tid; u < (LDS_BYTES - CTLL_OFF) / 4; u += NWAVES * 64) ((LAS unsigned*)(F.lds + CTLL_OFF))[u] = 0u;
    __syncthreads();
    XcdBarrier bar; bar.bar = (unsigned*)ctl + CW_BAR; bar.x = 0; bar.st = nullptr;
    if (N_LAUNCHES == 1) bar = xcd_barrier_post((unsigned*)ctl + CW_BAR, (volatile LAS unsigned*)(F.lds + CTLL_OFF));
#define GRID_BAR() do { if (N_LAUNCHES == 1) xcd_barrier(bar); } while (0)
    const int lo = args.ph_lo, hi = args.ph_hi;
#define IN(k) (lo <= (k) && (k) < hi)
#define BOTH(k) (IN(k) && IN((k) + 1))
    bf16* U0 = (bf16*)(ws + WS_U0);

    if (IN(0)) { p0_prologue(F, args); if (BOTH(0)) GRID_BAR(); }

    if (IN(1)) {
        pg8::DenseOrder S; S.init(ws + WS_U0, ws + WS_WIN, M, NIN, D, F.G, (int)blockIdx.x);
        pg8::EpiIn E{(bf16*)(ws + WS_U0 + 1 * USZ), (const float*)(ws + WS_RSTD0)};
        pg8::gemm_phase<D, pg8::EpiIn, pg8::DenseOrder, false, true>(F.lds + RING_OFF, S, E);
        if (BOTH(1)) GRID_BAR();
    }

    if (IN(2)) {
        if ((int)blockIdx.x < 64)
            lru_phase(F, (const bf16*)(ws + WS_U0 + 4 * USZ), (bf16*)(ws + WS_U0 + 5 * USZ), (const bf16*)(ws + WS_WLRU), args.in[9], args.in[10], args.in[12], args.in[14], args.in[15], (int)blockIdx.x);
        if (BOTH(2)) GRID_BAR();
    }

    if (IN(3)) {
        const bf16* Q = (const bf16*)(ws + WS_U0 + 1 * USZ); const bf16* Kb = (const bf16*)(ws + WS_U0 + 2 * USZ); const bf16* Vb = (const bf16*)(ws + WS_U0 + 3 * USZ);
        bf16* O1 = (bf16*)(ws + WS_U0); bf16* O2 = (bf16*)(ws + WS_U0 + 4 * USZ);
        for (int k = F.vcu; k < 2048; k += F.G) {
            const int v = k & 255, i = k >> 8, s = v & 7, bh = (v >> 3) + 32 * (i >> 2), j = i & 3;
            const int qb = (j == 0) ? s : (j == 1) ? 15 - s : (j == 2) ? 16 + s : 31 - s;
            const int b = bh >> 5, vu = bh & 31, h = vu >> 2, c = (vu >> 1) & 1, vh = vu & 1;
            attn_body::attn_unit<8>(b, 0, qb, (const attn_body::bf16*)(Q + 128 * h + 64 * c), (const attn_body::bf16*)(Kb + 128 * h + 64 * c), (const attn_body::bf16*)(Vb + 128 * h + 64 * vh),
                                    (attn_body::bf16*)((c ? O2 : O1) + 128 * h + 64 * vh), (char*)lds + RING_OFF);
        }
        if (BOTH(3)) GRID_BAR();
    }

    if (IN(4)) { p4_combine(F, args); if (BOTH(4)) GRID_BAR(); }

    if (IN(5)) {
        bf16* mixed = (bf16*)(ws + WS_U0 + 4 * USZ);
        { pg8::DenseOrder S; S.init(ws + WS_U0, ws + WS_WA, M, D, D, F.G, (int)blockIdx.x);
          pg8::EpiMix<true> E{mixed, (const bf16*)(ws + WS_U0 + 6 * USZ)};
          pg8::gemm_phase<D, pg8::EpiMix<true>, pg8::DenseOrder, false, false>(F.lds + RING_OFF, S, E); }
        { pg8::DenseOrder S; S.init(ws + WS_U0 + 5 * USZ, ws + WS_WL, M, D, D, F.G, (int)blockIdx.x);
          pg8::EpiMix<false> E{mixed, (const bf16*)(ws + WS_U0 + 7 * USZ)};
          pg8::gemm_phase<D, pg8::EpiMix<false>, pg8::DenseOrder, false, false>(F.lds + RING_OFF, S, E); }
        if (BOTH(5)) GRID_BAR();
    }

    if (IN(6)) {
        pg8::DenseOrder S; S.init(ws + WS_U0 + 4 * USZ, ws + WS_WO, M, D, D, F.G, (int)blockIdx.x);
        pg8::EpiOut E{args.in[0], args.out, U0};
        pg8::gemm_phase<D, pg8::EpiOut, pg8::DenseOrder, false, false>(F.lds + RING_OFF, S, E);
        if (BOTH(6)) GRID_BAR();
    }

    if (IN(7)) { p7_router(F, args); if (BOTH(7)) GRID_BAR(); }

    if (IN(8)) {
        moe_tables(F, (const unsigned*)ctl + CW_CNT);
        pg8::MoeOrder<true> S{(const char*)U0, (const char*)(ws + WS_WGU), (size_t)1024 * 1024 * 2, D, F.G, F.vcu, (const LAS int*)(F.lds + CTLL_OFF + 64), (const LAS int*)(F.lds + CTLL_OFF + 256), (const int*)(ws + WS_LIST)};
        pg8::EpiGU E{(bf16*)(ws + WS_HID), (const int*)(ws + WS_LIST), (const i32x4*)(ws + WS_TOKINFO)};
        pg8::gemm_phase<D, pg8::EpiGU, pg8::MoeOrder<true>, true, false>(F.lds + RING_OFF, S, E);
        if (BOTH(8)) GRID_BAR();
    }

    if (IN(9)) {
        moe_tables(F, (const unsigned*)ctl + CW_CNT);
        pg8::MoeOrder<false> S{(const char*)(ws + WS_HID), (const char*)(ws + WS_WD), (size_t)1024 * 512 * 2, FF, F.G, F.vcu, (const LAS int*)(F.lds + CTLL_OFF + 64), (const LAS int*)(F.lds + CTLL_OFF + 256), (const int*)(ws + WS_LIST)};
        pg8::EpiBf E{(bf16*)(ws + WS_Y), D};
        pg8::gemm_phase<FF, pg8::EpiBf, pg8::MoeOrder<false>, false, false>(F.lds + RING_OFF, S, E);
        if (BOTH(9)) GRID_BAR();
    }

    if (IN(10)) { moe_tables(F, (const unsigned*)ctl + CW_CNT); p10_combine(F, args); if (BOTH(10)) GRID_BAR(); }

    if (IN(11)) {
        { pg8::DenseOrder S; S.init(ws + WS_PB, ws + WS_WPP, M, D, PLE, F.G, (int)blockIdx.x);
          pg8::EpiBf E{(bf16*)(ws + WS_PROJ), D};
          pg8::gemm_phase<PLE, pg8::EpiBf, pg8::DenseOrder, false, false>(F.lds + RING_OFF, S, E); }
        { pg8::DenseOrder S; S.init(ws + WS_U0, ws + WS_WPG, M, D, D, F.G, (int)blockIdx.x);
          pg8::EpiPle E{args.out, (const bf16*)(ws + WS_PROJ), (const float*)(ws + WS_RSTD2)};
          pg8::gemm_phase<D, pg8::EpiPle, pg8::DenseOrder, false, false>(F.lds + RING_OFF, S, E); }
        if (BOTH(11)) GRID_BAR();
    }

    if (IN(12)) { p12_final(F, args); }
#undef IN
#undef BOTH
}

extern "C" void kernel_launch(void* const* d_in, const int* in_sizes, int n_in, void* d_out, int out_size, void* d_ws, size_t ws_size, hipStream_t stream) {
    static int grid = 0;
    if (grid == 0) {
        if (n_in != 31 || in_sizes[0] != M * D || out_size != M * D || ws_size < WS_END) { fprintf(stderr, "kernel_launch: unexpected shapes (n_in %d, in0 %d, out %d, ws %zu < %zu); nothing launched\n", n_in, n_in > 0 ? in_sizes[0] : -1, out_size, ws_size, (size_t)WS_END); grid = -1; return; }
        int dev = 0, cus = 0, per_cu = 0;
        if (hipGetDevice(&dev) != hipSuccess || hipDeviceGetAttribute(&cus, hipDeviceAttributeMultiprocessorCount, dev) != hipSuccess) { grid = -1; return; }
        if (hipFuncSetAttribute((const void*)mega_fwd, hipFuncAttributeMaxDynamicSharedMemorySize, LDS_BYTES) != hipSuccess) { fprintf(stderr, "kernel_launch: hipFuncSetAttribute failed\n"); grid = -1; return; }
        if (hipOccupancyMaxActiveBlocksPerMultiprocessor(&per_cu, (const void*)mega_fwd, NWAVES * 64, LDS_BYTES) != hipSuccess || per_cu < 1)
            fprintf(stderr, "kernel_launch: note: occupancy query reports %d workgroups per CU\n", per_cu);
        (void)hipGetLastError();
        grid = cus;
    }
    if (grid < 0) return;
    if (hipMemsetAsync((char*)d_ws + WS_CTL, 0, CTL_ZERO_BYTES, stream) != hipSuccess) return;
    Args a{};
    for (int i = 0; i < 31; ++i) a.in[i] = (const float*)d_in[i];
    a.out = (float*)d_out; a.ws = (unsigned char*)d_ws;
    for (int li = 0; li < N_LAUNCHES; ++li) {
        a.ph_lo = (N_LAUNCHES == 1) ? 0 : li; a.ph_hi = (N_LAUNCHES == 1) ? NPH : li + 1;
        hipLaunchKernelGGL(mega_fwd, dim3(grid), dim3(NWAVES * 64), LDS_BYTES, stream, a);
        const hipError_t le = hipPeekAtLastError();
        if (le != hipSuccess) { fprintf(stderr, "kernel_launch: launch %d failed: %s\n", li, hipGetErrorName(le)); break; }
    }
}
```

```cpp
#include <hip/hip_runtime.h>
#include <hip/hip_bf16.h>
#include <cstdio>
#include <cstdint>
#include <cmath>

#define LAS __attribute__((address_space(3)))
#define GAS __attribute__((address_space(1)))
typedef unsigned short bf16;
typedef short bf16x8 __attribute__((ext_vector_type(8)));
typedef float f32x4 __attribute__((ext_vector_type(4)));
typedef float f32x2 __attribute__((ext_vector_type(2)));
typedef float f32x16 __attribute__((ext_vector_type(16)));
typedef unsigned u32x4 __attribute__((ext_vector_type(4)));
typedef unsigned u32x2 __attribute__((ext_vector_type(2)));
typedef int i32x4 __attribute__((ext_vector_type(4)));
typedef GAS unsigned gu32;

constexpr int M = 16384, D = 1024, SEQ = 8192, NBATCH = 2, NIN = 7168, PLE = 256, NEXP = 32, FF = 512, CAP = 16384;
constexpr float C2 = 0.125f * 1.4426950408889634f;
constexpr float LAM_INIT = 0.2f;

constexpr size_t MiB = 1u << 20;
constexpr size_t WS_CTL = 0, CTL_ZERO_BYTES = 64 * 1024;
constexpr size_t WS_RSTD0 = 1 * MiB, WS_RSTD2 = 1 * MiB + 65536, WS_TOKINFO = 1 * MiB + 131072;
constexpr size_t WS_WR = 2 * MiB, WS_WLRU = 2 * MiB + 262144;
constexpr size_t WS_LIST = 4 * MiB;
constexpr size_t WS_WIN = 8 * MiB, WS_WA = 22 * MiB, WS_WL = 24 * MiB, WS_WO = 26 * MiB, WS_WPG = 28 * MiB, WS_WPP = 30 * MiB;
constexpr size_t WS_U0 = 32 * MiB, USZ = 32 * MiB;
constexpr size_t WS_WGU = WS_U0 + 1 * USZ, WS_WD = WS_U0 + 3 * USZ;
constexpr size_t WS_Y = WS_U0 + 4 * USZ;
constexpr size_t WS_HID = 246 * MiB, WS_PROJ = 246 * MiB;
constexpr size_t WS_PB = 288 * MiB, WS_END = 296 * MiB;
constexpr int CW_TMO = 0, CW_CODE = 1, CW_BAR = 1024, CW_CNT = 8192;

constexpr int RING_OFF = 0, RING_BYTES = 131072, AUX_OFF = 131072, CTLL_OFF = 147456, LDS_BYTES = 149504;
constexpr int NWAVES = 8;

#define RLX_AGENT __ATOMIC_RELAXED, __HIP_MEMORY_SCOPE_AGENT
#define LDS_WAIT() asm volatile("s_waitcnt lgkmcnt(0)" ::: "memory")
#define VM_WAIT() asm volatile("s_waitcnt vmcnt(0)" ::: "memory")
__device__ __forceinline__ unsigned f2bf(float f) { unsigned u = __builtin_bit_cast(unsigned, f); return (u + 0x7fffu + ((u >> 16) & 1u)) >> 16; }
__device__ __forceinline__ unsigned pk2(float lo, float hi) { return f2bf(lo) | (f2bf(hi) << 16); }
__device__ __forceinline__ float bflo(unsigned w) { return __uint_as_float(w << 16); }
__device__ __forceinline__ float bfhi(unsigned w) { return __uint_as_float(w & 0xffff0000u); }
__device__ __forceinline__ float sigmoidf_(float v) { return __builtin_amdgcn_rcpf(1.0f + __builtin_amdgcn_exp2f(-1.4426950408889634f * v)); }
__device__ __forceinline__ float gelu_tanh(float v) { return v * __builtin_amdgcn_rcpf(1.0f + __builtin_amdgcn_exp2f(-2.3022082f * v * (1.0f + 0.044715f * v * v))); }
__device__ __forceinline__ float wave_sum(float v) {
#pragma unroll
    for (int o = 1; o < 64; o <<= 1) v += __shfl_xor(v, o);
    return v;
}
__device__ __forceinline__ int crow16(int r, int hi) { return (r & 3) + 8 * (r >> 2) + 4 * hi; }

namespace pg8 {
constexpr int BM = 256, BK = 64, HALF = 128, HTB = HALF * BK * 2, NXCD = 8, WGM = 8;
__host__ __device__ __forceinline__ int lds_byte(int r, int c) { const int st = (r >> 4) * 2 + (c >> 5), rr = r & 15, cc = c & 31, ob = rr * 64 + cc * 2; return st * 1024 + (ob ^ (((ob >> 9) & 1) << 5)); }
__host__ __device__ __forceinline__ void stage_rc(int b, int& R, int& C) { const int st = b / 1024, sb = b % 1024, swz = sb ^ (((sb >> 9) & 1) << 5); R = (st >> 1) * 16 + swz / 64; C = (st & 1) * 32 + (swz % 64) / 2; }
__host__ __device__ __forceinline__ int perm32(int rho) { const int n = rho >> 4, i = rho & 15; return 8 * (i >> 2) + 4 * n + (i & 3); }

struct Unit { int pm, pn, e, nv, r0; const char* a; const char* b; };

struct DenseOrder {
    const char* A; const char* Bt; int K, nM, nN, nwg, G, c;
    __device__ __forceinline__ void init(const void* A_, const void* Bt_, int M_, int N_, int K_, int G_, int c_) { A = (const char*)A_; Bt = (const char*)Bt_; K = K_; nM = M_ / BM; nN = N_ / BM; nwg = nM * nN; G = G_; c = c_; }
    __device__ __forceinline__ bool next(int i, Unit& u) const {
        const long L = (long)i * G + c; if (L >= nwg) return false;
        int wgid = (int)L; { const int q = nwg / NXCD, r = nwg % NXCD, xcd = wgid % NXCD, off = wgid / NXCD; wgid = (xcd < r ? xcd * (q + 1) : r * (q + 1) + (xcd - r) * q) + off; }
        const int nig = WGM * nN, gid = wgid / nig, fm = gid * WGM, gsz = (nM - fm) < WGM ? (nM - fm) : WGM;
        u.pm = fm + ((wgid % nig) % gsz); u.pn = (wgid % nig) / gsz; u.e = 0; u.nv = BM; u.r0 = 0;
        u.a = A + (size_t)u.pm * BM * K * 2; u.b = Bt + (size_t)u.pn * BM * K * 2; return true;
    }
    __device__ __forceinline__ void rows(const Unit&, const int (&R)[2], const int (&C)[2], unsigned (&ra)[2][2]) const {
#pragma unroll
        for (int h = 0; h < 2; ++h)
#pragma unroll
            for (int i = 0; i < 2; ++i) ra[h][i] = (unsigned)(((h * HALF + R[i]) * K + C[i]) * 2);
    }
};
template <bool GATHER> struct MoeOrder {
    const char* A; const char* Bt; size_t bstride; int K, G, c; const LAS int* tp; const LAS int* cnt; const int* list;
    __device__ __forceinline__ bool next(int i, Unit& u) const {
        const int L = i * G + c; const int T = __builtin_amdgcn_readfirstlane(tp[NEXP]) * 4; if (L >= T) return false;
        const int rt = L >> 2; int e = 0;
        while (e < NEXP - 1 && __builtin_amdgcn_readfirstlane(tp[e + 1]) <= rt) ++e;
        const int lt = rt - __builtin_amdgcn_readfirstlane(tp[e]); const int rem = __builtin_amdgcn_readfirstlane(cnt[e]) - lt * BM;
        u.pm = rt; u.pn = L & 3; u.e = e; u.nv = rem < BM ? rem : BM; u.r0 = lt * BM;
        u.a = GATHER ? A : A + (size_t)rt * BM * K * 2; u.b = Bt + (size_t)e * bstride + (size_t)u.pn * BM * K * 2; return true;
    }
    __device__ __forceinline__ void rows(const Unit& u, const int (&R)[2], const int (&C)[2], unsigned (&ra)[2][2]) const {
#pragma unroll
        for (int h = 0; h < 2; ++h)
#pragma unroll
            for (int i = 0; i < 2; ++i) {
                if (GATHER) { const int lr = h * HALF + R[i]; const int tok = list[(size_t)u.e * CAP + u.r0 + (lr < u.nv ? lr : 0)]; ra[h][i] = (unsigned)((tok * K + C[i]) * 2); }
                else ra[h][i] = (unsigned)(((h * HALF + R[i]) * K + C[i]) * 2);
            }
    }
};

template <int K, class Epi, class Sched, bool GATHER, bool ALIGN_EPI>
__device__ __forceinline__ void gemm_phase(LAS unsigned char* lds, const Sched& S, const Epi& E) {
    const int tid = threadIdx.x, wid = __builtin_amdgcn_readfirstlane(tid >> 6), lane = tid & 63, wr = wid >> 2, wc = wid & 3, fr = lane & 15, fq = lane >> 4;
    constexpr int nt = K / BK;
    int R[2], C[2]; unsigned voffB[2];
#pragma unroll
    for (int i = 0; i < 2; ++i) { stage_rc(tid * 16 + i * 8192, R[i], C[i]); const int Rb = Epi::PERM ? ((R[i] & ~31) + perm32(R[i] & 31)) : R[i]; voffB[i] = (unsigned)(Rb * K + C[i]) * 2u; }
    constexpr size_t kstep = (size_t)(BK * 2);
    constexpr size_t hstepB = (size_t)HALF * K * 2;
    const unsigned ldsw = (unsigned)wid * 1024u;
    const int aoff = lds_byte(wr * 64 + fr, fq * 8), boff = lds_byte(wc * 32 + fr, fq * 8);
#define PG8_SA(b, h) (((b) * 2 + (h)) * HTB)
#define PG8_SB(b, h) ((4 + (b) * 2 + (h)) * HTB)
#define PG8_STAGE_B(bufoff, gbase) do { _Pragma("unroll") for (int _i = 0; _i < 2; ++_i) \
        __builtin_amdgcn_global_load_lds((const unsigned*)((const char*)(gbase) + voffB[_i]), (LAS unsigned*)(lds + (bufoff) + ldsw + _i * 8192), 16, 0, 0); } while (0)
#define PG8_STAGE_A(bufoff, gbase, va, h) do { _Pragma("unroll") for (int _i = 0; _i < 2; ++_i) \
        __builtin_amdgcn_global_load_lds((const unsigned*)((const char*)(gbase) + (va)[h][_i]), (LAS unsigned*)(lds + (bufoff) + ldsw + _i * 8192), 16, 0, 0); } while (0)
#define PG8_LDA(dst, b, h) do { _Pragma("unroll") for (int m = 0; m < 4; ++m) _Pragma("unroll") for (int k = 0; k < 2; ++k) dst[m][k] = *(const LAS bf16x8*)(lds + PG8_SA(b, h) + aoff + m * 2048 + k * 1024); } while (0)
#define PG8_LDB(dst, b, h) do { _Pragma("unroll") for (int n = 0; n < 2; ++n) _Pragma("unroll") for (int k = 0; k < 2; ++k) dst[n][k] = *(const LAS bf16x8*)(lds + PG8_SB(b, h) + boff + n * 2048 + k * 1024); } while (0)
#define PG8_MMA(ai, bj, At, Bt) do { __builtin_amdgcn_s_setprio(1); _Pragma("unroll") for (int m = 0; m < 4; ++m) _Pragma("unroll") for (int n = 0; n < 2; ++n) _Pragma("unroll") for (int k = 0; k < 2; ++k) \
        acc[ai][bj][m][n] = __builtin_amdgcn_mfma_f32_16x16x32_bf16(Bt[n][k], At[m][k], acc[ai][bj][m][n], 0, 0, 0); __builtin_amdgcn_s_setprio(0); } while (0)
#define PG8_WAIT_V(n) asm volatile("s_waitcnt vmcnt(" #n ")" ::: "memory")
#define PG8_WAIT_L(n) asm volatile("s_waitcnt lgkmcnt(" #n ")" ::: "memory")
#define PG8_BAR __builtin_amdgcn_s_barrier()
#define PG8_SCHED __builtin_amdgcn_sched_barrier(0)
    Unit cur, nxt; int ui = 0;
    if (!S.next(0, cur)) return;
    unsigned vAc[2][2], vAn[2][2];
    S.rows(cur, R, C, vAc);
    f32x4 acc[2][2][4][2];
#pragma unroll
    for (int a = 0; a < 2; ++a)
#pragma unroll
        for (int b = 0; b < 2; ++b)
#pragma unroll
            for (int m = 0; m < 4; ++m)
#pragma unroll
                for (int n = 0; n < 2; ++n) acc[a][b][m][n] = (f32x4){0.f, 0.f, 0.f, 0.f};
    bf16x8 At[4][2], B0[2][2], B1[2][2];
    const char* cA = cur.a; const char* cB = cur.b;
    PG8_STAGE_B(PG8_SB(0, 0), cB); PG8_STAGE_B(PG8_SB(0, 1), cB + hstepB); PG8_STAGE_A(PG8_SA(0, 0), cA, vAc, 0); PG8_STAGE_A(PG8_SA(0, 1), cA, vAc, 1);
    if (wr == 1) PG8_BAR;
    PG8_WAIT_V(2); PG8_BAR;
    PG8_STAGE_B(PG8_SB(1, 0), cB + kstep); PG8_STAGE_A(PG8_SA(1, 0), cA + kstep, vAc, 0); PG8_STAGE_B(PG8_SB(1, 1), cB + hstepB + kstep);
    PG8_WAIT_V(6); PG8_BAR;
    for (;;) {
        const bool has_next = S.next(ui + 1, nxt);
        if (GATHER) { if (has_next) S.rows(nxt, R, C, vAn); else {
#pragma unroll
            for (int h = 0; h < 2; ++h)
#pragma unroll
                for (int i = 0; i < 2; ++i) vAn[h][i] = vAc[h][i]; } }
        const char* nA = has_next ? nxt.a : cA; const char* nB = has_next ? nxt.b : cB;
        for (int t = 0; t < nt; t += 2) {
            const bool last = (t == nt - 2);
            const char* a1 = cA + (size_t)(t + 1) * kstep;
            const char* a2 = last ? nA : cA + (size_t)(t + 2) * kstep; const char* b2 = last ? nB : cB + (size_t)(t + 2) * kstep;
            const char* a3 = a2 + kstep; const char* b3 = b2 + kstep;
            unsigned va2[2][2];
#pragma unroll
            for (int h = 0; h < 2; ++h)
#pragma unroll
                for (int i = 0; i < 2; ++i) va2[h][i] = (GATHER && last) ? vAn[h][i] : vAc[h][i];
            PG8_LDB(B0, 0, 0); PG8_LDB(B1, 0, 1); PG8_SCHED; PG8_LDA(At, 0, 0); PG8_STAGE_A(PG8_SA(1, 1), a1, vAc, 1);
            PG8_WAIT_V(8); PG8_WAIT_L(0); PG8_BAR; PG8_MMA(0, 0, At, B0); PG8_MMA(0, 1, At, B1); PG8_BAR; PG8_SCHED;
            PG8_LDA(At, 0, 1); PG8_STAGE_B(PG8_SB(0, 0), b2); PG8_STAGE_B(PG8_SB(0, 1), b2 + hstepB); PG8_STAGE_A(PG8_SA(0, 0), a2, va2, 0);
            PG8_WAIT_V(8); PG8_WAIT_L(0); PG8_BAR; PG8_MMA(1, 0, At, B0); PG8_MMA(1, 1, At, B1); PG8_BAR; PG8_SCHED;
            PG8_LDB(B0, 1, 0); PG8_LDB(B1, 1, 1); PG8_SCHED; PG8_LDA(At, 1, 0); PG8_STAGE_A(PG8_SA(0, 1), a2, va2, 1);
            PG8_WAIT_V(8); PG8_WAIT_L(0); PG8_BAR; PG8_MMA(0, 0, At, B0); PG8_MMA(0, 1, At, B1); PG8_BAR; PG8_SCHED;
            PG8_LDA(At, 1, 1); PG8_STAGE_B(PG8_SB(1, 0), b3); PG8_STAGE_B(PG8_SB(1, 1), b3 + hstepB); PG8_STAGE_A(PG8_SA(1, 0), a3, va2, 0);
            PG8_WAIT_V(8); PG8_WAIT_L(0); PG8_BAR; PG8_MMA(1, 0, At, B0); PG8_MMA(1, 1, At, B1); PG8_BAR; PG8_SCHED;
        }
        if constexpr (ALIGN_EPI) { if (wr == 0) PG8_BAR; }
        E(acc, cur, wr, wc, fr, fq);
        if (!has_next) break;
#pragma unroll
        for (int a = 0; a < 2; ++a)
#pragma unroll
            for (int b = 0; b < 2; ++b)
#pragma unroll
                for (int m = 0; m < 4; ++m)
#pragma unroll
                    for (int n = 0; n < 2; ++n) acc[a][b][m][n] = (f32x4){0.f, 0.f, 0.f, 0.f};
        cur = nxt; cA = nA; cB = nB; ++ui;
        if (GATHER) {
#pragma unroll
            for (int h = 0; h < 2; ++h)
#pragma unroll
                for (int i = 0; i < 2; ++i) vAc[h][i] = vAn[h][i]; }
        if constexpr (ALIGN_EPI) { if (wr == 1) PG8_BAR; }
    }
    PG8_WAIT_V(0);
    if constexpr (!ALIGN_EPI) { if (wr == 0) PG8_BAR; }
    PG8_BAR;
#undef PG8_SA
#undef PG8_SB
#undef PG8_STAGE_A
#undef PG8_STAGE_B
#undef PG8_LDA
#undef PG8_LDB
#undef PG8_MMA
#undef PG8_WAIT_V
#undef PG8_WAIT_L
#undef PG8_BAR
#undef PG8_SCHED
}

__device__ __forceinline__ unsigned cvt_pk_bf16(float lo, float hi) { unsigned r; asm volatile("v_cvt_pk_bf16_f32 %0, %1, %2" : "=v"(r) : "v"(lo), "v"(hi)); return r; }
__device__ __forceinline__ u32x4 pack8(const f32x4& v0, const f32x4& v1) { u32x4 w; w.x = cvt_pk_bf16(v0[0], v0[1]); w.y = cvt_pk_bf16(v0[2], v0[3]); w.z = cvt_pk_bf16(v1[0], v1[1]); w.w = cvt_pk_bf16(v1[2], v1[3]); return w; }
__device__ __forceinline__ void unpack8(const u32x4& w, f32x4& v0, f32x4& v1) { v0 = (f32x4){bflo(w.x), bfhi(w.x), bflo(w.y), bfhi(w.y)}; v1 = (f32x4){bflo(w.z), bfhi(w.z), bflo(w.w), bfhi(w.w)}; }
__device__ __forceinline__ u32x4 ld16_sc1(const void* p) { u32x4 v; asm volatile("global_load_dwordx4 %0, %1, off sc1\n\ts_waitcnt vmcnt(0)" : "=v"(v) : "v"(p) : "memory"); return v; }

struct EpiIn {
    static constexpr bool PERM = true;
    bf16* base; const float* rstd;
    __device__ __forceinline__ void operator()(const f32x4 (&acc)[2][2][4][2], const Unit& u, int wr, int wc, int fr, int fq) const {
        const int t = u.pn >> 2; bf16* O = base + (size_t)t * M * 1024;
        const int row0 = u.pm * BM + wr * 64 + fr, col0 = (u.pn & 3) * BM + wc * 32 + 8 * fq;
        float rs[2][4];
#pragma unroll
        for (int ai = 0; ai < 2; ++ai)
#pragma unroll
            for (int m = 0; m < 4; ++m) rs[ai][m] = rstd[row0 + ai * HALF + m * 16] * (t == 0 ? C2 : 1.0f);
#pragma unroll
        for (int ai = 0; ai < 2; ++ai)
#pragma unroll
            for (int m = 0; m < 4; ++m) { bf16* rowp = O + (size_t)(row0 + ai * HALF + m * 16) * 1024 + col0;
#pragma unroll
                for (int bj = 0; bj < 2; ++bj) { f32x4 v0 = acc[ai][bj][m][0] * rs[ai][m], v1 = acc[ai][bj][m][1] * rs[ai][m];
                    if (t == 4) {
#pragma unroll
                        for (int q = 0; q < 4; ++q) { v0[q] = gelu_tanh(v0[q]); v1[q] = gelu_tanh(v1[q]); } }
                    else if (t >= 5) {
#pragma unroll
                        for (int q = 0; q < 4; ++q) { v0[q] = sigmoidf_(v0[q]); v1[q] = sigmoidf_(v1[q]); } }
                    *(u32x4*)(rowp + bj * HALF) = pack8(v0, v1); } }
    }
};
struct EpiBf {
    static constexpr bool PERM = true;
    bf16* O; int ldc;
    __device__ __forceinline__ void operator()(const f32x4 (&acc)[2][2][4][2], const Unit& u, int wr, int wc, int fr, int fq) const {
        const int row0 = u.pm * BM + wr * 64 + fr, col0 = u.pn * BM + wc * 32 + 8 * fq;
#pragma unroll
        for (int ai = 0; ai < 2; ++ai)
#pragma unroll
            for (int m = 0; m < 4; ++m) { bf16* rowp = O + (size_t)(row0 + ai * HALF + m * 16) * ldc + col0;
#pragma unroll
                for (int bj = 0; bj < 2; ++bj) *(u32x4*)(rowp + bj * HALF) = pack8(acc[ai][bj][m][0], acc[ai][bj][m][1]); }
    }
};
template <bool FIRST> struct EpiMix {
    static constexpr bool PERM = true;
    bf16* mixed; const bf16* gate;
    __device__ __forceinline__ void operator()(const f32x4 (&acc)[2][2][4][2], const Unit& u, int wr, int wc, int fr, int fq) const {
        const int row0 = u.pm * BM + wr * 64 + fr, col0 = u.pn * BM + wc * 32 + 8 * fq;
#pragma unroll
        for (int ai = 0; ai < 2; ++ai)
#pragma unroll
            for (int m = 0; m < 4; ++m) { const size_t ro = (size_t)(row0 + ai * HALF + m * 16) * 1024 + col0;
#pragma unroll
                for (int bj = 0; bj < 2; ++bj) { const u32x4 gw = *(const u32x4*)(gate + ro + bj * HALF); f32x4 g0, g1; unpack8(gw, g0, g1);
                    f32x4 v0 = acc[ai][bj][m][0] * g0, v1 = acc[ai][bj][m][1] * g1;
                    if (!FIRST) { const u32x4 pw = ld16_sc1(mixed + ro + bj * HALF); f32x4 p0, p1; unpack8(pw, p0, p1); v0 += p0; v1 += p1; }
                    *(u32x4*)(mixed + ro + bj * HALF) = pack8(v0, v1); } }
    }
};
struct EpiOut {
    static constexpr bool PERM = true;
    const float* x; float* out; bf16* xb;
    __device__ __forceinline__ void operator()(const f32x4 (&acc)[2][2][4][2], const Unit& u, int wr, int wc, int fr, int fq) const {
        const int row0 = u.pm * BM + wr * 64 + fr, col0 = u.pn * BM + wc * 32 + 8 * fq;
#pragma unroll
        for (int ai = 0; ai < 2; ++ai)
#pragma unroll
            for (int m = 0; m < 4; ++m) { const size_t ro = (size_t)(row0 + ai * HALF + m * 16) * 1024 + col0;
#pragma unroll
                for (int bj = 0; bj < 2; ++bj) { const f32x4 x0 = *(const f32x4*)(x + ro + bj * HALF), x1 = *(const f32x4*)(x + ro + bj * HALF + 4);
                    const f32x4 v0 = acc[ai][bj][m][0] + x0, v1 = acc[ai][bj][m][1] + x1;
                    *(f32x4*)(out + ro + bj * HALF) = v0; *(f32x4*)(out + ro + bj * HALF + 4) = v1;
                    *(u32x4*)(xb + ro + bj * HALF) = pack8(v0, v1); } }
    }
};
struct EpiGU {
    static constexpr bool PERM = true;
    bf16* hid; const int* list; const i32x4* tokinfo;
    __device__ __forceinline__ void operator()(const f32x4 (&acc)[2][2][4][2], const Unit& u, int wr, int wc, int fr, int fq) const {
        const int lr0 = wr * 64 + fr, col0 = u.pn * HALF + wc * 32 + 8 * fq;
#pragma unroll
        for (int ai = 0; ai < 2; ++ai)
#pragma unroll
            for (int m = 0; m < 4; ++m) { const int lr = lr0 + ai * HALF + m * 16; const bool valid = lr < u.nv;
                const int tok = list[(size_t)u.e * CAP + u.r0 + (valid ? lr : 0)];
                const i32x4 t0 = tokinfo[tok * 2], t1 = tokinfo[tok * 2 + 1];
                const float cw = (t0.x == u.e) ? __int_as_float(t1.x) : __int_as_float(t1.y), rs = __int_as_float(t1.z);
                f32x4 h0, h1;
#pragma unroll
                for (int q = 0; q < 4; ++q) { const float g0 = acc[ai][0][m][0][q] * rs, u0 = acc[ai][1][m][0][q] * rs, g1 = acc[ai][0][m][1][q] * rs, u1 = acc[ai][1][m][1][q] * rs;
                    h0[q] = cw * g0 * sigmoidf_(g0) * u0; h1[q] = cw * g1 * sigmoidf_(g1) * u1; }
                if (valid) *(u32x4*)(hid + (size_t)(u.pm * BM + lr) * FF + col0) = pack8(h0, h1); }
    }
};
struct EpiPle {
    static constexpr bool PERM = true;
    float* out; const bf16* proj; const float* rstd;
    __device__ __forceinline__ void operator()(const f32x4 (&acc)[2][2][4][2], const Unit& u, int wr, int wc, int fr, int fq) const {
        const int row0 = u.pm * BM + wr * 64 + fr, col0 = u.pn * BM + wc * 32 + 8 * fq;
#pragma unroll
        for (int ai = 0; ai < 2; ++ai)
#pragma unroll
            for (int m = 0; m < 4; ++m) { const int row = row0 + ai * HALF + m * 16; const size_t ro = (size_t)row * 1024 + col0; const float rs = rstd[row];
#pragma unroll
                for (int bj = 0; bj < 2; ++bj) { const u32x4 pw = ld16_sc1(proj + ro + bj * HALF); f32x4 p0, p1; unpack8(pw, p0, p1);
                    const f32x4 x0 = *(const f32x4*)(out + ro + bj * HALF), x1 = *(const f32x4*)(out + ro + bj * HALF + 4);
                    f32x4 v0, v1;
#pragma unroll
                    for (int q = 0; q < 4; ++q) { v0[q] = x0[q] + sigmoidf_(acc[ai][bj][m][0][q] * rs) * p0[q]; v1[q] = x1[q] + sigmoidf_(acc[ai][bj][m][1][q] * rs) * p1[q]; }
                    *(f32x4*)(out + ro + bj * HALF) = v0; *(f32x4*)(out + ro + bj * HALF + 4) = v1; } }
    }
};
}

namespace attn_body {
using bf16=__hip_bfloat16;
using bf16x8=__attribute__((ext_vector_type(8)))short;
using s16x4=__attribute__((ext_vector_type(4)))short;
using f32x16=__attribute__((ext_vector_type(16)))float;
using u32x4=__attribute__((ext_vector_type(4)))unsigned;
constexpr int BATCH=2,NHEAD=16,SEQ=8192,D=64,DM=NHEAD*D;
constexpr int NW=8,QBLK=32,QB=QBLK*NW,KVBLK=64,NQB=SEQ/QB;
constexpr int ATTN_PITCH=DM, ATTN_UNIT_ROWS=QB;
__device__ __forceinline__ int crow(int r,int hi){return (r&3)+8*(r>>2)+4*hi;}
#define SBAR() __builtin_amdgcn_sched_barrier(0)
__device__ __forceinline__ void cmask(f32x16&p0,f32x16&p1,int jb,int qrel,int hi){
  const float NEG=-INFINITY; int kb=64*jb+4*hi;
  #pragma unroll
  for(int r=0;r<16;++r){int kv=kb+(r&3)+8*(r>>2); if(kv>qrel)p0[r]=NEG; if(kv+32>qrel)p1[r]=NEG;}
}

constexpr int NSLOT=3, SLOTB=8192;
constexpr int LDS_K=0, LDS_V=NSLOT*SLOTB, LDS_WS=2*NSLOT*SLOTB, LDS_OST=LDS_WS+NW*64*4, LDS_BYTES=LDS_OST+NW*4096;
constexpr float C2=0.125f*1.4426950408889634f;
__device__ __forceinline__ void glds16(const void*gsrc,unsigned lds_dst){unsigned keep;
  asm volatile("s_mov_b32 %0, m0\n\ts_mov_b32 m0, %2\n\ts_nop 0\n\tglobal_load_lds_dwordx4 %1, off\n\ts_mov_b32 m0, %0":"=&s"(keep):"v"(gsrc),"s"(lds_dst):"memory");}
__device__ __forceinline__ float max3f(float a,float b,float c){float r;asm("v_max3_f32 %0, %1, %2, %3":"=v"(r):"v"(a),"v"(b),"v"(c));return r;}
__device__ __forceinline__ float max2f(float a,float b){float r;asm("v_max_f32_e32 %0, %1, %2":"=v"(r):"v"(a),"v"(b));return r;}
__device__ __forceinline__ float fadd_s(float a,float b){float r;asm("v_add_f32_e32 %0, %1, %2":"=v"(r):"v"(a),"v"(b));return r;}
__device__ __forceinline__ float fsub_s(float a,float b){float r;asm("v_sub_f32_e32 %0, %1, %2":"=v"(r):"v"(a),"v"(b));return r;}
typedef float f32x2_t __attribute__((ext_vector_type(2))); typedef __bf16 bf16x2_t __attribute__((ext_vector_type(2)));
__device__ __forceinline__ unsigned cvtpk_s(float lo,float hi){f32x2_t v={lo,hi};bf16x2_t b=__builtin_convertvector(v,bf16x2_t);return __builtin_bit_cast(unsigned,b);}
#define WAIT_BAR(N) asm volatile("s_waitcnt vmcnt(" #N ") lgkmcnt(0)\n\ts_barrier":::"memory")

__device__ __forceinline__ void qkt(f32x16&p0,f32x16&p1,const char*Kslot,const bf16x8*qr,const f32x16&negm,int r32,int hi){
  const char*kb=Kslot+hi*1024+r32*16;
  #pragma unroll
  for(int d0=0;d0<4;++d0){
    const bf16x8 b0=*reinterpret_cast<const bf16x8*>(kb+d0*2048);
    const bf16x8 b1=*reinterpret_cast<const bf16x8*>(kb+d0*2048+512);
    if(d0==0){p0=__builtin_amdgcn_mfma_f32_32x32x16_bf16(b0,qr[0],negm,0,0,0);p1=__builtin_amdgcn_mfma_f32_32x32x16_bf16(b1,qr[0],negm,0,0,0);}
    else{p0=__builtin_amdgcn_mfma_f32_32x32x16_bf16(b0,qr[d0],p0,0,0,0);p1=__builtin_amdgcn_mfma_f32_32x32x16_bf16(b1,qr[d0],p1,0,0,0);}}
}
typedef __attribute__((address_space(3))) const char* lds_cptr;
typedef short v4i16_t __attribute__((ext_vector_type(4)));
__device__ __forceinline__ void kload8(bf16x8*kf,lds_cptr kp){
  kf[0]=*(const __attribute__((address_space(3))) bf16x8*)(kp);      kf[1]=*(const __attribute__((address_space(3))) bf16x8*)(kp+512);
  kf[2]=*(const __attribute__((address_space(3))) bf16x8*)(kp+2048); kf[3]=*(const __attribute__((address_space(3))) bf16x8*)(kp+2560);
  kf[4]=*(const __attribute__((address_space(3))) bf16x8*)(kp+4096); kf[5]=*(const __attribute__((address_space(3))) bf16x8*)(kp+4608);
  kf[6]=*(const __attribute__((address_space(3))) bf16x8*)(kp+6144); kf[7]=*(const __attribute__((address_space(3))) bf16x8*)(kp+6656);
}
__device__ __forceinline__ void kload2(bf16x8*kf,lds_cptr kp,int j){ kf[2*j]=*(const __attribute__((address_space(3))) bf16x8*)(kp+j*2048); kf[2*j+1]=*(const __attribute__((address_space(3))) bf16x8*)(kp+j*2048+512); }
__device__ __forceinline__ s16x4 vtr(lds_cptr p){ return __builtin_bit_cast(s16x4,__builtin_amdgcn_ds_read_tr16_b64_v4i16((__attribute__((address_space(3))) v4i16_t*)p)); }
__device__ __forceinline__ float rowmax(const f32x16&p0,const f32x16&p1){
  float a=max3f(p0[0],p0[1],p1[0]),b=max3f(p0[2],p0[3],p1[1]);a=max3f(a,p1[2],p1[3]);
  #pragma unroll
  for(int r=4;r<16;r+=4){a=max3f(a,p0[r],p0[r+1]);b=max3f(b,p0[r+2],p0[r+3]);a=max3f(a,p1[r],p1[r+1]);b=max3f(b,p1[r+2],p1[r+3]);}
  const float m=max2f(a,b);
  auto rr=__builtin_amdgcn_permlane32_swap(__float_as_uint(m),__float_as_uint(m),false,false);
  return max2f(__uint_as_float(rr[0]),__uint_as_float(rr[1]));
}
__device__ __forceinline__ void pv(f32x16*o,int vb,bf16x8 pa0,bf16x8 pa1,bf16x8 pa2,bf16x8 pa3){
  #pragma unroll
  for(int d0=0;d0<2;++d0){s16x4 lo[4],hi[4];
    #pragma unroll
    for(int ks=0;ks<4;++ks){
      asm volatile("ds_read_b64_tr_b16 %0,%1 offset:%c2":"=&v"(lo[ks]):"v"(vb),"i"(d0*4096+ks*1024):"memory");
      asm volatile("ds_read_b64_tr_b16 %0,%1 offset:%c2":"=&v"(hi[ks]):"v"(vb),"i"(d0*4096+ks*1024+512):"memory");}
    asm volatile("s_waitcnt lgkmcnt(0)":::"memory");SBAR();
    #define PK(k) (bf16x8){lo[k][0],lo[k][1],lo[k][2],lo[k][3],hi[k][0],hi[k][1],hi[k][2],hi[k][3]}
    o[d0]=__builtin_amdgcn_mfma_f32_32x32x16_bf16(pa0,PK(0),o[d0],0,0,0);
    o[d0]=__builtin_amdgcn_mfma_f32_32x32x16_bf16(pa1,PK(1),o[d0],0,0,0);
    o[d0]=__builtin_amdgcn_mfma_f32_32x32x16_bf16(pa2,PK(2),o[d0],0,0,0);
    o[d0]=__builtin_amdgcn_mfma_f32_32x32x16_bf16(pa3,PK(3),o[d0],0,0,0);
    #undef PK
  }
}

#ifndef ATTN_STORE16
#define ATTN_STORE16(p,v) (*(u32x4*)(p)=(v))
#endif
template<int THRL> __device__ __forceinline__ void attn_unit(int b,int h,int qb,const bf16*Q,const bf16*__restrict__ K,const bf16*__restrict__ V,bf16*O,char*shm){
  const int tid=threadIdx.x,lane=tid&63,r32=lane&31,hi=lane>>5; const int wid=__builtin_amdgcn_readfirstlane(tid>>6);
  const long rowbase=(long)b*SEQ; const int q0=qb*QB;
  const bf16*Qw=Q+(rowbase+q0+wid*QBLK)*DM+h*D;
  const bf16*Kh=K+rowbase*DM+h*D,*Vh=V+rowbase*DM+h*D;
  const unsigned lds0=(unsigned)(uintptr_t)shm;
  float*wsf=(float*)(shm+LDS_WS)+wid*64;
  const bf16*ksrc=Kh+(long)lane*DM+wid*8;
  const bf16*vsrc=Vh+(long)(16*(wid&3)+(lane>>2))*DM+(wid>>2)*32+(lane&3)*8;
  const unsigned kdst=lds0+LDS_K+wid*1024, vdst=lds0+LDS_V+wid*1024;
  #define DMA_K(t,slot) glds16(ksrc+(long)(t)*KVBLK*DM,(unsigned)__builtin_amdgcn_readfirstlane(kdst+(slot)))
  #define DMA_V(t,slot) glds16(vsrc+(long)(t)*KVBLK*DM,(unsigned)__builtin_amdgcn_readfirstlane(vdst+(slot)))
  const int vb0=(int)(lds0+LDS_V)+((lane>>4)&1)*32+(lane&3)*8+(4*hi+((lane&15)>>2))*64;
  const char*Kbase=shm+LDS_K; bf16x8 kf[8];
  const lds_cptr shm3=(lds_cptr)shm; const lds_cptr kp0=shm3+LDS_K+hi*1024+r32*16; const lds_cptr vp0=shm3+LDS_V+((lane>>4)&1)*32+(lane&3)*8+(4*hi+((lane&15)>>2))*64;
  const int NT=(q0+QB)/KVBLK;
  DMA_K(0,0);DMA_V(0,0);DMA_K(1,SLOTB);
  bf16x8 qr[4];
  #pragma unroll
  for(int d0=0;d0<4;++d0)qr[d0]=*reinterpret_cast<const bf16x8*>(&Qw[(long)r32*DM+d0*16+hi*8]);
  float mhat=0.f,l_reg=0.f;float zz_;asm volatile("v_mov_b32 %0, 0":"=v"(zz_));f32x16 o[2];
  _Pragma("unroll") for(int r=0;r<16;++r){o[0][r]=zz_;o[1][r]=zz_;}
  f32x16 negm;_Pragma("unroll") for(int r=0;r<16;++r)negm[r]=zz_;asm volatile("":"+v"(negm));
  const int qrel=wid*QBLK+r32;
  #define CMASK(P0,P1,t) do{int jb_=(t)-(NT-4); if(jb_>=0)cmask(P0,P1,jb_,qrel,hi);}while(0)
  bool resc=false;
  #define START(P0,P1) do{ const float rm=rowmax(P0,P1); resc=false; \
    { const float dl=rm; mhat=fadd_s(mhat,dl); \
      _Pragma("unroll") for(int r=0;r<16;++r){P0[r]=fsub_s(P0[r],dl);P1[r]=fsub_s(P1[r],dl);} \
      _Pragma("unroll") for(int r=0;r<16;++r)negm[r]=-mhat; asm volatile("":"+v"(negm)); } \
    _Pragma("unroll") for(int r=0;r<16;++r)P0[r]=__builtin_amdgcn_exp2f(P0[r]); }while(0)
  #define RESC() do{ if(resc){ asm volatile("s_waitcnt lgkmcnt(0)":::"memory"); \
      _Pragma("unroll") for(int d_=0;d_<2;++d_) _Pragma("unroll") for(int r=0;r<16;++r)o[d_][r]*=wsf[crow(r,hi)]; } }while(0)
  f32x16 pA0,pA1,pB0,pB1;
  int sl_prev=0,sl_cur=0,sl_next=SLOTB;
  #define ROT() do{sl_prev=sl_cur;sl_cur=sl_next;sl_next=(sl_next==(NSLOT-1)*SLOTB)?0:sl_next+SLOTB;}while(0)
  DMA_K(2,2*SLOTB);
  WAIT_BAR(3);
  qkt(pA0,pA1,Kbase,qr,negm,r32,hi);asm volatile("s_nop 15\n\ts_nop 7":"+v"(pA0),"+v"(pA1));CMASK(pA0,pA1,0);
  START(pA0,pA1);
  _Pragma("unroll") for(int r=0;r<16;++r)pA1[r]=__builtin_amdgcn_exp2f(pA1[r]);
  WAIT_BAR(0);
  DMA_K(3,0);DMA_V(1,SLOTB);
  ROT();
  kload8(kf,kp0+sl_cur);
  WAIT_BAR(2);
  s16x4 vlo[8],vhi[8]; u32x4 pw0,pw1,pw2,pw3;
  #define PKW(P,B) cvtpk_s(P[B],P[B+1])
  #define PAF(k) __builtin_bit_cast(bf16x8,pw##k)
  #define VFR(i) (bf16x8){vlo[i][0],vlo[i][1],vlo[i][2],vlo[i][3],vhi[i][0],vhi[i][1],vhi[i][2],vhi[i][3]}
  #define PIN(x) asm volatile("":"+v"(x))
  #define MX3(a,b,c) __builtin_fmaxf(__builtin_fmaxf((a),(b)),(c))
  #define GAPA(MF,A0,A1,A2,A3,W0,W1,PW) do{ MF; sacc+=A0; sacc+=A1; sacc+=A2; sacc+=A3; PIN(sacc); W0; W1; PIN(PW); SBAR(); }while(0)
  #define EX(v) __builtin_amdgcn_exp2f(v)
  #define GAPB(MF,X,B) do{ MF; X[B]=EX(X[B]); X[B+1]=EX(X[B+1]); X[B+2]=EX(X[B+2]); X[B+3]=EX(X[B+3]); PIN(X); SBAR(); }while(0)
  #define VRD(i) do{ vlo[i]=vtr(vp_+(((i)>>2)*4096+((i)&3)*1024)); vhi[i]=vtr(vp_+(((i)>>2)*4096+((i)&3)*1024+512)); }while(0)
  #define KRD(G,j) do{ if(G){ kload2(kf,kp0+sl_next,j); SBAR(); } }while(0)
  #define STEP(C0,C1,P0,P1,t,GK,GV,GL) do{ SBAR(); \
    const lds_cptr vp_=vp0+sl_prev; \
    VRD(0); SBAR(); float sacc=(P0[0]+P0[1]); \
    GAPA(C0=__builtin_amdgcn_mfma_f32_32x32x16_bf16(kf[0],qr[0],negm,0,0,0), P0[2],P0[3],P0[4],P0[5],     pw0[0]=PKW(P0,0), pw0[1]=PKW(P0,2), pw0); \
    VRD(4); SBAR(); GAPA(C1=__builtin_amdgcn_mfma_f32_32x32x16_bf16(kf[1],qr[0],negm,0,0,0), P0[6],P0[7],P0[8],P0[9],     pw0[2]=PKW(P0,4), pw0[3]=PKW(P0,6), pw0); \
    VRD(1); SBAR(); GAPA(C0=__builtin_amdgcn_mfma_f32_32x32x16_bf16(kf[2],qr[1],C0,0,0,0),   P0[10],P0[11],P0[12],P0[13], pw1[0]=PKW(P0,8), pw1[1]=PKW(P0,10), pw1); \
    VRD(5); SBAR(); GAPA(C1=__builtin_amdgcn_mfma_f32_32x32x16_bf16(kf[3],qr[1],C1,0,0,0),   P0[14],P0[15],P1[0],P1[1],   pw1[2]=PKW(P0,12),pw1[3]=PKW(P0,14), pw1); \
    VRD(2); SBAR(); GAPA(C0=__builtin_amdgcn_mfma_f32_32x32x16_bf16(kf[4],qr[2],C0,0,0,0),   P1[2],P1[3],P1[4],P1[5],     pw2[0]=PKW(P1,0), pw2[1]=PKW(P1,2), pw2); \
    VRD(6); SBAR(); GAPA(C1=__builtin_amdgcn_mfma_f32_32x32x16_bf16(kf[5],qr[2],C1,0,0,0),   P1[6],P1[7],P1[8],P1[9],     pw2[2]=PKW(P1,4), pw2[3]=PKW(P1,6), pw2); \
    VRD(3); SBAR(); GAPA(C0=__builtin_amdgcn_mfma_f32_32x32x16_bf16(kf[6],qr[3],C0,0,0,0),   P1[10],P1[11],P1[12],P1[13], pw3[0]=PKW(P1,8), pw3[1]=PKW(P1,10), pw3); \
    VRD(7); SBAR(); GAPA(C1=__builtin_amdgcn_mfma_f32_32x32x16_bf16(kf[7],qr[3],C1,0,0,0),   P1[14],P1[15],0.f,0.f,       pw3[2]=PKW(P1,12),pw3[3]=PKW(P1,14), pw3); \
    l_reg+=sacc; \
    if(GK){DMA_K((t)+3,sl_cur);} if(GV){DMA_V((t)+1,sl_next);} \
    CMASK(C0,C1,t); \
    { float a=MX3(C0[0],C0[1],C1[0]),b=MX3(C0[2],C0[3],C1[1]); a=MX3(a,C1[2],C1[3]); \
      _Pragma("unroll") for(int r=4;r<16;r+=4){a=MX3(a,C0[r],C0[r+1]);b=MX3(b,C0[r+2],C0[r+3]);a=MX3(a,C1[r],C1[r+1]);b=MX3(b,C1[r+2],C1[r+3]);} \
      float rm=__builtin_fmaxf(a,b); { auto rr=__builtin_amdgcn_permlane32_swap(__float_as_uint(rm),__float_as_uint(rm),false,false); rm=__builtin_fmaxf(__uint_as_float(rr[0]),__uint_as_float(rr[1])); } \
      resc=false; \
      if(__builtin_expect(__any(rm>(float)THRL),0)){ const float dl=__builtin_fmaxf(rm,0.f); mhat+=dl; \
        _Pragma("unroll") for(int r=0;r<16;++r){C0[r]-=dl;C1[r]-=dl;} \
        _Pragma("unroll") for(int r=0;r<16;++r)negm[r]=-mhat; asm volatile("":"+v"(negm)); \
        const float f=__builtin_amdgcn_exp2f(-dl); l_reg*=f; if(hi==0)wsf[r32]=f; resc=true; } } \
    SBAR(); \
    GAPB(o[0]=__builtin_amdgcn_mfma_f32_32x32x16_bf16(PAF(0),VFR(0),o[0],0,0,0), C0,0); \
    GAPB(o[1]=__builtin_amdgcn_mfma_f32_32x32x16_bf16(PAF(0),VFR(4),o[1],0,0,0), C0,4); \
    KRD(GL,0); GAPB(o[0]=__builtin_amdgcn_mfma_f32_32x32x16_bf16(PAF(1),VFR(1),o[0],0,0,0), C0,8); \
    KRD(GL,1); GAPB(o[1]=__builtin_amdgcn_mfma_f32_32x32x16_bf16(PAF(1),VFR(5),o[1],0,0,0), C0,12); \
    KRD(GL,2); GAPB(o[0]=__builtin_amdgcn_mfma_f32_32x32x16_bf16(PAF(2),VFR(2),o[0],0,0,0), C1,0); \
    KRD(GL,3); GAPB(o[1]=__builtin_amdgcn_mfma_f32_32x32x16_bf16(PAF(2),VFR(6),o[1],0,0,0), C1,4); \
    GAPB(o[0]=__builtin_amdgcn_mfma_f32_32x32x16_bf16(PAF(3),VFR(3),o[0],0,0,0), C1,8); \
    GAPB(o[1]=__builtin_amdgcn_mfma_f32_32x32x16_bf16(PAF(3),VFR(7),o[1],0,0,0), C1,12); \
    }while(0)
  int t=1;
  #undef CMASK
  #define CMASK(P0,P1,t) do{}while(0)
  for(;t+5<NT;t+=2){
    STEP(pB0,pB1,pA0,pA1,t,true,true,true);     WAIT_BAR(2); RESC(); ROT();
    STEP(pA0,pA1,pB0,pB1,t+1,true,true,true);   WAIT_BAR(2); RESC(); ROT();
  }
  #undef CMASK
  #define CMASK(P0,P1,t) do{int jb_=(t)-(NT-4); if(jb_>=0)cmask(P0,P1,jb_,qrel,hi);}while(0)
  #define ENDW(tt) do{ if((tt)+3<NT){WAIT_BAR(2);} else if((tt)+2<NT){WAIT_BAR(1);} else {WAIT_BAR(0);} }while(0)
  for(;t+1<NT;t+=2){
    STEP(pB0,pB1,pA0,pA1,t,(t+3<NT),(t+1<NT),(t+1<NT));       ENDW(t);   RESC(); ROT();
    STEP(pA0,pA1,pB0,pB1,t+1,(t+4<NT),(t+2<NT),(t+2<NT));     ENDW(t+1); RESC(); ROT();
  }
  STEP(pB0,pB1,pA0,pA1,NT-1,false,false,false); RESC();
  { float sacc=pB0[0]+pB0[1]; _Pragma("unroll") for(int r=2;r<16;++r)sacc+=pB0[r]; _Pragma("unroll") for(int r=0;r<16;++r)sacc+=pB1[r]; l_reg+=sacc;
    pw0=(u32x4){PKW(pB0,0),PKW(pB0,2),PKW(pB0,4),PKW(pB0,6)};pw1=(u32x4){PKW(pB0,8),PKW(pB0,10),PKW(pB0,12),PKW(pB0,14)};pw2=(u32x4){PKW(pB1,0),PKW(pB1,2),PKW(pB1,4),PKW(pB1,6)};pw3=(u32x4){PKW(pB1,8),PKW(pB1,10),PKW(pB1,12),PKW(pB1,14)};
    SBAR(); pv(o,vb0+sl_cur,PAF(0),PAF(1),PAF(2),PAF(3)); }
  #undef PKW
  #undef PAF
  #undef VFR
  #undef PIN
  #undef MX3
  #undef GAPA
  #undef GAPB
  #undef EX
  #undef VRD
  #undef KRD
  #undef STEP
  #undef ENDW
  {auto rr=__builtin_amdgcn_permlane32_swap(__float_as_uint(l_reg),__float_as_uint(l_reg),false,false);l_reg=__uint_as_float(rr[0])+__uint_as_float(rr[1]);}
  if(hi==0)wsf[32+r32]=l_reg;asm volatile("s_waitcnt lgkmcnt(0)":::"memory");
  float rli[16];
  #pragma unroll
  for(int r=0;r<16;++r)rli[r]=__builtin_amdgcn_rcpf(wsf[32+crow(r,hi)]);
  bf16*Ow=O+(rowbase+q0+wid*QBLK)*DM+h*D;
  { bf16*stg=(bf16*)(shm+LDS_OST)+wid*2048;
    #pragma unroll
    for(int r=0;r<16;++r){const int orow=crow(r,hi);
      #pragma unroll
      for(int d0=0;d0<2;++d0)stg[orow*64+d0*32+r32]=__float2bfloat16(o[d0][r]*rli[r]);}
    asm volatile("s_waitcnt lgkmcnt(0)":::"memory");
    #pragma unroll
    for(int i=0;i<4;++i){const int row=i*8+(lane>>3),ch=lane&7; const u32x4 v=*(const u32x4*)(stg+row*64+ch*8); ATTN_STORE16(Ow+(long)row*DM+ch*8,v);} }
  asm volatile("s_waitcnt lgkmcnt(0)\n\ts_barrier":::"memory");
  #undef DMA_K
  #undef DMA_V
  #undef CMASK
  #undef START
  #undef RESC
  #undef ROT
}
constexpr int ATTN_LDS_BYTES=LDS_BYTES;
struct AttnTensors { const bf16* Q; const bf16* K; const bf16* V; bf16* O; };
struct AttnUnit { int bh; int qb; };
struct StaticOrder {
  int vcu;
  __device__ __forceinline__ explicit StaticOrder(int grid,int block):vcu((block%8)*(grid/8)+block/8){}
  __device__ __forceinline__ bool next(int i,AttnUnit&u)const{ if(i>=4)return false; const int s=vcu&7; u.bh=vcu>>3; u.qb=(i==0)?s:(i==1)?15-s:(i==2)?16+s:31-s; return true; }
  __device__ __forceinline__ void a_ready(const AttnUnit&)const{}
  __device__ __forceinline__ void done(const AttnUnit&)const{}
};
template<class Sched,int THRL=8> __device__ __forceinline__ void attn_phase(char*lds,const AttnTensors&T,const Sched&S){
  AttnUnit u;
  for(int i=0;S.next(i,u);++i){ S.a_ready(u); attn_unit<THRL>(u.bh/NHEAD,u.bh%NHEAD,u.qb,T.Q,T.K,T.V,T.O,lds); S.done(u); }
}
#undef SBAR
#undef WAIT_BAR
}
#define XB_TMO      128
#define XB_XCNT(j)  (256  + 64 * (j))
#define XB_XSUB(j)  (1280 + 64 * (j))
#define XB_XGEN(j)  (2304 + 64 * (j))
#define XB_TOP      3328
#define XB_TOPGEN   3392
#define XCD_BAR_WORDS 3456
#define XB_SPIN_CAP (1u << 18)

__device__ __forceinline__ unsigned xb_ld(unsigned* p)              { return __hip_atomic_load(p, __ATOMIC_RELAXED, __HIP_MEMORY_SCOPE_AGENT); }
__device__ __forceinline__ unsigned xb_add(unsigned* p, unsigned v) { return __hip_atomic_fetch_add(p, v, __ATOMIC_RELAXED, __HIP_MEMORY_SCOPE_AGENT); }
__device__ __forceinline__ unsigned xb_xcc_id() { return (unsigned)__builtin_amdgcn_s_getreg((3 << 11) | 20) & 0xFu; }
#define XB_SPIN(cond, bar) do { unsigned _sp = 0; while (cond) { __builtin_amdgcn_s_sleep(1); \
    if ((++_sp & 255u) == 0u) { if (xb_ld(&(bar)[XB_TMO])) break; if (_sp > XB_SPIN_CAP) { atomicAdd(&(bar)[XB_TMO], 1u); break; } } } } while (0)

struct XcdBarrier {
    unsigned* bar; unsigned x;
    volatile LAS unsigned* st;
};

__device__ __forceinline__ XcdBarrier xcd_barrier_post(unsigned* bar, volatile LAS unsigned* st) {
    XcdBarrier b; b.bar = bar; b.x = xb_xcc_id(); b.st = st;
    if (threadIdx.x == 0) (void)xb_add(&bar[XB_XCNT(b.x)], 1u);
    return b;
}
__device__ __forceinline__ void xcd_barrier_complete(unsigned* bar, unsigned x, unsigned& nloc, unsigned& nx) {
    const unsigned G = gridDim.x * gridDim.y * gridDim.z;
    unsigned sum, cnt, mine, sp = 0u;
    for (;;) {
        sum = 0u; cnt = 0u; mine = 0u;
#pragma unroll
        for (unsigned j = 0; j < 16; ++j) { const unsigned c = xb_ld(&bar[XB_XCNT(j)]); sum += c; cnt += (c > 0u) ? 1u : 0u; mine = (j == x) ? c : mine; }
        if (sum == G) break;
        __builtin_amdgcn_s_sleep(1);
        if ((++sp & 255u) == 0u) { if (xb_ld(&bar[XB_TMO])) break; if (sp > XB_SPIN_CAP) { atomicAdd(&bar[XB_TMO], 1u); break; } }
    }
    nloc = mine > 0u ? mine : 1u; nx = cnt > 0u ? cnt : 1u;
}

__device__ __forceinline__ void xcd_barrier(const XcdBarrier& b) {
    asm volatile("s_waitcnt vmcnt(0)" ::: "memory");
    __syncthreads();
    if (threadIdx.x == 0) {
        unsigned* bar = b.bar;
        __builtin_amdgcn_s_waitcnt(0);
        unsigned nloc = b.st[0], nx = b.st[1];
        if (nloc == 0u) { xcd_barrier_complete(bar, b.x, nloc, nx); b.st[0] = nloc; b.st[1] = nx; }
        const unsigned old = xb_add(&bar[XB_XSUB(b.x)], 1u);
        const unsigned gen = old / nloc;
        if (old + 1u == (gen + 1u) * nloc) {
            __builtin_amdgcn_fence(__ATOMIC_RELEASE, "agent");
            asm volatile("s_waitcnt vmcnt(0)" ::: "memory");
            const unsigned og = xb_add(&bar[XB_TOP], 1u);
            const unsigned tg = og / nx;
            if (og + 1u == (tg + 1u) * nx) xb_add(&bar[XB_TOPGEN], 1u);
            else XB_SPIN(xb_ld(&bar[XB_TOPGEN]) == tg, bar);
            __builtin_amdgcn_fence(__ATOMIC_ACQUIRE, "agent");
            xb_add(&bar[XB_XGEN(b.x)], 1u);
            asm volatile("s_waitcnt vmcnt(0)" ::: "memory");
        } else {
            XB_SPIN(xb_ld(&bar[XB_XGEN(b.x)]) == gen, bar);
            __builtin_amdgcn_fence(__ATOMIC_ACQUIRE, "agent");
            asm volatile("s_waitcnt vmcnt(0)" ::: "memory");
        }
    }
    __syncthreads();
}

__device__ __forceinline__ int lane_id_v() { int l; asm volatile("v_mbcnt_lo_u32_b32 %0, -1, 0\n\tv_mbcnt_hi_u32_b32 %0, -1, %0" : "=v"(l)); return l; }
struct Ctx {
    LAS unsigned char* lds; int tid, lane, wave, vcu, G, gw, NGW;
};

__device__ __forceinline__ void tr_item(const float* W, int K, int N, bf16* WT, const float* ksc, int kmask, float kmul, int mode, LAS float* scr, int item, int lane) {
    const int nblk = N / 32, kb = item / nblk, nb = item % nblk, k0 = 64 * kb, n0 = 32 * nb;
#pragma unroll 8
    for (int i = 0; i < 32; ++i) { const int kk = 2 * i + (lane >> 5); const float s = ksc ? ksc[(k0 + kk) & kmask] * kmul : 1.0f; scr[kk * 33 + (lane & 31)] = W[(size_t)(k0 + kk) * N + n0 + (lane & 31)] * s; }
    LDS_WAIT(); asm volatile("" ::: "memory");
    const int c = lane & 7;
#pragma unroll
    for (int j = 0; j < 4; ++j) { const int n = (lane >> 3) + 8 * j; const LAS float* s = scr + (8 * c) * 33 + n;
        u32x4 o; o.x = pk2(s[0 * 33], s[1 * 33]); o.y = pk2(s[2 * 33], s[3 * 33]); o.z = pk2(s[4 * 33], s[5 * 33]); o.w = pk2(s[6 * 33], s[7 * 33]);
        const int nn = n0 + n; const int dr = mode == 0 ? nn : ((nn >> 7) * 256 + (nn & 127) + (mode == 2 ? 128 : 0));
        *(GAS u32x4*)(WT + (size_t)dr * K + k0 + 8 * c) = o; }
    LDS_WAIT(); asm volatile("" ::: "memory");
}

struct Args { const float* in[31]; float* out; unsigned char* ws; int ph_lo, ph_hi; };
#define AS4 __attribute__((address_space(4)))
struct KA { const AS4 char* p;
    __device__ __forceinline__ const float* in(int i) const { return *(const float* const AS4*)(p + 8 * i); }
    __device__ __forceinline__ float* out() const { return *(float* const AS4*)(p + 8 * 31); }
    __device__ __forceinline__ unsigned char* ws() const { return *(unsigned char* const AS4*)(p + 8 * 32); }
    __device__ __forceinline__ int lo() const { return *(const int AS4*)(p + 8 * 33); }
    __device__ __forceinline__ int hi() const { return *(const int AS4*)(p + 8 * 33 + 4); }
};
__device__ __forceinline__ KA ka_get() { const AS4 char* p = (const AS4 char*)__builtin_amdgcn_kernarg_segment_ptr(); asm volatile("" : "+s"(p)); return KA{p}; }

__device__ __forceinline__ void p0_prologue(const Ctx& F, const KA& a) {
    unsigned char* ws = a.ws();
    LAS float* scr = (LAS float*)(F.lds + RING_OFF + F.wave * 16384);
    constexpr int I_IN = (D / 64) * (NIN / 32), I_SQ = (D / 64) * (D / 32), I_PP = (PLE / 64) * (D / 32);
    constexpr int NITEMS = I_IN + 4 * I_SQ + I_PP;
    for (int it = F.gw; it < NITEMS; it += F.NGW) {
        int r = it;
        if (r < I_IN) { tr_item(a.in(3), D, NIN, (bf16*)(ws + WS_WIN), a.in(2), 1023, 1.0f, 0, scr, r, F.lane); continue; } r -= I_IN;
        if (r < I_SQ) { tr_item(a.in(16), D, D, (bf16*)(ws + WS_WA), a.in(8), 127, 1.0f - LAM_INIT, 0, scr, r, F.lane); continue; } r -= I_SQ;
        if (r < I_SQ) { tr_item(a.in(17), D, D, (bf16*)(ws + WS_WL), nullptr, 0, 1.0f, 0, scr, r, F.lane); continue; } r -= I_SQ;
        if (r < I_SQ) { tr_item(a.in(18), D, D, (bf16*)(ws + WS_WO), nullptr, 0, 1.0f, 0, scr, r, F.lane); continue; } r -= I_SQ;
        if (r < I_SQ) { tr_item(a.in(28), D, D, (bf16*)(ws + WS_WPG), a.in(27), 1023, 1.0f, 0, scr, r, F.lane); continue; } r -= I_SQ;
        tr_item(a.in(29), PLE, D, (bf16*)(ws + WS_WPP), nullptr, 0, 1.0f, 0, scr, r, F.lane);
    }
    const int gt = F.gw * 64 + F.lane, NGT = F.NGW * 64;
    { float* Wr = (float*)(ws + WS_WR); const float* gm = a.in(19);
      for (int i = gt; i < 36 * 1024; i += NGT) { const int j = i >> 10, k = i & 1023; const float w = j < 32 ? a.in(22)[(size_t)((j >> 3) * 1024 + k) * 8 + (j & 7)] : a.in(20)[k * 4 + (j - 32)]; Wr[i] = w * gm[k]; } }
    { bf16* Wl = (bf16*)(ws + WS_WLRU);
      for (int i = gt; i < 2 * 65536; i += NGT) { const int gate = i >> 16, n = (i >> 12) & 15, v = (i >> 6) & 63, w = i & 63; const float* src = gate ? a.in(13) : a.in(11); Wl[i] = (bf16)f2bf(src[(n * 64 + w) * 64 + v]); } }
    { const float* x = a.in(0); bf16* xb = (bf16*)(ws + WS_U0); float* rstd0 = (float*)(ws + WS_RSTD0);
      for (int m = F.gw; m < M; m += F.NGW) { const GAS f32x4* xr = (const GAS f32x4*)(x + (size_t)m * D) + F.lane; f32x4 v[4]; float s = 0.f;
#pragma unroll
          for (int j = 0; j < 4; ++j) { v[j] = xr[64 * j]; s += (v[j].x * v[j].x + v[j].y * v[j].y) + (v[j].z * v[j].z + v[j].w * v[j].w); }
          s = wave_sum(s); if (F.lane == 0) rstd0[m] = 1.0f / sqrtf(s * (1.0f / D) + 1e-6f);
          GAS u32x2* o8 = (GAS u32x2*)(xb + (size_t)m * D) + F.lane;
#pragma unroll
          for (int j = 0; j < 4; ++j) o8[64 * j] = (u32x2){pk2(v[j].x, v[j].y), pk2(v[j].z, v[j].w)}; } }
    { const f32x4* p4 = (const f32x4*)a.in(1); u32x2* pb = (u32x2*)(ws + WS_PB);
      for (int i = gt; i < M * PLE / 4; i += NGT) { const f32x4 v = p4[i]; pb[i] = (u32x2){pk2(v.x, v.y), pk2(v.z, v.w)}; } }
}

__device__ __forceinline__ void lru_phase(const Ctx& F, const bf16* xr, bf16* gl, const bf16* Wlru, const float* w_conv, const float* b_conv, const float* b_rg, const float* b_ig, const float* lam, int unit) {
    const int tid = F.tid, lane = F.lane, wave = F.wave, r32 = lane & 31, hi = lane >> 5;
    const int b = unit >> 5, n = (unit >> 1) & 15, half = unit & 1;
    constexpr int XRS = 144;
    LAS unsigned char* XR = F.lds; LAS unsigned char* XC = F.lds + 37376; LAS float* WCV = (LAS float*)(F.lds + 74240); LAS float* WS = (LAS float*)(F.lds + 75776);
    if (tid < 320) { const int j = tid >> 6, c = tid & 63; WCV[tid] = (j < 4) ? w_conv[j * 1024 + 64 * n + c] : b_conv[64 * n + c]; }
    const int oc = 64 * n + 32 * half + r32;
    const float brg = b_rg[oc], big = b_ig[oc];
    const float cdec = -8.0f * log1pf(expf(-lam[oc])) * 1.4426950408889634f;
    bf16x8 BwR[4], BwI[4];
#pragma unroll
    for (int ks = 0; ks < 4; ++ks) { BwR[ks] = *(const bf16x8*)(Wlru + ((size_t)(0 * 16 + n) * 64 + 32 * half + r32) * 64 + 16 * ks + 8 * hi);
                                     BwI[ks] = *(const bf16x8*)(Wlru + ((size_t)(1 * 16 + n) * 64 + 32 * half + r32) * 64 + 16 * ks + 8 * hi); }
    float hc = 0.f;
    const size_t rowb = (size_t)b * SEQ;
    for (int c = 0; c < SEQ / 256; ++c) {
        const int t0 = c * 256;
        for (int idx = tid; idx < 259 * 8; idx += 512) { const int row = idx >> 3, pc = idx & 7, t = t0 - 3 + row; u32x4 v = (u32x4){0u, 0u, 0u, 0u};
            if (t >= 0) v = *(const u32x4*)(xr + (rowb + t) * 1024 + 64 * n + 8 * pc);
            *(LAS u32x4*)(XR + row * XRS + pc * 16) = v; }
        bf16* gp = gl + (rowb + t0 + 32 * wave) * 1024 + oc;
        unsigned short gv[16];
#pragma unroll
        for (int r = 0; r < 16; ++r) gv[r] = gp[(size_t)crow16(r, hi) * 1024];
        __syncthreads();
        const int trow = 32 * wave + r32;
        bf16x8 av8[4];
#pragma unroll
        for (int ks = 0; ks < 4; ++ks) { const int c8 = 16 * ks + 8 * hi;
            f32x4 x0 = *(const LAS f32x4*)(WCV + 256 + c8), x1 = *(const LAS f32x4*)(WCV + 256 + c8 + 4);
#pragma unroll
            for (int j = 0; j < 4; ++j) { const u32x4 xv = *(const LAS u32x4*)(XR + (trow + j) * XRS + c8 * 2);
                const f32x4 w0 = *(const LAS f32x4*)(WCV + j * 64 + c8), w1 = *(const LAS f32x4*)(WCV + j * 64 + c8 + 4);
                x0 += w0 * (f32x4){bflo(xv.x), bfhi(xv.x), bflo(xv.y), bfhi(xv.y)}; x1 += w1 * (f32x4){bflo(xv.z), bfhi(xv.z), bflo(xv.w), bfhi(xv.w)}; }
            const u32x4 pk = (u32x4){pk2(x0[0], x0[1]), pk2(x0[2], x0[3]), pk2(x1[0], x1[1]), pk2(x1[2], x1[3])};
            av8[ks] = __builtin_bit_cast(bf16x8, pk);
            *(LAS u32x4*)(XC + trow * XRS + c8 * 2) = pk; }
        f32x16 aR = {}, aI = {};
#pragma unroll
        for (int ks = 0; ks < 4; ++ks) { aR = __builtin_amdgcn_mfma_f32_32x32x16_bf16(av8[ks], BwR[ks], aR, 0, 0, 0); aI = __builtin_amdgcn_mfma_f32_32x32x16_bf16(av8[ks], BwI[ks], aI, 0, 0, 0); }
        float av[16], uv[16];
#pragma unroll
        for (int r = 0; r < 16; ++r) { const int row = 32 * wave + crow16(r, hi);
            const float xcv = __uint_as_float((unsigned)(*(const LAS unsigned short*)(XC + row * XRS + (32 * half + r32) * 2)) << 16);
            const float rg = sigmoidf_(aR[r] + brg), ig = sigmoidf_(aI[r] + big);
            const float a_ = __builtin_amdgcn_exp2f(cdec * rg); const float mult = sqrtf(fmaxf(1.0f - a_ * a_, 0.f));
            av[r] = a_; uv[r] = mult * ig * xcv; }
        float gA[4], gB[4], pA[4], pB[4];
#pragma unroll
        for (int j = 0; j < 4; ++j) { float A = 1.f, B = 0.f;
#pragma unroll
            for (int i = 0; i < 4; ++i) { B = av[4 * j + i] * B + uv[4 * j + i]; A *= av[4 * j + i]; }
            gA[j] = A; gB[j] = B; pA[j] = __shfl_xor(A, 32); pB[j] = __shfl_xor(B, 32); }
        float AW = 1.f, BW = 0.f;
#pragma unroll
        for (int j = 0; j < 4; ++j) { const float fA = hi ? pA[j] : gA[j], fB = hi ? pB[j] : gB[j], sA = hi ? gA[j] : pA[j], sB = hi ? gB[j] : pB[j];
            BW = fA * BW + fB; AW *= fA; BW = sA * BW + sB; AW *= sA; }
        if (hi == 0) { WS[(wave * 32 + r32) * 2] = AW; WS[(wave * 32 + r32) * 2 + 1] = BW; }
        __syncthreads();
        float h = hc, hin = hc;
#pragma unroll
        for (int w = 0; w < 8; ++w) { const float A = WS[(w * 32 + r32) * 2], B = WS[(w * 32 + r32) * 2 + 1]; h = A * h + B; if (w + 1 == wave) hin = h; }
        hc = h;
        h = hin;
#pragma unroll
        for (int j = 0; j < 4; ++j) { float hh = hi ? pA[j] * h + pB[j] : h;
#pragma unroll
            for (int i = 0; i < 4; ++i) { hh = av[4 * j + i] * hh + uv[4 * j + i]; uv[4 * j + i] = hh; }
            h = hi ? hh : pA[j] * hh + pB[j]; }
#pragma unroll
        for (int r = 0; r < 16; ++r) gp[(size_t)crow16(r, hi) * 1024] = (bf16)f2bf(uv[r] * __uint_as_float((unsigned)gv[r] << 16));
        __syncthreads();
    }
}

__device__ __forceinline__ void p4_combine(const Ctx& F, const KA& a) {
    unsigned char* ws = a.ws();
    float lam;
    { const float s1 = wave_sum(a.in(4)[F.lane] * a.in(5)[F.lane]), s2 = wave_sum(a.in(6)[F.lane] * a.in(7)[F.lane]); lam = expf(s1) - expf(s2) + LAM_INIT; }
    bf16* O1 = (bf16*)(ws + WS_U0); const bf16* O2 = (const bf16*)(ws + WS_U0 + 4 * USZ);
    for (int m = F.gw; m < M; m += F.NGW) {
        const u32x4* p1 = (const u32x4*)(O1 + (size_t)m * D) + 2 * F.lane; const u32x4* p2 = (const u32x4*)(O2 + (size_t)m * D) + 2 * F.lane;
        const u32x4 a0 = p1[0], a1 = p1[1], b0 = p2[0], b1 = p2[1];
        f32x4 o[4], q[4]; pg8::unpack8(a0, o[0], o[1]); pg8::unpack8(a1, o[2], o[3]); pg8::unpack8(b0, q[0], q[1]); pg8::unpack8(b1, q[2], q[3]);
        float ss = 0.f;
#pragma unroll
        for (int j = 0; j < 4; ++j) { o[j] = o[j] - lam * q[j]; ss += (o[j].x * o[j].x + o[j].y * o[j].y) + (o[j].z * o[j].z + o[j].w * o[j].w); }
        ss += __shfl_xor(ss, 1); ss += __shfl_xor(ss, 2); ss += __shfl_xor(ss, 4);
        const float rs = 1.0f / sqrtf(ss * (1.0f / 128.0f) + 1e-5f);
        u32x4 w0, w1; w0 = (u32x4){pk2(o[0].x * rs, o[0].y * rs), pk2(o[0].z * rs, o[0].w * rs), pk2(o[1].x * rs, o[1].y * rs), pk2(o[1].z * rs, o[1].w * rs)};
        w1 = (u32x4){pk2(o[2].x * rs, o[2].y * rs), pk2(o[2].z * rs, o[2].w * rs), pk2(o[3].x * rs, o[3].y * rs), pk2(o[3].z * rs, o[3].w * rs)};
        u32x4* po = (u32x4*)(O1 + (size_t)m * D) + 2 * F.lane; po[0] = w0; po[1] = w1;
    }
    LAS float* scr = (LAS float*)(F.lds + RING_OFF + F.wave * 16384);
    constexpr int I_GU = (D / 64) * (FF / 32), I_DN = (FF / 64) * (D / 32);
    for (int it = F.gw; it < NEXP * (2 * I_GU + I_DN); it += F.NGW) {
        const int e = it / (2 * I_GU + I_DN); int r = it % (2 * I_GU + I_DN);
        if (r < I_GU) { tr_item(a.in(24) + (size_t)e * D * FF, D, FF, (bf16*)(ws + WS_WGU) + (size_t)e * 1024 * 1024, a.in(19), 1023, 1.0f, 1, scr, r, F.lane); continue; } r -= I_GU;
        if (r < I_GU) { tr_item(a.in(25) + (size_t)e * D * FF, D, FF, (bf16*)(ws + WS_WGU) + (size_t)e * 1024 * 1024, a.in(19), 1023, 1.0f, 2, scr, r, F.lane); continue; } r -= I_GU;
        tr_item(a.in(26) + (size_t)e * FF * D, FF, D, (bf16*)(ws + WS_WD) + (size_t)e * 1024 * 512, nullptr, 0, 1.0f, 0, scr, r, F.lane);
    }
}

__device__ __forceinline__ void p7_router(const Ctx& F, const KA& a) {
    unsigned char* ws = a.ws();
    const float* x1 = a.out(); const float* Wr = (const float*)(ws + WS_WR);
    LAS float* WL = (LAS float*)F.lds;
    for (int i = F.tid; i < 36 * 256; i += NWAVES * 64) ((LAS f32x4*)WL)[i] = ((const f32x4*)Wr)[i];
    __syncthreads();
    int* list = (int*)(ws + WS_LIST); unsigned* cnt = (unsigned*)(ws + WS_CTL) + CW_CNT; i32x4* tokinfo = (i32x4*)(ws + WS_TOKINFO);
    const float* bg = a.in(21); const float* bfe = a.in(23);
    for (int m = F.gw; m < M; m += F.NGW) {
        const GAS f32x4* xr = (const GAS f32x4*)(x1 + (size_t)m * D) + F.lane; f32x4 v[4]; float s = 0.f;
#pragma unroll
        for (int j = 0; j < 4; ++j) { v[j] = xr[64 * j]; s += (v[j].x * v[j].x + v[j].y * v[j].y) + (v[j].z * v[j].z + v[j].w * v[j].w); }
        const float rstd = 1.0f / sqrtf(wave_sum(s) * (1.0f / D) + 1e-6f);
        float gl[4];
#pragma unroll
        for (int g = 0; g < 4; ++g) { float d = 0.f;
#pragma unroll
            for (int j = 0; j < 4; ++j) { const f32x4 w = *(const LAS f32x4*)(WL + (32 + g) * 1024 + 4 * F.lane + 256 * j); d += (v[j].x * w.x + v[j].y * w.y) + (v[j].z * w.z + v[j].w * w.w); }
            gl[g] = wave_sum(d) * rstd + bg[g]; }
        int gi = 0; float gmax = gl[0];
#pragma unroll
        for (int g = 1; g < 4; ++g) if (gl[g] > gmax) { gmax = gl[g]; gi = g; }
        float gs = 0.f;
#pragma unroll
        for (int g = 0; g < 4; ++g) gs += expf(gl[g] - gmax);
        const float gw = 1.0f / gs;
        gi = __builtin_amdgcn_readfirstlane(gi);
        float fl[8];
#pragma unroll
        for (int e = 0; e < 8; ++e) { float d = 0.f;
#pragma unroll
            for (int j = 0; j < 4; ++j) { const f32x4 w = *(const LAS f32x4*)(WL + (gi * 8 + e) * 1024 + 4 * F.lane + 256 * j); d += (v[j].x * w.x + v[j].y * w.y) + (v[j].z * w.z + v[j].w * w.w); }
            fl[e] = wave_sum(d) * rstd + bfe[gi * 8 + e]; }
        int i0 = 0; float l0 = fl[0];
#pragma unroll
        for (int e = 1; e < 8; ++e) if (fl[e] > l0) { l0 = fl[e]; i0 = e; }
        int i1 = -1; float l1 = -INFINITY;
#pragma unroll
        for (int e = 0; e < 8; ++e) if (e != i0 && fl[e] > l1) { l1 = fl[e]; i1 = e; }
        const float ex = expf(l1 - l0), w0 = 1.0f / (1.0f + ex), w1 = ex * w0;
        if (F.lane == 0) { const int e0 = gi * 8 + i0, e1 = gi * 8 + i1;
            const int p0 = (int)atomicAdd(cnt + e0, 1u), p1 = (int)atomicAdd(cnt + e1, 1u);
            list[(size_t)e0 * CAP + p0] = m; list[(size_t)e1 * CAP + p1] = m;
            tokinfo[m * 2] = (i32x4){e0, e1, p0, p1}; tokinfo[m * 2 + 1] = (i32x4){__float_as_int(gw * w0), __float_as_int(gw * w1), __float_as_int(rstd), 0}; }
    }
}

__device__ __forceinline__ void moe_tables(const Ctx& F, const unsigned* cnt) {
    LAS int* tp = (LAS int*)(F.lds + CTLL_OFF + 64); LAS int* cn = (LAS int*)(F.lds + CTLL_OFF + 256);
    if (F.tid == 0) { int acc = 0; for (int e = 0; e < NEXP; ++e) { const int c = (int)__hip_atomic_load(cnt + e, RLX_AGENT); cn[e] = c; tp[e] = acc; acc += (c + 255) >> 8; } tp[NEXP] = acc; }
    __syncthreads();
}

__device__ __forceinline__ void p10_combine(const Ctx& F, const KA& a) {
    unsigned char* ws = a.ws();
    const LAS int* tp = (const LAS int*)(F.lds + CTLL_OFF + 64);
    const i32x4* tokinfo = (const i32x4*)(ws + WS_TOKINFO); const bf16* Y = (const bf16*)(ws + WS_Y); bf16* x2b = (bf16*)(ws + WS_U0); float* rstd2 = (float*)(ws + WS_RSTD2);
    for (int m = F.gw; m < M; m += F.NGW) {
        const i32x4 t0 = tokinfo[m * 2];
        const int s0 = tp[t0.x] * 256 + t0.z, s1 = tp[t0.y] * 256 + t0.w;
        GAS f32x4* xr = (GAS f32x4*)(a.out() + (size_t)m * D) + F.lane; const u32x2* y0 = (const u32x2*)(Y + (size_t)s0 * D) + F.lane; const u32x2* y1 = (const u32x2*)(Y + (size_t)s1 * D) + F.lane;
        f32x4 v[4]; float s = 0.f;
#pragma unroll
        for (int j = 0; j < 4; ++j) { const u32x2 p = y0[64 * j], q = y1[64 * j]; v[j] = xr[64 * j];
            v[j].x += bflo(p.x) + bflo(q.x); v[j].y += bfhi(p.x) + bfhi(q.x); v[j].z += bflo(p.y) + bflo(q.y); v[j].w += bfhi(p.y) + bfhi(q.y);
            s += (v[j].x * v[j].x + v[j].y * v[j].y) + (v[j].z * v[j].z + v[j].w * v[j].w); }
        s = wave_sum(s); if (F.lane == 0) rstd2[m] = 1.0f / sqrtf(s * (1.0f / D) + 1e-6f);
        GAS u32x2* o8 = (GAS u32x2*)(x2b + (size_t)m * D) + F.lane;
#pragma unroll
        for (int j = 0; j < 4; ++j) { xr[64 * j] = v[j]; o8[64 * j] = (u32x2){pk2(v[j].x, v[j].y), pk2(v[j].z, v[j].w)}; }
    }
}

__device__ __forceinline__ void p12_final(const Ctx& F, const KA& a) {
    const f32x4* g4 = (const f32x4*)a.in(30);
    for (int m = F.gw; m < M; m += F.NGW) {
        GAS f32x4* xr = (GAS f32x4*)(a.out() + (size_t)m * D) + F.lane; f32x4 v[4]; float s = 0.f;
#pragma unroll
        for (int j = 0; j < 4; ++j) { v[j] = xr[64 * j]; s += (v[j].x * v[j].x + v[j].y * v[j].y) + (v[j].z * v[j].z + v[j].w * v[j].w); }
        const float rs = 1.0f / sqrtf(wave_sum(s) * (1.0f / D) + 1e-6f);
#pragma unroll
        for (int j = 0; j < 4; ++j) xr[64 * j] = v[j] * rs * g4[F.lane + 64 * j];
    }
}

#ifndef MK_N_LAUNCHES
#define MK_N_LAUNCHES 1
#endif
constexpr int NPH = 13;
constexpr int N_LAUNCHES = MK_N_LAUNCHES;

__global__ void __launch_bounds__(NWAVES * 64, 2) mega_fwd(Args args) {
    extern __shared__ __attribute__((aligned(16))) unsigned char lds[];
#define MKCTX() Ctx F; F.lds = (LAS unsigned char*)lds; F.tid = threadIdx.x; F.lane = lane_id_v(); F.wave = __builtin_amdgcn_readfirstlane(F.tid >> 6); \
    F.G = gridDim.x; { const int bx = blockIdx.x; F.vcu = (F.G % 8 == 0) ? (bx % 8) * (F.G / 8) + bx / 8 : bx; } F.gw = F.vcu * NWAVES + F.wave; F.NGW = F.G * NWAVES
    const KA ka0 = ka_get();
    unsigned char* ws = ka0.ws();
    gu32* ctl = (gu32*)(ws + WS_CTL);
    for (int u = threadIdx.x; u < (LDS_BYTES - CTLL_OFF) / 4; u += NWAVES * 64) ((LAS unsigned*)((LAS unsigned char*)lds + CTLL_OFF))[u] = 0u;
    __syncthreads();
    XcdBarrier bar; bar.bar = (unsigned*)ctl + CW_BAR; bar.x = 0; bar.st = nullptr;
    if (N_LAUNCHES == 1) bar = xcd_barrier_post((unsigned*)ctl + CW_BAR, (volatile LAS unsigned*)((LAS unsigned char*)lds + CTLL_OFF));
#define GRID_BAR() do { if (N_LAUNCHES == 1) xcd_barrier(bar); } while (0)
    const int lo = ka0.lo(), hi = ka0.hi();
#define IN(k) (lo <= (k) && (k) < hi)
#define BOTH(k) (IN(k) && IN((k) + 1))
    bf16* U0 = (bf16*)(ws + WS_U0);

    if (IN(0)) { MKCTX(); p0_prologue(F, ka_get()); if (BOTH(0)) GRID_BAR(); }

    if (IN(1)) {
        pg8::DenseOrder S; S.init(ws + WS_U0, ws + WS_WIN, M, NIN, D, gridDim.x, (int)blockIdx.x);
        pg8::EpiIn E{(bf16*)(ws + WS_U0 + 1 * USZ), (const float*)(ws + WS_RSTD0)};
        pg8::gemm_phase<D, pg8::EpiIn, pg8::DenseOrder, false, true>((LAS unsigned char*)lds + RING_OFF, S, E);
        if (BOTH(1)) GRID_BAR();
    }

    if (IN(2)) {
        if ((int)blockIdx.x < 64) { MKCTX(); const KA ka = ka_get();
            lru_phase(F, (const bf16*)(ws + WS_U0 + 4 * USZ), (bf16*)(ws + WS_U0 + 5 * USZ), (const bf16*)(ws + WS_WLRU), ka.in(9), ka.in(10), ka.in(12), ka.in(14), ka.in(15), (int)blockIdx.x); }
        if (BOTH(2)) GRID_BAR();
    }

    if (IN(3)) {
        const bf16* Q = (const bf16*)(ws + WS_U0 + 1 * USZ); const bf16* Kb = (const bf16*)(ws + WS_U0 + 2 * USZ); const bf16* Vb = (const bf16*)(ws + WS_U0 + 3 * USZ);
        bf16* O1 = (bf16*)(ws + WS_U0); bf16* O2 = (bf16*)(ws + WS_U0 + 4 * USZ);
        const int G = gridDim.x, bx = blockIdx.x, vcu = (G % 8 == 0) ? (bx % 8) * (G / 8) + bx / 8 : bx;
        for (int k = vcu; k < 2048; k += G) {
            const int v = k & 255, i = k >> 8, s = v & 7, bh = (v >> 3) + 32 * (i >> 2), j = i & 3;
            const int qb = (j == 0) ? s : (j == 1) ? 15 - s : (j == 2) ? 16 + s : 31 - s;
            const int b = bh >> 5, vu = bh & 31, h = vu >> 2, c = (vu >> 1) & 1, vh = vu & 1;
            attn_body::attn_unit<8>(b, 0, qb, (const attn_body::bf16*)(Q + 128 * h + 64 * c), (const attn_body::bf16*)(Kb + 128 * h + 64 * c), (const attn_body::bf16*)(Vb + 128 * h + 64 * vh),
                                    (attn_body::bf16*)((c ? O2 : O1) + 128 * h + 64 * vh), (char*)lds + RING_OFF);
        }
        if (BOTH(3)) GRID_BAR();
    }

    if (IN(4)) { MKCTX(); p4_combine(F, ka_get()); if (BOTH(4)) GRID_BAR(); }

    if (IN(5)) {
        bf16* mixed = (bf16*)(ws + WS_U0 + 4 * USZ);
        { pg8::DenseOrder S; S.init(ws + WS_U0, ws + WS_WA, M, D, D, gridDim.x, (int)blockIdx.x);
          pg8::EpiMix<true> E{mixed, (const bf16*)(ws + WS_U0 + 6 * USZ)};
          pg8::gemm_phase<D, pg8::EpiMix<true>, pg8::DenseOrder, false, false>((LAS unsigned char*)lds + RING_OFF, S, E); }
        { pg8::DenseOrder S; S.init(ws + WS_U0 + 5 * USZ, ws + WS_WL, M, D, D, gridDim.x, (int)blockIdx.x);
          pg8::EpiMix<false> E{mixed, (const bf16*)(ws + WS_U0 + 7 * USZ)};
          pg8::gemm_phase<D, pg8::EpiMix<false>, pg8::DenseOrder, false, false>((LAS unsigned char*)lds + RING_OFF, S, E); }
        if (BOTH(5)) GRID_BAR();
    }

    if (IN(6)) {
        pg8::DenseOrder S; S.init(ws + WS_U0 + 4 * USZ, ws + WS_WO, M, D, D, gridDim.x, (int)blockIdx.x);
        const KA ka = ka_get(); pg8::EpiOut E{ka.in(0), ka.out(), U0};
        pg8::gemm_phase<D, pg8::EpiOut, pg8::DenseOrder, false, false>((LAS unsigned char*)lds + RING_OFF, S, E);
        if (BOTH(6)) GRID_BAR();
    }

    if (IN(7)) { MKCTX(); p7_router(F, ka_get()); if (BOTH(7)) GRID_BAR(); }

    if (IN(8)) {
        { MKCTX(); moe_tables(F, (const unsigned*)ctl + CW_CNT);
        pg8::MoeOrder<true> S{(const char*)U0, (const char*)(ws + WS_WGU), (size_t)1024 * 1024 * 2, D, F.G, F.vcu, (const LAS int*)(F.lds + CTLL_OFF + 64), (const LAS int*)(F.lds + CTLL_OFF + 256), (const int*)(ws + WS_LIST)};
        pg8::EpiGU E{(bf16*)(ws + WS_HID), (const int*)(ws + WS_LIST), (const i32x4*)(ws + WS_TOKINFO)};
        pg8::gemm_phase<D, pg8::EpiGU, pg8::MoeOrder<true>, true, false>(F.lds + RING_OFF, S, E); }
        if (BOTH(8)) GRID_BAR();
    }

    if (IN(9)) {
        { MKCTX(); moe_tables(F, (const unsigned*)ctl + CW_CNT);
        pg8::MoeOrder<false> S{(const char*)(ws + WS_HID), (const char*)(ws + WS_WD), (size_t)1024 * 512 * 2, FF, F.G, F.vcu, (const LAS int*)(F.lds + CTLL_OFF + 64), (const LAS int*)(F.lds + CTLL_OFF + 256), (const int*)(ws + WS_LIST)};
        pg8::EpiBf E{(bf16*)(ws + WS_Y), D};
        pg8::gemm_phase<FF, pg8::EpiBf, pg8::MoeOrder<false>, false, false>(F.lds + RING_OFF, S, E); }
        if (BOTH(9)) GRID_BAR();
    }

    if (IN(10)) { MKCTX(); moe_tables(F, (const unsigned*)ctl + CW_CNT); p10_combine(F, ka_get()); if (BOTH(10)) GRID_BAR(); }

    if (IN(11)) {
        { pg8::DenseOrder S; S.init(ws + WS_PB, ws + WS_WPP, M, D, PLE, gridDim.x, (int)blockIdx.x);
          pg8::EpiBf E{(bf16*)(ws + WS_PROJ), D};
          pg8::gemm_phase<PLE, pg8::EpiBf, pg8::DenseOrder, false, false>((LAS unsigned char*)lds + RING_OFF, S, E); }
        { pg8::DenseOrder S; S.init(ws + WS_U0, ws + WS_WPG, M, D, D, gridDim.x, (int)blockIdx.x);
          const KA ka = ka_get(); pg8::EpiPle E{ka.out(), (const bf16*)(ws + WS_PROJ), (const float*)(ws + WS_RSTD2)};
          pg8::gemm_phase<D, pg8::EpiPle, pg8::DenseOrder, false, false>((LAS unsigned char*)lds + RING_OFF, S, E); }
        if (BOTH(11)) GRID_BAR();
    }

    if (IN(12)) { MKCTX(); p12_final(F, ka_get()); }
#undef IN
#undef BOTH
}

extern "C" void kernel_launch(void* const* d_in, const int* in_sizes, int n_in, void* d_out, int out_size, void* d_ws, size_t ws_size, hipStream_t stream) {
    static int grid = 0;
    if (grid == 0) {
        if (n_in != 31 || in_sizes[0] != M * D || out_size != M * D || ws_size < WS_END) { fprintf(stderr, "kernel_launch: unexpected shapes (n_in %d, in0 %d, out %d, ws %zu < %zu); nothing launched\n", n_in, n_in > 0 ? in_sizes[0] : -1, out_size, ws_size, (size_t)WS_END); grid = -1; return; }
        int dev = 0, cus = 0, per_cu = 0;
        if (hipGetDevice(&dev) != hipSuccess || hipDeviceGetAttribute(&cus, hipDeviceAttributeMultiprocessorCount, dev) != hipSuccess) { grid = -1; return; }
        if (hipFuncSetAttribute((const void*)mega_fwd, hipFuncAttributeMaxDynamicSharedMemorySize, LDS_BYTES) != hipSuccess) { fprintf(stderr, "kernel_launch: hipFuncSetAttribute failed\n"); grid = -1; return; }
        if (hipOccupancyMaxActiveBlocksPerMultiprocessor(&per_cu, (const void*)mega_fwd, NWAVES * 64, LDS_BYTES) != hipSuccess || per_cu < 1)
            fprintf(stderr, "kernel_launch: note: occupancy query reports %d workgroups per CU\n", per_cu);
        (void)hipGetLastError();
        grid = cus;
    }
    if (grid < 0) return;
    if (hipMemsetAsync((char*)d_ws + WS_CTL, 0, CTL_ZERO_BYTES, stream) != hipSuccess) return;
    Args a{};
    for (int i = 0; i < 31; ++i) a.in[i] = (const float*)d_in[i];
    a.out = (float*)d_out; a.ws = (unsigned char*)d_ws;
    for (int li = 0; li < N_LAUNCHES; ++li) {
        a.ph_lo = (N_LAUNCHES == 1) ? 0 : li; a.ph_hi = (N_LAUNCHES == 1) ? NPH : li + 1;
        hipLaunchKernelGGL(mega_fwd, dim3(grid), dim3(NWAVES * 64), LDS_BYTES, stream, a);
        const hipError_t le = hipPeekAtLastError();
        if (le != hipSuccess) { fprintf(stderr, "kernel_launch: launch %d failed: %s\n", li, hipGetErrorName(le)); break; }
    }
}
```

```cpp
#include <hip/hip_runtime.h>
#include <hip/hip_bf16.h>
#include <cstdio>
#include <cstdint>
#include <cmath>

#define LAS __attribute__((address_space(3)))
#define GAS __attribute__((address_space(1)))
typedef unsigned short bf16;
typedef short bf16x8 __attribute__((ext_vector_type(8)));
typedef float f32x4 __attribute__((ext_vector_type(4)));
typedef float f32x2 __attribute__((ext_vector_type(2)));
typedef float f32x16 __attribute__((ext_vector_type(16)));
typedef unsigned u32x4 __attribute__((ext_vector_type(4)));
typedef unsigned u32x2 __attribute__((ext_vector_type(2)));
typedef int i32x4 __attribute__((ext_vector_type(4)));
typedef GAS unsigned gu32;

constexpr int M = 16384, D = 1024, SEQ = 8192, NBATCH = 2, NIN = 7168, PLE = 256, NEXP = 32, FF = 512, CAP = 16384;
constexpr float C2 = 0.125f * 1.4426950408889634f;
constexpr float LAM_INIT = 0.2f;

constexpr size_t MiB = 1u << 20;
constexpr size_t WS_CTL = 0, CTL_ZERO_BYTES = 64 * 1024;
constexpr size_t WS_RSTD0 = 1 * MiB, WS_RSTD2 = 1 * MiB + 65536, WS_TOKINFO = 1 * MiB + 131072;
constexpr size_t WS_SUMM = 1 * MiB + 655360;
constexpr size_t WS_WR = 2 * MiB, WS_WLRU = 2 * MiB + 262144;
constexpr size_t WS_LIST = 4 * MiB;
constexpr size_t WS_WIN = 8 * MiB, WS_WA = 22 * MiB, WS_WL = 24 * MiB, WS_WO = 26 * MiB, WS_WPG = 28 * MiB, WS_WPP = 30 * MiB;
constexpr size_t WS_U0 = 32 * MiB, USZ = 32 * MiB;
constexpr size_t WS_WGU = WS_U0 + 1 * USZ, WS_WD = WS_U0 + 3 * USZ;
constexpr size_t WS_Y = WS_U0 + 4 * USZ;
constexpr size_t WS_HID = 246 * MiB, WS_PROJ = 246 * MiB;
constexpr size_t WS_PB = 288 * MiB, WS_END = 296 * MiB;
constexpr int CW_TMO = 0, CW_CODE = 1, CW_BAR = 1024, CW_CNT = 8192;

constexpr int RING_OFF = 0, RING_BYTES = 131072, AUX_OFF = 131072, CTLL_OFF = 147456, LDS_BYTES = 149504;
constexpr int NWAVES = 8;

#define RLX_AGENT __ATOMIC_RELAXED, __HIP_MEMORY_SCOPE_AGENT
#define LDS_WAIT() asm volatile("s_waitcnt lgkmcnt(0)" ::: "memory")
#define VM_WAIT() asm volatile("s_waitcnt vmcnt(0)" ::: "memory")
__device__ __forceinline__ unsigned f2bf(float f) { unsigned u = __builtin_bit_cast(unsigned, f); return (u + 0x7fffu + ((u >> 16) & 1u)) >> 16; }
__device__ __forceinline__ unsigned pk2(float lo, float hi) { return f2bf(lo) | (f2bf(hi) << 16); }
__device__ __forceinline__ float bflo(unsigned w) { return __uint_as_float(w << 16); }
__device__ __forceinline__ float bfhi(unsigned w) { return __uint_as_float(w & 0xffff0000u); }
__device__ __forceinline__ float sigmoidf_(float v) { return __builtin_amdgcn_rcpf(1.0f + __builtin_amdgcn_exp2f(-1.4426950408889634f * v)); }
__device__ __forceinline__ float gelu_tanh(float v) { return v * __builtin_amdgcn_rcpf(1.0f + __builtin_amdgcn_exp2f(-2.3022082f * v * (1.0f + 0.044715f * v * v))); }
__device__ __forceinline__ float wave_sum(float v) {
#pragma unroll
    for (int o = 1; o < 64; o <<= 1) v += __shfl_xor(v, o);
    return v;
}
__device__ __forceinline__ int crow16(int r, int hi) { return (r & 3) + 8 * (r >> 2) + 4 * hi; }

namespace pg8 {
constexpr int BM = 256, BK = 64, HALF = 128, HTB = HALF * BK * 2, NXCD = 8, WGM = 8;
__host__ __device__ __forceinline__ int lds_byte(int r, int c) { const int st = (r >> 4) * 2 + (c >> 5), rr = r & 15, cc = c & 31, ob = rr * 64 + cc * 2; return st * 1024 + (ob ^ (((ob >> 9) & 1) << 5)); }
__host__ __device__ __forceinline__ void stage_rc(int b, int& R, int& C) { const int st = b / 1024, sb = b % 1024, swz = sb ^ (((sb >> 9) & 1) << 5); R = (st >> 1) * 16 + swz / 64; C = (st & 1) * 32 + (swz % 64) / 2; }
__host__ __device__ __forceinline__ int perm32(int rho) { const int n = rho >> 4, i = rho & 15; return 8 * (i >> 2) + 4 * n + (i & 3); }

struct Unit { int pm, pn, e, nv, r0; const char* a; const char* b; };

struct DenseOrder {
    const char* A; const char* Bt; int K, nM, nN, nwg, G, c;
    __device__ __forceinline__ void init(const void* A_, const void* Bt_, int M_, int N_, int K_, int G_, int c_) { A = (const char*)A_; Bt = (const char*)Bt_; K = K_; nM = M_ / BM; nN = N_ / BM; nwg = nM * nN; G = G_; c = c_; }
    __device__ __forceinline__ bool next(int i, Unit& u) const {
        const long L = (long)i * G + c; if (L >= nwg) return false;
        int wgid = (int)L; { const int q = nwg / NXCD, r = nwg % NXCD, xcd = wgid % NXCD, off = wgid / NXCD; wgid = (xcd < r ? xcd * (q + 1) : r * (q + 1) + (xcd - r) * q) + off; }
        const int nig = WGM * nN, gid = wgid / nig, fm = gid * WGM, gsz = (nM - fm) < WGM ? (nM - fm) : WGM;
        u.pm = fm + ((wgid % nig) % gsz); u.pn = (wgid % nig) / gsz; u.e = 0; u.nv = BM; u.r0 = 0;
        u.a = A + (size_t)u.pm * BM * K * 2; u.b = Bt + (size_t)u.pn * BM * K * 2; return true;
    }
    __device__ __forceinline__ void rows(const Unit&, const int (&R)[2], const int (&C)[2], unsigned (&ra)[2][2]) const {
#pragma unroll
        for (int h = 0; h < 2; ++h)
#pragma unroll
            for (int i = 0; i < 2; ++i) ra[h][i] = (unsigned)(((h * HALF + R[i]) * K + C[i]) * 2);
    }
};
template <bool GATHER> struct MoeOrder {
    const char* A; const char* Bt; size_t bstride; int K, G, c; const LAS int* tp; const LAS int* cnt; const int* list;
    __device__ __forceinline__ bool next(int i, Unit& u) const {
        const int L = i * G + c; const int T = __builtin_amdgcn_readfirstlane(tp[NEXP]) * 4; if (L >= T) return false;
        const int rt = L >> 2; int e = 0;
        while (e < NEXP - 1 && __builtin_amdgcn_readfirstlane(tp[e + 1]) <= rt) ++e;
        const int lt = rt - __builtin_amdgcn_readfirstlane(tp[e]); const int rem = __builtin_amdgcn_readfirstlane(cnt[e]) - lt * BM;
        u.pm = rt; u.pn = L & 3; u.e = e; u.nv = rem < BM ? rem : BM; u.r0 = lt * BM;
        u.a = GATHER ? A : A + (size_t)rt * BM * K * 2; u.b = Bt + (size_t)e * bstride + (size_t)u.pn * BM * K * 2; return true;
    }
    __device__ __forceinline__ void rows(const Unit& u, const int (&R)[2], const int (&C)[2], unsigned (&ra)[2][2]) const {
#pragma unroll
        for (int h = 0; h < 2; ++h)
#pragma unroll
            for (int i = 0; i < 2; ++i) {
                if (GATHER) { const int lr = h * HALF + R[i]; const int tok = list[(size_t)u.e * CAP + u.r0 + (lr < u.nv ? lr : 0)]; ra[h][i] = (unsigned)((tok * K + C[i]) * 2); }
                else ra[h][i] = (unsigned)(((h * HALF + R[i]) * K + C[i]) * 2);
            }
    }
};

template <int K, class Epi, class Sched, bool GATHER, bool ALIGN_EPI>
__device__ __forceinline__ void gemm_phase(LAS unsigned char* lds, const Sched& S, const Epi& E) {
    const int tid = threadIdx.x, wid = __builtin_amdgcn_readfirstlane(tid >> 6), lane = tid & 63, wr = wid >> 2, wc = wid & 3, fr = lane & 15, fq = lane >> 4;
    constexpr int nt = K / BK;
    int R[2], C[2]; unsigned voffB[2];
#pragma unroll
    for (int i = 0; i < 2; ++i) { stage_rc(tid * 16 + i * 8192, R[i], C[i]); const int Rb = Epi::PERM ? ((R[i] & ~31) + perm32(R[i] & 31)) : R[i]; voffB[i] = (unsigned)(Rb * K + C[i]) * 2u; }
    constexpr size_t kstep = (size_t)(BK * 2);
    constexpr size_t hstepB = (size_t)HALF * K * 2;
    const unsigned ldsw = (unsigned)wid * 1024u;
    const int aoff = lds_byte(wr * 64 + fr, fq * 8), boff = lds_byte(wc * 32 + fr, fq * 8);
#define PG8_SA(b, h) (((b) * 2 + (h)) * HTB)
#define PG8_SB(b, h) ((4 + (b) * 2 + (h)) * HTB)
#define PG8_STAGE_B(bufoff, gbase) do { _Pragma("unroll") for (int _i = 0; _i < 2; ++_i) \
        __builtin_amdgcn_global_load_lds((const unsigned*)((const char*)(gbase) + voffB[_i]), (LAS unsigned*)(lds + (bufoff) + ldsw + _i * 8192), 16, 0, 0); } while (0)
#define PG8_STAGE_A(bufoff, gbase, va, h) do { _Pragma("unroll") for (int _i = 0; _i < 2; ++_i) \
        __builtin_amdgcn_global_load_lds((const unsigned*)((const char*)(gbase) + (va)[h][_i]), (LAS unsigned*)(lds + (bufoff) + ldsw + _i * 8192), 16, 0, 0); } while (0)
#define PG8_LDA(dst, b, h) do { _Pragma("unroll") for (int m = 0; m < 4; ++m) _Pragma("unroll") for (int k = 0; k < 2; ++k) dst[m][k] = *(const LAS bf16x8*)(lds + PG8_SA(b, h) + aoff + m * 2048 + k * 1024); } while (0)
#define PG8_LDB(dst, b, h) do { _Pragma("unroll") for (int n = 0; n < 2; ++n) _Pragma("unroll") for (int k = 0; k < 2; ++k) dst[n][k] = *(const LAS bf16x8*)(lds + PG8_SB(b, h) + boff + n * 2048 + k * 1024); } while (0)
#define PG8_MMA(ai, bj, At, Bt) do { __builtin_amdgcn_s_setprio(1); _Pragma("unroll") for (int m = 0; m < 4; ++m) _Pragma("unroll") for (int n = 0; n < 2; ++n) _Pragma("unroll") for (int k = 0; k < 2; ++k) \
        acc[ai][bj][m][n] = __builtin_amdgcn_mfma_f32_16x16x32_bf16(Bt[n][k], At[m][k], acc[ai][bj][m][n], 0, 0, 0); __builtin_amdgcn_s_setprio(0); } while (0)
#define PG8_WAIT_V(n) asm volatile("s_waitcnt vmcnt(" #n ")" ::: "memory")
#define PG8_WAIT_L(n) asm volatile("s_waitcnt lgkmcnt(" #n ")" ::: "memory")
#define PG8_BAR __builtin_amdgcn_s_barrier()
#define PG8_SCHED __builtin_amdgcn_sched_barrier(0)
    Unit cur, nxt; int ui = 0;
    if (!S.next(0, cur)) return;
    unsigned vAc[2][2], vAn[2][2];
    S.rows(cur, R, C, vAc);
    f32x4 acc[2][2][4][2];
#pragma unroll
    for (int a = 0; a < 2; ++a)
#pragma unroll
        for (int b = 0; b < 2; ++b)
#pragma unroll
            for (int m = 0; m < 4; ++m)
#pragma unroll
                for (int n = 0; n < 2; ++n) acc[a][b][m][n] = (f32x4){0.f, 0.f, 0.f, 0.f};
    bf16x8 At[4][2], B0[2][2], B1[2][2];
    const char* cA = cur.a; const char* cB = cur.b;
    PG8_STAGE_B(PG8_SB(0, 0), cB); PG8_STAGE_B(PG8_SB(0, 1), cB + hstepB); PG8_STAGE_A(PG8_SA(0, 0), cA, vAc, 0); PG8_STAGE_A(PG8_SA(0, 1), cA, vAc, 1);
    if (wr == 1) PG8_BAR;
    PG8_WAIT_V(2); PG8_BAR;
    PG8_STAGE_B(PG8_SB(1, 0), cB + kstep); PG8_STAGE_A(PG8_SA(1, 0), cA + kstep, vAc, 0); PG8_STAGE_B(PG8_SB(1, 1), cB + hstepB + kstep);
    PG8_WAIT_V(6); PG8_BAR;
    for (;;) {
        const bool has_next = S.next(ui + 1, nxt);
        if (GATHER) { if (has_next) S.rows(nxt, R, C, vAn); else {
#pragma unroll
            for (int h = 0; h < 2; ++h)
#pragma unroll
                for (int i = 0; i < 2; ++i) vAn[h][i] = vAc[h][i]; } }
        const char* nA = has_next ? nxt.a : cA; const char* nB = has_next ? nxt.b : cB;
        for (int t = 0; t < nt; t += 2) {
            const bool last = (t == nt - 2);
            const char* a1 = cA + (size_t)(t + 1) * kstep;
            const char* a2 = last ? nA : cA + (size_t)(t + 2) * kstep; const char* b2 = last ? nB : cB + (size_t)(t + 2) * kstep;
            const char* a3 = a2 + kstep; const char* b3 = b2 + kstep;
            unsigned va2[2][2];
#pragma unroll
            for (int h = 0; h < 2; ++h)
#pragma unroll
                for (int i = 0; i < 2; ++i) va2[h][i] = (GATHER && last) ? vAn[h][i] : vAc[h][i];
            PG8_LDB(B0, 0, 0); PG8_LDB(B1, 0, 1); PG8_SCHED; PG8_LDA(At, 0, 0); PG8_STAGE_A(PG8_SA(1, 1), a1, vAc, 1);
            PG8_WAIT_V(8); PG8_WAIT_L(0); PG8_BAR; PG8_MMA(0, 0, At, B0); PG8_MMA(0, 1, At, B1); PG8_BAR; PG8_SCHED;
            PG8_LDA(At, 0, 1); PG8_STAGE_B(PG8_SB(0, 0), b2); PG8_STAGE_B(PG8_SB(0, 1), b2 + hstepB); PG8_STAGE_A(PG8_SA(0, 0), a2, va2, 0);
            PG8_WAIT_V(8); PG8_WAIT_L(0); PG8_BAR; PG8_MMA(1, 0, At, B0); PG8_MMA(1, 1, At, B1); PG8_BAR; PG8_SCHED;
            PG8_LDB(B0, 1, 0); PG8_LDB(B1, 1, 1); PG8_SCHED; PG8_LDA(At, 1, 0); PG8_STAGE_A(PG8_SA(0, 1), a2, va2, 1);
            PG8_WAIT_V(8); PG8_WAIT_L(0); PG8_BAR; PG8_MMA(0, 0, At, B0); PG8_MMA(0, 1, At, B1); PG8_BAR; PG8_SCHED;
            PG8_LDA(At, 1, 1); PG8_STAGE_B(PG8_SB(1, 0), b3); PG8_STAGE_B(PG8_SB(1, 1), b3 + hstepB); PG8_STAGE_A(PG8_SA(1, 0), a3, va2, 0);
            PG8_WAIT_V(8); PG8_WAIT_L(0); PG8_BAR; PG8_MMA(1, 0, At, B0); PG8_MMA(1, 1, At, B1); PG8_BAR; PG8_SCHED;
        }
        if constexpr (ALIGN_EPI) { if (wr == 0) PG8_BAR; }
        E(acc, cur, wr, wc, fr, fq);
        if (!has_next) break;
#pragma unroll
        for (int a = 0; a < 2; ++a)
#pragma unroll
            for (int b = 0; b < 2; ++b)
#pragma unroll
                for (int m = 0; m < 4; ++m)
#pragma unroll
                    for (int n = 0; n < 2; ++n) acc[a][b][m][n] = (f32x4){0.f, 0.f, 0.f, 0.f};
        cur = nxt; cA = nA; cB = nB; ++ui;
        if (GATHER) {
#pragma unroll
            for (int h = 0; h < 2; ++h)
#pragma unroll
                for (int i = 0; i < 2; ++i) vAc[h][i] = vAn[h][i]; }
        if constexpr (ALIGN_EPI) { if (wr == 1) PG8_BAR; }
    }
    PG8_WAIT_V(0);
    if constexpr (!ALIGN_EPI) { if (wr == 0) PG8_BAR; }
    PG8_BAR;
#undef PG8_SA
#undef PG8_SB
#undef PG8_STAGE_A
#undef PG8_STAGE_B
#undef PG8_LDA
#undef PG8_LDB
#undef PG8_MMA
#undef PG8_WAIT_V
#undef PG8_WAIT_L
#undef PG8_BAR
#undef PG8_SCHED
}

__device__ __forceinline__ unsigned cvt_pk_bf16(float lo, float hi) { unsigned r; asm volatile("v_cvt_pk_bf16_f32 %0, %1, %2" : "=v"(r) : "v"(lo), "v"(hi)); return r; }
__device__ __forceinline__ u32x4 pack8(const f32x4& v0, const f32x4& v1) { u32x4 w; w.x = cvt_pk_bf16(v0[0], v0[1]); w.y = cvt_pk_bf16(v0[2], v0[3]); w.z = cvt_pk_bf16(v1[0], v1[1]); w.w = cvt_pk_bf16(v1[2], v1[3]); return w; }
__device__ __forceinline__ void unpack8(const u32x4& w, f32x4& v0, f32x4& v1) { v0 = (f32x4){bflo(w.x), bfhi(w.x), bflo(w.y), bfhi(w.y)}; v1 = (f32x4){bflo(w.z), bfhi(w.z), bflo(w.w), bfhi(w.w)}; }
__device__ __forceinline__ u32x4 ld16_sc1(const void* p) { u32x4 v; asm volatile("global_load_dwordx4 %0, %1, off sc1\n\ts_waitcnt vmcnt(0)" : "=v"(v) : "v"(p) : "memory"); return v; }

__device__ __forceinline__ u32x4 ld16_sc1_nw(const void* p) { u32x4 v; asm volatile("global_load_dwordx4 %0, %1, off sc1" : "=v"(v) : "v"(p) : "memory"); return v; }
__device__ __forceinline__ void wait8(u32x4 (&v)[4][2]) { asm volatile("s_waitcnt vmcnt(0)" : "+v"(v[0][0]), "+v"(v[0][1]), "+v"(v[1][0]), "+v"(v[1][1]), "+v"(v[2][0]), "+v"(v[2][1]), "+v"(v[3][0]), "+v"(v[3][1]) :: "memory"); }
struct EpiIn {
    static constexpr bool PERM = true;
    bf16* base; const float* rstd;
    __device__ __forceinline__ void operator()(const f32x4 (&acc)[2][2][4][2], const Unit& u, int wr, int wc, int fr, int fq) const {
        const int t = u.pn >> 2; bf16* O = base + (size_t)t * M * 1024;
        const int row0 = u.pm * BM + wr * 64 + fr, col0 = (u.pn & 3) * BM + wc * 32 + 8 * fq;
        float rs[2][4];
#pragma unroll
        for (int ai = 0; ai < 2; ++ai)
#pragma unroll
            for (int m = 0; m < 4; ++m) rs[ai][m] = rstd[row0 + ai * HALF + m * 16] * (t == 0 ? C2 : 1.0f);
#pragma unroll
        for (int ai = 0; ai < 2; ++ai)
#pragma unroll
            for (int m = 0; m < 4; ++m) { bf16* rowp = O + (size_t)(row0 + ai * HALF + m * 16) * 1024 + col0;
#pragma unroll
                for (int bj = 0; bj < 2; ++bj) { f32x4 v0 = acc[ai][bj][m][0] * rs[ai][m], v1 = acc[ai][bj][m][1] * rs[ai][m];
                    if (t == 4) {
#pragma unroll
                        for (int q = 0; q < 4; ++q) { v0[q] = gelu_tanh(v0[q]); v1[q] = gelu_tanh(v1[q]); } }
                    else if (t >= 5) {
#pragma unroll
                        for (int q = 0; q < 4; ++q) { v0[q] = sigmoidf_(v0[q]); v1[q] = sigmoidf_(v1[q]); } }
                    *(u32x4*)(rowp + bj * HALF) = pack8(v0, v1); } }
    }
};
struct EpiBf {
    static constexpr bool PERM = true;
    bf16* O; int ldc;
    __device__ __forceinline__ void operator()(const f32x4 (&acc)[2][2][4][2], const Unit& u, int wr, int wc, int fr, int fq) const {
        const int row0 = u.pm * BM + wr * 64 + fr, col0 = u.pn * BM + wc * 32 + 8 * fq;
#pragma unroll
        for (int ai = 0; ai < 2; ++ai)
#pragma unroll
            for (int m = 0; m < 4; ++m) { bf16* rowp = O + (size_t)(row0 + ai * HALF + m * 16) * ldc + col0;
#pragma unroll
                for (int bj = 0; bj < 2; ++bj) *(u32x4*)(rowp + bj * HALF) = pack8(acc[ai][bj][m][0], acc[ai][bj][m][1]); }
    }
};
template <bool FIRST> struct EpiMix {
    static constexpr bool PERM = true;
    bf16* mixed; const bf16* gate;
    __device__ __forceinline__ void operator()(const f32x4 (&acc)[2][2][4][2], const Unit& u, int wr, int wc, int fr, int fq) const {
        const int row0 = u.pm * BM + wr * 64 + fr, col0 = u.pn * BM + wc * 32 + 8 * fq;
#pragma unroll
        for (int ai = 0; ai < 2; ++ai) {
            u32x4 pw[4][2], gw[4][2];
#pragma unroll
            for (int m = 0; m < 4; ++m)
#pragma unroll
                for (int bj = 0; bj < 2; ++bj) { const size_t ro = (size_t)(row0 + ai * HALF + m * 16) * 1024 + col0 + bj * HALF; gw[m][bj] = *(const u32x4*)(gate + ro); if (!FIRST) pw[m][bj] = ld16_sc1_nw(mixed + ro); }
            if (!FIRST) wait8(pw);
#pragma unroll
            for (int m = 0; m < 4; ++m)
#pragma unroll
                for (int bj = 0; bj < 2; ++bj) { const size_t ro = (size_t)(row0 + ai * HALF + m * 16) * 1024 + col0 + bj * HALF; f32x4 g0, g1; unpack8(gw[m][bj], g0, g1);
                    f32x4 v0 = acc[ai][bj][m][0] * g0, v1 = acc[ai][bj][m][1] * g1;
                    if (!FIRST) { f32x4 p0, p1; unpack8(pw[m][bj], p0, p1); v0 += p0; v1 += p1; }
                    *(u32x4*)(mixed + ro) = pack8(v0, v1); }
        }
    }
};
struct EpiOut {
    static constexpr bool PERM = true;
    const float* x; float* out; bf16* xb;
    __device__ __forceinline__ void operator()(const f32x4 (&acc)[2][2][4][2], const Unit& u, int wr, int wc, int fr, int fq) const {
        const int row0 = u.pm * BM + wr * 64 + fr, col0 = u.pn * BM + wc * 32 + 8 * fq;
#pragma unroll
        for (int ai = 0; ai < 2; ++ai)
#pragma unroll
            for (int m = 0; m < 4; ++m) { const size_t ro = (size_t)(row0 + ai * HALF + m * 16) * 1024 + col0;
#pragma unroll
                for (int bj = 0; bj < 2; ++bj) { const f32x4 x0 = *(const f32x4*)(x + ro + bj * HALF), x1 = *(const f32x4*)(x + ro + bj * HALF + 4);
                    const f32x4 v0 = acc[ai][bj][m][0] + x0, v1 = acc[ai][bj][m][1] + x1;
                    *(f32x4*)(out + ro + bj * HALF) = v0; *(f32x4*)(out + ro + bj * HALF + 4) = v1;
                    *(u32x4*)(xb + ro + bj * HALF) = pack8(v0, v1); } }
    }
};
struct EpiGU {
    static constexpr bool PERM = true;
    bf16* hid; const int* list; const i32x4* tokinfo;
    __device__ __forceinline__ void operator()(const f32x4 (&acc)[2][2][4][2], const Unit& u, int wr, int wc, int fr, int fq) const {
        const int lr0 = wr * 64 + fr, col0 = u.pn * HALF + wc * 32 + 8 * fq;
#pragma unroll
        for (int ai = 0; ai < 2; ++ai)
#pragma unroll
            for (int m = 0; m < 4; ++m) { const int lr = lr0 + ai * HALF + m * 16; const bool valid = lr < u.nv;
                const int tok = list[(size_t)u.e * CAP + u.r0 + (valid ? lr : 0)];
                const i32x4 t0 = tokinfo[tok * 2], t1 = tokinfo[tok * 2 + 1];
                const float cw = (t0.x == u.e) ? __int_as_float(t1.x) : __int_as_float(t1.y), rs = __int_as_float(t1.z);
                f32x4 h0, h1;
#pragma unroll
                for (int q = 0; q < 4; ++q) { const float g0 = acc[ai][0][m][0][q] * rs, u0 = acc[ai][1][m][0][q] * rs, g1 = acc[ai][0][m][1][q] * rs, u1 = acc[ai][1][m][1][q] * rs;
                    h0[q] = cw * g0 * sigmoidf_(g0) * u0; h1[q] = cw * g1 * sigmoidf_(g1) * u1; }
                if (valid) *(u32x4*)(hid + (size_t)(u.pm * BM + lr) * FF + col0) = pack8(h0, h1); }
    }
};
struct EpiPle {
    static constexpr bool PERM = true;
    float* out; const bf16* proj; const float* rstd;
    __device__ __forceinline__ void operator()(const f32x4 (&acc)[2][2][4][2], const Unit& u, int wr, int wc, int fr, int fq) const {
        const int row0 = u.pm * BM + wr * 64 + fr, col0 = u.pn * BM + wc * 32 + 8 * fq;
#pragma unroll
        for (int ai = 0; ai < 2; ++ai) {
            u32x4 pw[4][2]; float rs[4];
#pragma unroll
            for (int m = 0; m < 4; ++m) { rs[m] = rstd[row0 + ai * HALF + m * 16];
#pragma unroll
                for (int bj = 0; bj < 2; ++bj) pw[m][bj] = ld16_sc1_nw(proj + (size_t)(row0 + ai * HALF + m * 16) * 1024 + col0 + bj * HALF); }
            wait8(pw);
#pragma unroll
            for (int m = 0; m < 4; ++m)
#pragma unroll
                for (int bj = 0; bj < 2; ++bj) { const size_t ro = (size_t)(row0 + ai * HALF + m * 16) * 1024 + col0 + bj * HALF; f32x4 p0, p1; unpack8(pw[m][bj], p0, p1);
                    const f32x4 x0 = *(const f32x4*)(out + ro), x1 = *(const f32x4*)(out + ro + 4);
                    f32x4 v0, v1;
#pragma unroll
                    for (int q = 0; q < 4; ++q) { v0[q] = x0[q] + sigmoidf_(acc[ai][bj][m][0][q] * rs[m]) * p0[q]; v1[q] = x1[q] + sigmoidf_(acc[ai][bj][m][1][q] * rs[m]) * p1[q]; }
                    *(f32x4*)(out + ro) = v0; *(f32x4*)(out + ro + 4) = v1; }
        }
    }
};
}

namespace attn_body {
using bf16=__hip_bfloat16;
using bf16x8=__attribute__((ext_vector_type(8)))short;
using s16x4=__attribute__((ext_vector_type(4)))short;
using f32x16=__attribute__((ext_vector_type(16)))float;
using u32x4=__attribute__((ext_vector_type(4)))unsigned;
constexpr int BATCH=2,NHEAD=16,SEQ=8192,D=64,DM=NHEAD*D;
constexpr int NW=8,QBLK=32,QB=QBLK*NW,KVBLK=64,NQB=SEQ/QB;
constexpr int ATTN_PITCH=DM, ATTN_UNIT_ROWS=QB;
__device__ __forceinline__ int crow(int r,int hi){return (r&3)+8*(r>>2)+4*hi;}
#define SBAR() __builtin_amdgcn_sched_barrier(0)
__device__ __forceinline__ void cmask(f32x16&p0,f32x16&p1,int jb,int qrel,int hi){
  const float NEG=-INFINITY; int kb=64*jb+4*hi;
  #pragma unroll
  for(int r=0;r<16;++r){int kv=kb+(r&3)+8*(r>>2); if(kv>qrel)p0[r]=NEG; if(kv+32>qrel)p1[r]=NEG;}
}

constexpr int NSLOT=3, SLOTB=8192;
constexpr int LDS_K=0, LDS_V=NSLOT*SLOTB, LDS_WS=2*NSLOT*SLOTB, LDS_OST=LDS_WS+NW*64*4, LDS_BYTES=LDS_OST+NW*4096;
constexpr float C2=0.125f*1.4426950408889634f;
__device__ __forceinline__ void glds16(const void*gsrc,unsigned lds_dst){unsigned keep;
  asm volatile("s_mov_b32 %0, m0\n\ts_mov_b32 m0, %2\n\ts_nop 0\n\tglobal_load_lds_dwordx4 %1, off\n\ts_mov_b32 m0, %0":"=&s"(keep):"v"(gsrc),"s"(lds_dst):"memory");}
__device__ __forceinline__ float max3f(float a,float b,float c){float r;asm("v_max3_f32 %0, %1, %2, %3":"=v"(r):"v"(a),"v"(b),"v"(c));return r;}
__device__ __forceinline__ float max2f(float a,float b){float r;asm("v_max_f32_e32 %0, %1, %2":"=v"(r):"v"(a),"v"(b));return r;}
__device__ __forceinline__ float fadd_s(float a,float b){float r;asm("v_add_f32_e32 %0, %1, %2":"=v"(r):"v"(a),"v"(b));return r;}
__device__ __forceinline__ float fsub_s(float a,float b){float r;asm("v_sub_f32_e32 %0, %1, %2":"=v"(r):"v"(a),"v"(b));return r;}
typedef float f32x2_t __attribute__((ext_vector_type(2))); typedef __bf16 bf16x2_t __attribute__((ext_vector_type(2)));
__device__ __forceinline__ unsigned cvtpk_s(float lo,float hi){f32x2_t v={lo,hi};bf16x2_t b=__builtin_convertvector(v,bf16x2_t);return __builtin_bit_cast(unsigned,b);}
#define WAIT_BAR(N) asm volatile("s_waitcnt vmcnt(" #N ") lgkmcnt(0)\n\ts_barrier":::"memory")

__device__ __forceinline__ void qkt(f32x16&p0,f32x16&p1,const char*Kslot,const bf16x8*qr,const f32x16&negm,int r32,int hi){
  const char*kb=Kslot+hi*1024+r32*16;
  #pragma unroll
  for(int d0=0;d0<4;++d0){
    const bf16x8 b0=*reinterpret_cast<const bf16x8*>(kb+d0*2048);
    const bf16x8 b1=*reinterpret_cast<const bf16x8*>(kb+d0*2048+512);
    if(d0==0){p0=__builtin_amdgcn_mfma_f32_32x32x16_bf16(b0,qr[0],negm,0,0,0);p1=__builtin_amdgcn_mfma_f32_32x32x16_bf16(b1,qr[0],negm,0,0,0);}
    else{p0=__builtin_amdgcn_mfma_f32_32x32x16_bf16(b0,qr[d0],p0,0,0,0);p1=__builtin_amdgcn_mfma_f32_32x32x16_bf16(b1,qr[d0],p1,0,0,0);}}
}
typedef __attribute__((address_space(3))) const char* lds_cptr;
typedef short v4i16_t __attribute__((ext_vector_type(4)));
__device__ __forceinline__ void kload8(bf16x8*kf,lds_cptr kp){
  kf[0]=*(const __attribute__((address_space(3))) bf16x8*)(kp);      kf[1]=*(const __attribute__((address_space(3))) bf16x8*)(kp+512);
  kf[2]=*(const __attribute__((address_space(3))) bf16x8*)(kp+2048); kf[3]=*(const __attribute__((address_space(3))) bf16x8*)(kp+2560);
  kf[4]=*(const __attribute__((address_space(3))) bf16x8*)(kp+4096); kf[5]=*(const __attribute__((address_space(3))) bf16x8*)(kp+4608);
  kf[6]=*(const __attribute__((address_space(3))) bf16x8*)(kp+6144); kf[7]=*(const __attribute__((address_space(3))) bf16x8*)(kp+6656);
}
__device__ __forceinline__ void kload2(bf16x8*kf,lds_cptr kp,int j){ kf[2*j]=*(const __attribute__((address_space(3))) bf16x8*)(kp+j*2048); kf[2*j+1]=*(const __attribute__((address_space(3))) bf16x8*)(kp+j*2048+512); }
__device__ __forceinline__ s16x4 vtr(lds_cptr p){ return __builtin_bit_cast(s16x4,__builtin_amdgcn_ds_read_tr16_b64_v4i16((__attribute__((address_space(3))) v4i16_t*)p)); }
__device__ __forceinline__ float rowmax(const f32x16&p0,const f32x16&p1){
  float a=max3f(p0[0],p0[1],p1[0]),b=max3f(p0[2],p0[3],p1[1]);a=max3f(a,p1[2],p1[3]);
  #pragma unroll
  for(int r=4;r<16;r+=4){a=max3f(a,p0[r],p0[r+1]);b=max3f(b,p0[r+2],p0[r+3]);a=max3f(a,p1[r],p1[r+1]);b=max3f(b,p1[r+2],p1[r+3]);}
  const float m=max2f(a,b);
  auto rr=__builtin_amdgcn_permlane32_swap(__float_as_uint(m),__float_as_uint(m),false,false);
  return max2f(__uint_as_float(rr[0]),__uint_as_float(rr[1]));
}
__device__ __forceinline__ void pv(f32x16*o,int vb,bf16x8 pa0,bf16x8 pa1,bf16x8 pa2,bf16x8 pa3){
  #pragma unroll
  for(int d0=0;d0<2;++d0){s16x4 lo[4],hi[4];
    #pragma unroll
    for(int ks=0;ks<4;++ks){
      asm volatile("ds_read_b64_tr_b16 %0,%1 offset:%c2":"=&v"(lo[ks]):"v"(vb),"i"(d0*4096+ks*1024):"memory");
      asm volatile("ds_read_b64_tr_b16 %0,%1 offset:%c2":"=&v"(hi[ks]):"v"(vb),"i"(d0*4096+ks*1024+512):"memory");}
    asm volatile("s_waitcnt lgkmcnt(0)":::"memory");SBAR();
    #define PK(k) (bf16x8){lo[k][0],lo[k][1],lo[k][2],lo[k][3],hi[k][0],hi[k][1],hi[k][2],hi[k][3]}
    o[d0]=__builtin_amdgcn_mfma_f32_32x32x16_bf16(pa0,PK(0),o[d0],0,0,0);
    o[d0]=__builtin_amdgcn_mfma_f32_32x32x16_bf16(pa1,PK(1),o[d0],0,0,0);
    o[d0]=__builtin_amdgcn_mfma_f32_32x32x16_bf16(pa2,PK(2),o[d0],0,0,0);
    o[d0]=__builtin_amdgcn_mfma_f32_32x32x16_bf16(pa3,PK(3),o[d0],0,0,0);
    #undef PK
  }
}

#ifndef ATTN_STORE16
#define ATTN_STORE16(p,v) (*(u32x4*)(p)=(v))
#endif
template<int THRL> __device__ __forceinline__ void attn_unit(int b,int h,int qb,const bf16*Q,const bf16*__restrict__ K,const bf16*__restrict__ V,bf16*O,char*shm){
  const int tid=threadIdx.x,lane=tid&63,r32=lane&31,hi=lane>>5; const int wid=__builtin_amdgcn_readfirstlane(tid>>6);
  const long rowbase=(long)b*SEQ; const int q0=qb*QB;
  const bf16*Qw=Q+(rowbase+q0+wid*QBLK)*DM+h*D;
  const bf16*Kh=K+rowbase*DM+h*D,*Vh=V+rowbase*DM+h*D;
  const unsigned lds0=(unsigned)(uintptr_t)shm;
  float*wsf=(float*)(shm+LDS_WS)+wid*64;
  const bf16*ksrc=Kh+(long)lane*DM+wid*8;
  const bf16*vsrc=Vh+(long)(16*(wid&3)+(lane>>2))*DM+(wid>>2)*32+(lane&3)*8;
  const unsigned kdst=lds0+LDS_K+wid*1024, vdst=lds0+LDS_V+wid*1024;
  #define DMA_K(t,slot) glds16(ksrc+(long)(t)*KVBLK*DM,(unsigned)__builtin_amdgcn_readfirstlane(kdst+(slot)))
  #define DMA_V(t,slot) glds16(vsrc+(long)(t)*KVBLK*DM,(unsigned)__builtin_amdgcn_readfirstlane(vdst+(slot)))
  const int vb0=(int)(lds0+LDS_V)+((lane>>4)&1)*32+(lane&3)*8+(4*hi+((lane&15)>>2))*64;
  const char*Kbase=shm+LDS_K; bf16x8 kf[8];
  const lds_cptr shm3=(lds_cptr)shm; const lds_cptr kp0=shm3+LDS_K+hi*1024+r32*16; const lds_cptr vp0=shm3+LDS_V+((lane>>4)&1)*32+(lane&3)*8+(4*hi+((lane&15)>>2))*64;
  const int NT=(q0+QB)/KVBLK;
  DMA_K(0,0);DMA_V(0,0);DMA_K(1,SLOTB);
  bf16x8 qr[4];
  #pragma unroll
  for(int d0=0;d0<4;++d0)qr[d0]=*reinterpret_cast<const bf16x8*>(&Qw[(long)r32*DM+d0*16+hi*8]);
  float mhat=0.f,l_reg=0.f;float zz_;asm volatile("v_mov_b32 %0, 0":"=v"(zz_));f32x16 o[2];
  _Pragma("unroll") for(int r=0;r<16;++r){o[0][r]=zz_;o[1][r]=zz_;}
  f32x16 negm;_Pragma("unroll") for(int r=0;r<16;++r)negm[r]=zz_;asm volatile("":"+v"(negm));
  const int qrel=wid*QBLK+r32;
  #define CMASK(P0,P1,t) do{int jb_=(t)-(NT-4); if(jb_>=0)cmask(P0,P1,jb_,qrel,hi);}while(0)
  bool resc=false;
  #define START(P0,P1) do{ const float rm=rowmax(P0,P1); resc=false; \
    { const float dl=rm; mhat=fadd_s(mhat,dl); \
      _Pragma("unroll") for(int r=0;r<16;++r){P0[r]=fsub_s(P0[r],dl);P1[r]=fsub_s(P1[r],dl);} \
      _Pragma("unroll") for(int r=0;r<16;++r)negm[r]=-mhat; asm volatile("":"+v"(negm)); } \
    _Pragma("unroll") for(int r=0;r<16;++r)P0[r]=__builtin_amdgcn_exp2f(P0[r]); }while(0)
  #define RESC() do{ if(resc){ asm volatile("s_waitcnt lgkmcnt(0)":::"memory"); \
      _Pragma("unroll") for(int d_=0;d_<2;++d_) _Pragma("unroll") for(int r=0;r<16;++r)o[d_][r]*=wsf[crow(r,hi)]; } }while(0)
  f32x16 pA0,pA1,pB0,pB1;
  int sl_prev=0,sl_cur=0,sl_next=SLOTB;
  #define ROT() do{sl_prev=sl_cur;sl_cur=sl_next;sl_next=(sl_next==(NSLOT-1)*SLOTB)?0:sl_next+SLOTB;}while(0)
  DMA_K(2,2*SLOTB);
  WAIT_BAR(3);
  qkt(pA0,pA1,Kbase,qr,negm,r32,hi);asm volatile("s_nop 15\n\ts_nop 7":"+v"(pA0),"+v"(pA1));CMASK(pA0,pA1,0);
  START(pA0,pA1);
  _Pragma("unroll") for(int r=0;r<16;++r)pA1[r]=__builtin_amdgcn_exp2f(pA1[r]);
  WAIT_BAR(0);
  DMA_K(3,0);DMA_V(1,SLOTB);
  ROT();
  kload8(kf,kp0+sl_cur);
  WAIT_BAR(2);
  s16x4 vlo[8],vhi[8]; u32x4 pw0,pw1,pw2,pw3;
  #define PKW(P,B) cvtpk_s(P[B],P[B+1])
  #define PAF(k) __builtin_bit_cast(bf16x8,pw##k)
  #define VFR(i) (bf16x8){vlo[i][0],vlo[i][1],vlo[i][2],vlo[i][3],vhi[i][0],vhi[i][1],vhi[i][2],vhi[i][3]}
  #define PIN(x) asm volatile("":"+v"(x))
  #define MX3(a,b,c) __builtin_fmaxf(__builtin_fmaxf((a),(b)),(c))
  #define GAPA(MF,A0,A1,A2,A3,W0,W1,PW) do{ MF; sacc+=A0; sacc+=A1; sacc+=A2; sacc+=A3; PIN(sacc); W0; W1; PIN(PW); SBAR(); }while(0)
  #define EX(v) __builtin_amdgcn_exp2f(v)
  #define GAPB(MF,X,B) do{ MF; X[B]=EX(X[B]); X[B+1]=EX(X[B+1]); X[B+2]=EX(X[B+2]); X[B+3]=EX(X[B+3]); PIN(X); SBAR(); }while(0)
  #define VRD(i) do{ vlo[i]=vtr(vp_+(((i)>>2)*4096+((i)&3)*1024)); vhi[i]=vtr(vp_+(((i)>>2)*4096+((i)&3)*1024+512)); }while(0)
  #define KRD(G,j) do{ if(G){ kload2(kf,kp0+sl_next,j); SBAR(); } }while(0)
  #define STEP(C0,C1,P0,P1,t,GK,GV,GL) do{ SBAR(); \
    const lds_cptr vp_=vp0+sl_prev; \
    VRD(0); SBAR(); float sacc=(P0[0]+P0[1]); \
    GAPA(C0=__builtin_amdgcn_mfma_f32_32x32x16_bf16(kf[0],qr[0],negm,0,0,0), P0[2],P0[3],P0[4],P0[5],     pw0[0]=PKW(P0,0), pw0[1]=PKW(P0,2), pw0); \
    VRD(4); SBAR(); GAPA(C1=__builtin_amdgcn_mfma_f32_32x32x16_bf16(kf[1],qr[0],negm,0,0,0), P0[6],P0[7],P0[8],P0[9],     pw0[2]=PKW(P0,4), pw0[3]=PKW(P0,6), pw0); \
    VRD(1); SBAR(); GAPA(C0=__builtin_amdgcn_mfma_f32_32x32x16_bf16(kf[2],qr[1],C0,0,0,0),   P0[10],P0[11],P0[12],P0[13], pw1[0]=PKW(P0,8), pw1[1]=PKW(P0,10), pw1); \
    VRD(5); SBAR(); GAPA(C1=__builtin_amdgcn_mfma_f32_32x32x16_bf16(kf[3],qr[1],C1,0,0,0),   P0[14],P0[15],P1[0],P1[1],   pw1[2]=PKW(P0,12),pw1[3]=PKW(P0,14), pw1); \
    VRD(2); SBAR(); GAPA(C0=__builtin_amdgcn_mfma_f32_32x32x16_bf16(kf[4],qr[2],C0,0,0,0),   P1[2],P1[3],P1[4],P1[5],     pw2[0]=PKW(P1,0), pw2[1]=PKW(P1,2), pw2); \
    VRD(6); SBAR(); GAPA(C1=__builtin_amdgcn_mfma_f32_32x32x16_bf16(kf[5],qr[2],C1,0,0,0),   P1[6],P1[7],P1[8],P1[9],     pw2[2]=PKW(P1,4), pw2[3]=PKW(P1,6), pw2); \
    VRD(3); SBAR(); GAPA(C0=__builtin_amdgcn_mfma_f32_32x32x16_bf16(kf[6],qr[3],C0,0,0,0),   P1[10],P1[11],P1[12],P1[13], pw3[0]=PKW(P1,8), pw3[1]=PKW(P1,10), pw3); \
    VRD(7); SBAR(); GAPA(C1=__builtin_amdgcn_mfma_f32_32x32x16_bf16(kf[7],qr[3],C1,0,0,0),   P1[14],P1[15],0.f,0.f,       pw3[2]=PKW(P1,12),pw3[3]=PKW(P1,14), pw3); \
    l_reg+=sacc; \
    if(GK){DMA_K((t)+3,sl_cur);} if(GV){DMA_V((t)+1,sl_next);} \
    CMASK(C0,C1,t); \
    { float a=MX3(C0[0],C0[1],C1[0]),b=MX3(C0[2],C0[3],C1[1]); a=MX3(a,C1[2],C1[3]); \
      _Pragma("unroll") for(int r=4;r<16;r+=4){a=MX3(a,C0[r],C0[r+1]);b=MX3(b,C0[r+2],C0[r+3]);a=MX3(a,C1[r],C1[r+1]);b=MX3(b,C1[r+2],C1[r+3]);} \
      float rm=__builtin_fmaxf(a,b); { auto rr=__builtin_amdgcn_permlane32_swap(__float_as_uint(rm),__float_as_uint(rm),false,false); rm=__builtin_fmaxf(__uint_as_float(rr[0]),__uint_as_float(rr[1])); } \
      resc=false; \
      if(__builtin_expect(__any(rm>(float)THRL),0)){ const float dl=__builtin_fmaxf(rm,0.f); mhat+=dl; \
        _Pragma("unroll") for(int r=0;r<16;++r){C0[r]-=dl;C1[r]-=dl;} \
        _Pragma("unroll") for(int r=0;r<16;++r)negm[r]=-mhat; asm volatile("":"+v"(negm)); \
        const float f=__builtin_amdgcn_exp2f(-dl); l_reg*=f; if(hi==0)wsf[r32]=f; resc=true; } } \
    SBAR(); \
    GAPB(o[0]=__builtin_amdgcn_mfma_f32_32x32x16_bf16(PAF(0),VFR(0),o[0],0,0,0), C0,0); \
    GAPB(o[1]=__builtin_amdgcn_mfma_f32_32x32x16_bf16(PAF(0),VFR(4),o[1],0,0,0), C0,4); \
    KRD(GL,0); GAPB(o[0]=__builtin_amdgcn_mfma_f32_32x32x16_bf16(PAF(1),VFR(1),o[0],0,0,0), C0,8); \
    KRD(GL,1); GAPB(o[1]=__builtin_amdgcn_mfma_f32_32x32x16_bf16(PAF(1),VFR(5),o[1],0,0,0), C0,12); \
    KRD(GL,2); GAPB(o[0]=__builtin_amdgcn_mfma_f32_32x32x16_bf16(PAF(2),VFR(2),o[0],0,0,0), C1,0); \
    KRD(GL,3); GAPB(o[1]=__builtin_amdgcn_mfma_f32_32x32x16_bf16(PAF(2),VFR(6),o[1],0,0,0), C1,4); \
    GAPB(o[0]=__builtin_amdgcn_mfma_f32_32x32x16_bf16(PAF(3),VFR(3),o[0],0,0,0), C1,8); \
    GAPB(o[1]=__builtin_amdgcn_mfma_f32_32x32x16_bf16(PAF(3),VFR(7),o[1],0,0,0), C1,12); \
    }while(0)
  int t=1;
  #undef CMASK
  #define CMASK(P0,P1,t) do{}while(0)
  for(;t+5<NT;t+=2){
    STEP(pB0,pB1,pA0,pA1,t,true,true,true);     WAIT_BAR(2); RESC(); ROT();
    STEP(pA0,pA1,pB0,pB1,t+1,true,true,true);   WAIT_BAR(2); RESC(); ROT();
  }
  #undef CMASK
  #define CMASK(P0,P1,t) do{int jb_=(t)-(NT-4); if(jb_>=0)cmask(P0,P1,jb_,qrel,hi);}while(0)
  #define ENDW(tt) do{ if((tt)+3<NT){WAIT_BAR(2);} else if((tt)+2<NT){WAIT_BAR(1);} else {WAIT_BAR(0);} }while(0)
  for(;t+1<NT;t+=2){
    STEP(pB0,pB1,pA0,pA1,t,(t+3<NT),(t+1<NT),(t+1<NT));       ENDW(t);   RESC(); ROT();
    STEP(pA0,pA1,pB0,pB1,t+1,(t+4<NT),(t+2<NT),(t+2<NT));     ENDW(t+1); RESC(); ROT();
  }
  STEP(pB0,pB1,pA0,pA1,NT-1,false,false,false); RESC();
  { float sacc=pB0[0]+pB0[1]; _Pragma("unroll") for(int r=2;r<16;++r)sacc+=pB0[r]; _Pragma("unroll") for(int r=0;r<16;++r)sacc+=pB1[r]; l_reg+=sacc;
    pw0=(u32x4){PKW(pB0,0),PKW(pB0,2),PKW(pB0,4),PKW(pB0,6)};pw1=(u32x4){PKW(pB0,8),PKW(pB0,10),PKW(pB0,12),PKW(pB0,14)};pw2=(u32x4){PKW(pB1,0),PKW(pB1,2),PKW(pB1,4),PKW(pB1,6)};pw3=(u32x4){PKW(pB1,8),PKW(pB1,10),PKW(pB1,12),PKW(pB1,14)};
    SBAR(); pv(o,vb0+sl_cur,PAF(0),PAF(1),PAF(2),PAF(3)); }
  #undef PKW
  #undef PAF
  #undef VFR
  #undef PIN
  #undef MX3
  #undef GAPA
  #undef GAPB
  #undef EX
  #undef VRD
  #undef KRD
  #undef STEP
  #undef ENDW
  {auto rr=__builtin_amdgcn_permlane32_swap(__float_as_uint(l_reg),__float_as_uint(l_reg),false,false);l_reg=__uint_as_float(rr[0])+__uint_as_float(rr[1]);}
  if(hi==0)wsf[32+r32]=l_reg;asm volatile("s_waitcnt lgkmcnt(0)":::"memory");
  float rli[16];
  #pragma unroll
  for(int r=0;r<16;++r)rli[r]=__builtin_amdgcn_rcpf(wsf[32+crow(r,hi)]);
  bf16*Ow=O+(rowbase+q0+wid*QBLK)*DM+h*D;
  { bf16*stg=(bf16*)(shm+LDS_OST)+wid*2048;
    #pragma unroll
    for(int r=0;r<16;++r){const int orow=crow(r,hi);
      #pragma unroll
      for(int d0=0;d0<2;++d0)stg[orow*64+d0*32+r32]=__float2bfloat16(o[d0][r]*rli[r]);}
    asm volatile("s_waitcnt lgkmcnt(0)":::"memory");
    #pragma unroll
    for(int i=0;i<4;++i){const int row=i*8+(lane>>3),ch=lane&7; const u32x4 v=*(const u32x4*)(stg+row*64+ch*8); ATTN_STORE16(Ow+(long)row*DM+ch*8,v);} }
  asm volatile("s_waitcnt lgkmcnt(0)\n\ts_barrier":::"memory");
  #undef DMA_K
  #undef DMA_V
  #undef CMASK
  #undef START
  #undef RESC
  #undef ROT
}
constexpr int ATTN_LDS_BYTES=LDS_BYTES;
struct AttnTensors { const bf16* Q; const bf16* K; const bf16* V; bf16* O; };
struct AttnUnit { int bh; int qb; };
struct StaticOrder {
  int vcu;
  __device__ __forceinline__ explicit StaticOrder(int grid,int block):vcu((block%8)*(grid/8)+block/8){}
  __device__ __forceinline__ bool next(int i,AttnUnit&u)const{ if(i>=4)return false; const int s=vcu&7; u.bh=vcu>>3; u.qb=(i==0)?s:(i==1)?15-s:(i==2)?16+s:31-s; return true; }
  __device__ __forceinline__ void a_ready(const AttnUnit&)const{}
  __device__ __forceinline__ void done(const AttnUnit&)const{}
};
template<class Sched,int THRL=8> __device__ __forceinline__ void attn_phase(char*lds,const AttnTensors&T,const Sched&S){
  AttnUnit u;
  for(int i=0;S.next(i,u);++i){ S.a_ready(u); attn_unit<THRL>(u.bh/NHEAD,u.bh%NHEAD,u.qb,T.Q,T.K,T.V,T.O,lds); S.done(u); }
}
#undef SBAR
#undef WAIT_BAR
}
#define XB_TMO      128
#define XB_XCNT(j)  (256  + 64 * (j))
#define XB_XSUB(j)  (1280 + 64 * (j))
#define XB_XGEN(j)  (2304 + 64 * (j))
#define XB_TOP      3328
#define XB_TOPGEN   3392
#define XCD_BAR_WORDS 3456
#define XB_SPIN_CAP (1u << 18)

__device__ __forceinline__ unsigned xb_ld(unsigned* p)              { return __hip_atomic_load(p, __ATOMIC_RELAXED, __HIP_MEMORY_SCOPE_AGENT); }
__device__ __forceinline__ unsigned xb_add(unsigned* p, unsigned v) { return __hip_atomic_fetch_add(p, v, __ATOMIC_RELAXED, __HIP_MEMORY_SCOPE_AGENT); }
__device__ __forceinline__ unsigned xb_xcc_id() { return (unsigned)__builtin_amdgcn_s_getreg((3 << 11) | 20) & 0xFu; }
#define XB_SPIN(cond, bar) do { unsigned _sp = 0; while (cond) { __builtin_amdgcn_s_sleep(1); \
    if ((++_sp & 255u) == 0u) { if (xb_ld(&(bar)[XB_TMO])) break; if (_sp > XB_SPIN_CAP) { atomicAdd(&(bar)[XB_TMO], 1u); break; } } } } while (0)

struct XcdBarrier {
    unsigned* bar; unsigned x;
    volatile LAS unsigned* st;
};

__device__ __forceinline__ XcdBarrier xcd_barrier_post(unsigned* bar, volatile LAS unsigned* st) {
    XcdBarrier b; b.bar = bar; b.x = xb_xcc_id(); b.st = st;
    if (threadIdx.x == 0) (void)xb_add(&bar[XB_XCNT(b.x)], 1u);
    return b;
}
__device__ __forceinline__ void xcd_barrier_complete(unsigned* bar, unsigned x, unsigned& nloc, unsigned& nx) {
    const unsigned G = gridDim.x * gridDim.y * gridDim.z;
    unsigned sum, cnt, mine, sp = 0u;
    for (;;) {
        sum = 0u; cnt = 0u; mine = 0u;
#pragma unroll
        for (unsigned j = 0; j < 16; ++j) { const unsigned c = xb_ld(&bar[XB_XCNT(j)]); sum += c; cnt += (c > 0u) ? 1u : 0u; mine = (j == x) ? c : mine; }
        if (sum == G) break;
        __builtin_amdgcn_s_sleep(1);
        if ((++sp & 255u) == 0u) { if (xb_ld(&bar[XB_TMO])) break; if (sp > XB_SPIN_CAP) { atomicAdd(&bar[XB_TMO], 1u); break; } }
    }
    nloc = mine > 0u ? mine : 1u; nx = cnt > 0u ? cnt : 1u;
}

__device__ __forceinline__ void xcd_barrier(const XcdBarrier& b) {
    asm volatile("s_waitcnt vmcnt(0)" ::: "memory");
    __syncthreads();
    if (threadIdx.x == 0) {
        unsigned* bar = b.bar;
        __builtin_amdgcn_s_waitcnt(0);
        unsigned nloc = b.st[0], nx = b.st[1];
        if (nloc == 0u) { xcd_barrier_complete(bar, b.x, nloc, nx); b.st[0] = nloc; b.st[1] = nx; }
        const unsigned old = xb_add(&bar[XB_XSUB(b.x)], 1u);
        const unsigned gen = old / nloc;
        if (old + 1u == (gen + 1u) * nloc) {
            __builtin_amdgcn_fence(__ATOMIC_RELEASE, "agent");
            asm volatile("s_waitcnt vmcnt(0)" ::: "memory");
            const unsigned og = xb_add(&bar[XB_TOP], 1u);
            const unsigned tg = og / nx;
            if (og + 1u == (tg + 1u) * nx) xb_add(&bar[XB_TOPGEN], 1u);
            else XB_SPIN(xb_ld(&bar[XB_TOPGEN]) == tg, bar);
            __builtin_amdgcn_fence(__ATOMIC_ACQUIRE, "agent");
            xb_add(&bar[XB_XGEN(b.x)], 1u);
            asm volatile("s_waitcnt vmcnt(0)" ::: "memory");
        } else {
            XB_SPIN(xb_ld(&bar[XB_XGEN(b.x)]) == gen, bar);
            __builtin_amdgcn_fence(__ATOMIC_ACQUIRE, "agent");
            asm volatile("s_waitcnt vmcnt(0)" ::: "memory");
        }
    }
    __syncthreads();
}

__device__ __forceinline__ int lane_id_v() { int l; asm volatile("v_mbcnt_lo_u32_b32 %0, -1, 0\n\tv_mbcnt_hi_u32_b32 %0, -1, %0" : "=v"(l)); return l; }
struct Ctx {
    LAS unsigned char* lds; int tid, lane, wave, vcu, G, gw, NGW;
};

__device__ __forceinline__ void tr_item(const float* W, int K, int N, bf16* WT, const float* ksc, int kmask, float kmul, int mode, LAS float* scr, int item, int lane) {
    const int nblk = N / 32, kb = item / nblk, nb = item % nblk, k0 = 64 * kb, n0 = 32 * nb;
#pragma unroll 8
    for (int i = 0; i < 32; ++i) { const int kk = 2 * i + (lane >> 5); const float s = ksc ? ksc[(k0 + kk) & kmask] * kmul : 1.0f; scr[kk * 33 + (lane & 31)] = W[(size_t)(k0 + kk) * N + n0 + (lane & 31)] * s; }
    LDS_WAIT(); asm volatile("" ::: "memory");
    const int c = lane & 7;
#pragma unroll
    for (int j = 0; j < 4; ++j) { const int n = (lane >> 3) + 8 * j; const LAS float* s = scr + (8 * c) * 33 + n;
        u32x4 o; o.x = pk2(s[0 * 33], s[1 * 33]); o.y = pk2(s[2 * 33], s[3 * 33]); o.z = pk2(s[4 * 33], s[5 * 33]); o.w = pk2(s[6 * 33], s[7 * 33]);
        const int nn = n0 + n; const int dr = mode == 0 ? nn : ((nn >> 7) * 256 + (nn & 127) + (mode == 2 ? 128 : 0));
        *(GAS u32x4*)(WT + (size_t)dr * K + k0 + 8 * c) = o; }
    LDS_WAIT(); asm volatile("" ::: "memory");
}

struct Args { const float* in[31]; float* out; unsigned char* ws; int ph_lo, ph_hi; };
#define AS4 __attribute__((address_space(4)))
struct KA { const AS4 char* p;
    __device__ __forceinline__ const float* in(int i) const { return *(const float* const AS4*)(p + 8 * i); }
    __device__ __forceinline__ float* out() const { return *(float* const AS4*)(p + 8 * 31); }
    __device__ __forceinline__ unsigned char* ws() const { return *(unsigned char* const AS4*)(p + 8 * 32); }
    __device__ __forceinline__ int lo() const { return *(const int AS4*)(p + 8 * 33); }
    __device__ __forceinline__ int hi() const { return *(const int AS4*)(p + 8 * 33 + 4); }
};
__device__ __forceinline__ KA ka_get() { const AS4 char* p = (const AS4 char*)__builtin_amdgcn_kernarg_segment_ptr(); asm volatile("" : "+s"(p)); return KA{p}; }

__device__ __forceinline__ void p0_prologue(const Ctx& F, const KA& a) {
    unsigned char* ws = a.ws();
    LAS float* scr = (LAS float*)(F.lds + RING_OFF + F.wave * 16384);
    constexpr int I_IN = (D / 64) * (NIN / 32), I_SQ = (D / 64) * (D / 32), I_PP = (PLE / 64) * (D / 32);
    constexpr int NITEMS = I_IN + 4 * I_SQ + I_PP;
    for (int it = F.gw; it < NITEMS; it += F.NGW) {
        int r = it;
        if (r < I_IN) { tr_item(a.in(3), D, NIN, (bf16*)(ws + WS_WIN), a.in(2), 1023, 1.0f, 0, scr, r, F.lane); continue; } r -= I_IN;
        if (r < I_SQ) { tr_item(a.in(16), D, D, (bf16*)(ws + WS_WA), a.in(8), 127, 1.0f - LAM_INIT, 0, scr, r, F.lane); continue; } r -= I_SQ;
        if (r < I_SQ) { tr_item(a.in(17), D, D, (bf16*)(ws + WS_WL), nullptr, 0, 1.0f, 0, scr, r, F.lane); continue; } r -= I_SQ;
        if (r < I_SQ) { tr_item(a.in(18), D, D, (bf16*)(ws + WS_WO), nullptr, 0, 1.0f, 0, scr, r, F.lane); continue; } r -= I_SQ;
        if (r < I_SQ) { tr_item(a.in(28), D, D, (bf16*)(ws + WS_WPG), a.in(27), 1023, 1.0f, 0, scr, r, F.lane); continue; } r -= I_SQ;
        tr_item(a.in(29), PLE, D, (bf16*)(ws + WS_WPP), nullptr, 0, 1.0f, 0, scr, r, F.lane);
    }
    const int gt = F.gw * 64 + F.lane, NGT = F.NGW * 64;
    { float* Wr = (float*)(ws + WS_WR); const float* gm = a.in(19);
      for (int i = gt; i < 36 * 1024; i += NGT) { const int j = i >> 10, k = i & 1023; const float w = j < 32 ? a.in(22)[(size_t)((j >> 3) * 1024 + k) * 8 + (j & 7)] : a.in(20)[k * 4 + (j - 32)]; Wr[i] = w * gm[k]; } }
    { bf16* Wl = (bf16*)(ws + WS_WLRU);
      for (int i = gt; i < 2 * 65536; i += NGT) { const int gate = i >> 16, n = (i >> 12) & 15, v = (i >> 6) & 63, w = i & 63; const float* src = gate ? a.in(13) : a.in(11); Wl[i] = (bf16)f2bf(src[(n * 64 + w) * 64 + v]); } }
    { const float* x = a.in(0); bf16* xb = (bf16*)(ws + WS_U0); float* rstd0 = (float*)(ws + WS_RSTD0);
      for (int m = F.gw; m < M; m += F.NGW) { const GAS f32x4* xr = (const GAS f32x4*)(x + (size_t)m * D) + F.lane; f32x4 v[4]; float s = 0.f;
#pragma unroll
          for (int j = 0; j < 4; ++j) { v[j] = xr[64 * j]; s += (v[j].x * v[j].x + v[j].y * v[j].y) + (v[j].z * v[j].z + v[j].w * v[j].w); }
          s = wave_sum(s); if (F.lane == 0) rstd0[m] = 1.0f / sqrtf(s * (1.0f / D) + 1e-6f);
          GAS u32x2* o8 = (GAS u32x2*)(xb + (size_t)m * D) + F.lane;
#pragma unroll
          for (int j = 0; j < 4; ++j) o8[64 * j] = (u32x2){pk2(v[j].x, v[j].y), pk2(v[j].z, v[j].w)}; } }
    { const f32x4* p4 = (const f32x4*)a.in(1); u32x2* pb = (u32x2*)(ws + WS_PB);
      for (int i = gt; i < M * PLE / 4; i += NGT) { const f32x4 v = p4[i]; pb[i] = (u32x2){pk2(v.x, v.y), pk2(v.z, v.w)}; } }
}

template <bool FINAL>
__device__ __forceinline__ void lru_pass(const Ctx& F, const bf16* xr, bf16* gl, float* summ, const bf16* Wlru, const float* w_conv, const float* b_conv, const float* b_rg, const float* b_ig, const float* lam) {
    const int tid = F.tid, lane = F.lane, wave = F.wave, r32 = lane & 31, hi = lane >> 5;
    constexpr int XRS = 144;
    LAS unsigned char* XR = F.lds; LAS unsigned char* XC = F.lds + 37376; LAS unsigned char* GR = F.lds + 74240;
    LAS float* WS = (LAS float*)(F.lds + 111104); LAS float* WCV = (LAS float*)(F.lds + 115200); LAS unsigned char* WG = F.lds + 116480;
    for (int uu = F.vcu; uu < 256; uu += F.G) {
        const int bn = uu >> 3, b = bn >> 4, n = bn & 15, c0 = (uu & 7) * 4;
        const size_t rowb = (size_t)b * SEQ;
        __syncthreads();
        if (tid < 320) { const int j = tid >> 6, c = tid & 63; WCV[tid] = (j < 4) ? w_conv[j * 1024 + 64 * n + c] : b_conv[64 * n + c]; }
        for (int idx = tid; idx < 2 * 64 * 8; idx += 512) { const int gate = idx >> 9, v = (idx >> 3) & 63, pc = idx & 7;
            *(LAS u32x4*)(WG + (gate * 64 + v) * XRS + pc * 16) = *(const u32x4*)(Wlru + ((size_t)(gate * 16 + n) * 64 + v) * 64 + pc * 8); }
        float brg[2], big[2], cdec[2], hc[2], Arun[2];
#pragma unroll
        for (int hf = 0; hf < 2; ++hf) { const int oc = 64 * n + 32 * hf + r32; brg[hf] = b_rg[oc]; big[hf] = b_ig[oc]; cdec[hf] = -8.0f * log1pf(expf(-lam[oc])) * 1.4426950408889634f; hc[hf] = 0.f; Arun[hf] = 1.f;
            if (FINAL) for (int u2 = uu & ~7; u2 < uu; ++u2) { const float A = summ[(u2 * 64 + 32 * hf + r32) * 2], B = summ[(u2 * 64 + 32 * hf + r32) * 2 + 1]; hc[hf] = A * hc[hf] + B; } }
        u32x4 st[5];
#pragma unroll
        for (int k = 0; k < 5; ++k) { const int idx = tid + 512 * k, row = idx >> 3, pc = idx & 7, t = c0 * 256 - 3 + row; st[k] = (u32x4){0u, 0u, 0u, 0u};
            if (idx < 259 * 8 && t >= 0) st[k] = *(const u32x4*)(xr + (rowb + t) * 1024 + 64 * n + 8 * pc); }
        for (int ci = 0; ci < 4; ++ci) {
            const int t0 = (c0 + ci) * 256;
#pragma unroll
            for (int k = 0; k < 5; ++k) { const int idx = tid + 512 * k, row = idx >> 3, pc = idx & 7; if (idx < 259 * 8) *(LAS u32x4*)(XR + row * XRS + pc * 16) = st[k]; }
            bf16* gw_ = gl + (rowb + t0 + 32 * wave) * 1024 + 64 * n;
            LAS unsigned char* GRw = GR + 32 * wave * XRS;
            if (FINAL) {
#pragma unroll
                for (int i = 0; i < 4; ++i) { const int row = (lane >> 3) + 8 * i, pc = lane & 7; *(LAS u32x4*)(GRw + row * XRS + pc * 16) = *(const u32x4*)(gw_ + (size_t)row * 1024 + 8 * pc); } }
            __syncthreads();
            if (ci < 3) {
#pragma unroll
                for (int k = 0; k < 5; ++k) { const int idx = tid + 512 * k, row = idx >> 3, pc = idx & 7, t = t0 + 256 - 3 + row;
                    if (idx < 259 * 8) st[k] = *(const u32x4*)(xr + (rowb + t) * 1024 + 64 * n + 8 * pc); } }
            const int trow = 32 * wave + r32;
            bf16x8 av8[4];
#pragma unroll
            for (int ks = 0; ks < 4; ++ks) { const int c8 = 16 * ks + 8 * hi;
                f32x4 x0 = *(const LAS f32x4*)(WCV + 256 + c8), x1 = *(const LAS f32x4*)(WCV + 256 + c8 + 4);
#pragma unroll
                for (int j = 0; j < 4; ++j) { const u32x4 xv = *(const LAS u32x4*)(XR + (trow + j) * XRS + c8 * 2);
                    const f32x4 w0 = *(const LAS f32x4*)(WCV + j * 64 + c8), w1 = *(const LAS f32x4*)(WCV + j * 64 + c8 + 4);
                    x0 += w0 * (f32x4){bflo(xv.x), bfhi(xv.x), bflo(xv.y), bfhi(xv.y)}; x1 += w1 * (f32x4){bflo(xv.z), bfhi(xv.z), bflo(xv.w), bfhi(xv.w)}; }
                const u32x4 pk = (u32x4){pk2(x0[0], x0[1]), pk2(x0[2], x0[3]), pk2(x1[0], x1[1]), pk2(x1[2], x1[3])};
                av8[ks] = __builtin_bit_cast(bf16x8, pk);
                *(LAS u32x4*)(XC + trow * XRS + c8 * 2) = pk; }
            float av[2][16], uv[2][16], pA[2][4], pB[2][4];
#pragma unroll
            for (int hf = 0; hf < 2; ++hf) {
                f32x16 aR = {}, aI = {};
#pragma unroll
                for (int ks = 0; ks < 4; ++ks) { const bf16x8 bR = *(const LAS bf16x8*)(WG + (0 * 64 + 32 * hf + r32) * XRS + (16 * ks + 8 * hi) * 2), bI = *(const LAS bf16x8*)(WG + (1 * 64 + 32 * hf + r32) * XRS + (16 * ks + 8 * hi) * 2);
                    aR = __builtin_amdgcn_mfma_f32_32x32x16_bf16(av8[ks], bR, aR, 0, 0, 0); aI = __builtin_amdgcn_mfma_f32_32x32x16_bf16(av8[ks], bI, aI, 0, 0, 0); }
#pragma unroll
                for (int r = 0; r < 16; ++r) { const int row = 32 * wave + crow16(r, hi);
                    const float xcv = __uint_as_float((unsigned)(*(const LAS unsigned short*)(XC + row * XRS + (32 * hf + r32) * 2)) << 16);
                    const float rg = sigmoidf_(aR[r] + brg[hf]), ig = sigmoidf_(aI[r] + big[hf]);
                    const float a_ = __builtin_amdgcn_exp2f(cdec[hf] * rg); const float mult = __builtin_amdgcn_sqrtf(fmaxf(1.0f - a_ * a_, 0.f));
                    av[hf][r] = a_; uv[hf][r] = mult * ig * xcv; }
                float AW = 1.f, BW = 0.f, gA[4], gB[4];
#pragma unroll
                for (int j = 0; j < 4; ++j) { float A = 1.f, B = 0.f;
#pragma unroll
                    for (int i = 0; i < 4; ++i) { B = av[hf][4 * j + i] * B + uv[hf][4 * j + i]; A *= av[hf][4 * j + i]; }
                    gA[j] = A; gB[j] = B; pA[hf][j] = __shfl_xor(A, 32); pB[hf][j] = __shfl_xor(B, 32); }
#pragma unroll
                for (int j = 0; j < 4; ++j) { const float fA = hi ? pA[hf][j] : gA[j], fB = hi ? pB[hf][j] : gB[j], sA = hi ? gA[j] : pA[hf][j], sB = hi ? gB[j] : pB[hf][j];
                    BW = fA * BW + fB; AW *= fA; BW = sA * BW + sB; AW *= sA; }
                if (hi == 0) { WS[(wave * 64 + 32 * hf + r32) * 2] = AW; WS[(wave * 64 + 32 * hf + r32) * 2 + 1] = BW; }
            }
            __syncthreads();
#pragma unroll
            for (int hf = 0; hf < 2; ++hf) {
                float h = hc[hf], hin = hc[hf], Ar = Arun[hf];
#pragma unroll
                for (int w = 0; w < 8; ++w) { const float A = WS[(w * 64 + 32 * hf + r32) * 2], B = WS[(w * 64 + 32 * hf + r32) * 2 + 1]; h = A * h + B; Ar *= A; if (w + 1 == wave) hin = h; }
                hc[hf] = h; Arun[hf] = Ar;
                if (FINAL) {
                    h = hin;
#pragma unroll
                    for (int j = 0; j < 4; ++j) { float hh = hi ? pA[hf][j] * h + pB[hf][j] : h;
#pragma unroll
                        for (int i = 0; i < 4; ++i) { hh = av[hf][4 * j + i] * hh + uv[hf][4 * j + i]; uv[hf][4 * j + i] = hh; }
                        h = hi ? hh : pA[hf][j] * hh + pB[hf][j]; }
#pragma unroll
                    for (int r = 0; r < 16; ++r) { LAS unsigned short* g = (LAS unsigned short*)(GRw + crow16(r, hi) * XRS + (32 * hf + r32) * 2);
                        *g = (unsigned short)f2bf(uv[hf][r] * __uint_as_float((unsigned)(*g) << 16)); }
                }
            }
            if (FINAL) {
#pragma unroll
                for (int i = 0; i < 4; ++i) { const int row = (lane >> 3) + 8 * i, pc = lane & 7; *(u32x4*)(gw_ + (size_t)row * 1024 + 8 * pc) = *(const LAS u32x4*)(GRw + row * XRS + pc * 16); } }
        }
        if (!FINAL && hi == 0) {
#pragma unroll
            for (int hf = 0; hf < 2; ++hf) { summ[(uu * 64 + 32 * hf + r32) * 2] = Arun[hf]; summ[(uu * 64 + 32 * hf + r32) * 2 + 1] = hc[hf]; } }
    }
}

__device__ __forceinline__ void p4_combine(const Ctx& F, const KA& a) {
    unsigned char* ws = a.ws();
    float lam;
    { const float s1 = wave_sum(a.in(4)[F.lane] * a.in(5)[F.lane]), s2 = wave_sum(a.in(6)[F.lane] * a.in(7)[F.lane]); lam = expf(s1) - expf(s2) + LAM_INIT; }
    bf16* O1 = (bf16*)(ws + WS_U0); const bf16* O2 = (const bf16*)(ws + WS_U0 + 4 * USZ);
    for (int m = F.gw; m < M; m += F.NGW) {
        const u32x4* p1 = (const u32x4*)(O1 + (size_t)m * D) + 2 * F.lane; const u32x4* p2 = (const u32x4*)(O2 + (size_t)m * D) + 2 * F.lane;
        const u32x4 a0 = p1[0], a1 = p1[1], b0 = p2[0], b1 = p2[1];
        f32x4 o[4], q[4]; pg8::unpack8(a0, o[0], o[1]); pg8::unpack8(a1, o[2], o[3]); pg8::unpack8(b0, q[0], q[1]); pg8::unpack8(b1, q[2], q[3]);
        float ss = 0.f;
#pragma unroll
        for (int j = 0; j < 4; ++j) { o[j] = o[j] - lam * q[j]; ss += (o[j].x * o[j].x + o[j].y * o[j].y) + (o[j].z * o[j].z + o[j].w * o[j].w); }
        ss += __shfl_xor(ss, 1); ss += __shfl_xor(ss, 2); ss += __shfl_xor(ss, 4);
        const float rs = 1.0f / sqrtf(ss * (1.0f / 128.0f) + 1e-5f);
        u32x4 w0, w1; w0 = (u32x4){pk2(o[0].x * rs, o[0].y * rs), pk2(o[0].z * rs, o[0].w * rs), pk2(o[1].x * rs, o[1].y * rs), pk2(o[1].z * rs, o[1].w * rs)};
        w1 = (u32x4){pk2(o[2].x * rs, o[2].y * rs), pk2(o[2].z * rs, o[2].w * rs), pk2(o[3].x * rs, o[3].y * rs), pk2(o[3].z * rs, o[3].w * rs)};
        u32x4* po = (u32x4*)(O1 + (size_t)m * D) + 2 * F.lane; po[0] = w0; po[1] = w1;
    }
    LAS float* scr = (LAS float*)(F.lds + RING_OFF + F.wave * 16384);
    constexpr int I_GU = (D / 64) * (FF / 32), I_DN = (FF / 64) * (D / 32);
    for (int it = F.gw; it < NEXP * (2 * I_GU + I_DN); it += F.NGW) {
        const int e = it / (2 * I_GU + I_DN); int r = it % (2 * I_GU + I_DN);
        if (r < I_GU) { tr_item(a.in(24) + (size_t)e * D * FF, D, FF, (bf16*)(ws + WS_WGU) + (size_t)e * 1024 * 1024, a.in(19), 1023, 1.0f, 1, scr, r, F.lane); continue; } r -= I_GU;
        if (r < I_GU) { tr_item(a.in(25) + (size_t)e * D * FF, D, FF, (bf16*)(ws + WS_WGU) + (size_t)e * 1024 * 1024, a.in(19), 1023, 1.0f, 2, scr, r, F.lane); continue; } r -= I_GU;
        tr_item(a.in(26) + (size_t)e * FF * D, FF, D, (bf16*)(ws + WS_WD) + (size_t)e * 1024 * 512, nullptr, 0, 1.0f, 0, scr, r, F.lane);
    }
}

__device__ __forceinline__ void p7_router(const Ctx& F, const KA& a) {
    unsigned char* ws = a.ws();
    const float* x1 = a.out(); const float* Wr = (const float*)(ws + WS_WR);
    LAS float* WL = (LAS float*)F.lds;
    for (int i = F.tid; i < 36 * 256; i += NWAVES * 64) ((LAS f32x4*)WL)[i] = ((const f32x4*)Wr)[i];
    __syncthreads();
    int* list = (int*)(ws + WS_LIST); unsigned* cnt = (unsigned*)(ws + WS_CTL) + CW_CNT; i32x4* tokinfo = (i32x4*)(ws + WS_TOKINFO);
    const float* bg = a.in(21); const float* bfe = a.in(23);
    for (int m = F.gw; m < M; m += F.NGW) {
        const GAS f32x4* xr = (const GAS f32x4*)(x1 + (size_t)m * D) + F.lane; f32x4 v[4]; float s = 0.f;
#pragma unroll
        for (int j = 0; j < 4; ++j) { v[j] = xr[64 * j]; s += (v[j].x * v[j].x + v[j].y * v[j].y) + (v[j].z * v[j].z + v[j].w * v[j].w); }
        const float rstd = 1.0f / sqrtf(wave_sum(s) * (1.0f / D) + 1e-6f);
        float gl[4];
#pragma unroll
        for (int g = 0; g < 4; ++g) { float d = 0.f;
#pragma unroll
            for (int j = 0; j < 4; ++j) { const f32x4 w = *(const LAS f32x4*)(WL + (32 + g) * 1024 + 4 * F.lane + 256 * j); d += (v[j].x * w.x + v[j].y * w.y) + (v[j].z * w.z + v[j].w * w.w); }
            gl[g] = wave_sum(d) * rstd + bg[g]; }
        int gi = 0; float gmax = gl[0];
#pragma unroll
        for (int g = 1; g < 4; ++g) if (gl[g] > gmax) { gmax = gl[g]; gi = g; }
        float gs = 0.f;
#pragma unroll
        for (int g = 0; g < 4; ++g) gs += expf(gl[g] - gmax);
        const float gw = 1.0f / gs;
        gi = __builtin_amdgcn_readfirstlane(gi);
        float fl[8];
#pragma unroll
        for (int e = 0; e < 8; ++e) { float d = 0.f;
#pragma unroll
            for (int j = 0; j < 4; ++j) { const f32x4 w = *(const LAS f32x4*)(WL + (gi * 8 + e) * 1024 + 4 * F.lane + 256 * j); d += (v[j].x * w.x + v[j].y * w.y) + (v[j].z * w.z + v[j].w * w.w); }
            fl[e] = wave_sum(d) * rstd + bfe[gi * 8 + e]; }
        int i0 = 0; float l0 = fl[0];
#pragma unroll
        for (int e = 1; e < 8; ++e) if (fl[e] > l0) { l0 = fl[e]; i0 = e; }
        int i1 = -1; float l1 = -INFINITY;
#pragma unroll
        for (int e = 0; e < 8; ++e) if (e != i0 && fl[e] > l1) { l1 = fl[e]; i1 = e; }
        const float ex = expf(l1 - l0), w0 = 1.0f / (1.0f + ex), w1 = ex * w0;
        if (F.lane == 0) { const int e0 = gi * 8 + i0, e1 = gi * 8 + i1;
            const int p0 = (int)atomicAdd(cnt + e0, 1u), p1 = (int)atomicAdd(cnt + e1, 1u);
            list[(size_t)e0 * CAP + p0] = m; list[(size_t)e1 * CAP + p1] = m;
            tokinfo[m * 2] = (i32x4){e0, e1, p0, p1}; tokinfo[m * 2 + 1] = (i32x4){__float_as_int(gw * w0), __float_as_int(gw * w1), __float_as_int(rstd), 0}; }
    }
}

__device__ __forceinline__ void moe_tables(const Ctx& F, const unsigned* cnt) {
    LAS int* tp = (LAS int*)(F.lds + CTLL_OFF + 64); LAS int* cn = (LAS int*)(F.lds + CTLL_OFF + 256);
    if (F.tid == 0) { int acc = 0; for (int e = 0; e < NEXP; ++e) { const int c = (int)__hip_atomic_load(cnt + e, RLX_AGENT); cn[e] = c; tp[e] = acc; acc += (c + 255) >> 8; } tp[NEXP] = acc; }
    __syncthreads();
}

__device__ __forceinline__ void p10_combine(const Ctx& F, const KA& a) {
    unsigned char* ws = a.ws();
    const LAS int* tp = (const LAS int*)(F.lds + CTLL_OFF + 64);
    const i32x4* tokinfo = (const i32x4*)(ws + WS_TOKINFO); const bf16* Y = (const bf16*)(ws + WS_Y); bf16* x2b = (bf16*)(ws + WS_U0); float* rstd2 = (float*)(ws + WS_RSTD2);
    for (int m = F.gw; m < M; m += F.NGW) {
        const i32x4 t0 = tokinfo[m * 2];
        const int s0 = tp[t0.x] * 256 + t0.z, s1 = tp[t0.y] * 256 + t0.w;
        GAS f32x4* xr = (GAS f32x4*)(a.out() + (size_t)m * D) + F.lane; const u32x2* y0 = (const u32x2*)(Y + (size_t)s0 * D) + F.lane; const u32x2* y1 = (const u32x2*)(Y + (size_t)s1 * D) + F.lane;
        f32x4 v[4]; float s = 0.f;
#pragma unroll
        for (int j = 0; j < 4; ++j) { const u32x2 p = y0[64 * j], q = y1[64 * j]; v[j] = xr[64 * j];
            v[j].x += bflo(p.x) + bflo(q.x); v[j].y += bfhi(p.x) + bfhi(q.x); v[j].z += bflo(p.y) + bflo(q.y); v[j].w += bfhi(p.y) + bfhi(q.y);
            s += (v[j].x * v[j].x + v[j].y * v[j].y) + (v[j].z * v[j].z + v[j].w * v[j].w); }
        s = wave_sum(s); if (F.lane == 0) rstd2[m] = 1.0f / sqrtf(s * (1.0f / D) + 1e-6f);
        GAS u32x2* o8 = (GAS u32x2*)(x2b + (size_t)m * D) + F.lane;
#pragma unroll
        for (int j = 0; j < 4; ++j) { xr[64 * j] = v[j]; o8[64 * j] = (u32x2){pk2(v[j].x, v[j].y), pk2(v[j].z, v[j].w)}; }
    }
}

__device__ __forceinline__ void p12_final(const Ctx& F, const KA& a) {
    const f32x4* g4 = (const f32x4*)a.in(30);
    for (int m = F.gw; m < M; m += F.NGW) {
        GAS f32x4* xr = (GAS f32x4*)(a.out() + (size_t)m * D) + F.lane; f32x4 v[4]; float s = 0.f;
#pragma unroll
        for (int j = 0; j < 4; ++j) { v[j] = xr[64 * j]; s += (v[j].x * v[j].x + v[j].y * v[j].y) + (v[j].z * v[j].z + v[j].w * v[j].w); }
        const float rs = 1.0f / sqrtf(wave_sum(s) * (1.0f / D) + 1e-6f);
#pragma unroll
        for (int j = 0; j < 4; ++j) xr[64 * j] = v[j] * rs * g4[F.lane + 64 * j];
    }
}

#ifndef MK_N_LAUNCHES
#define MK_N_LAUNCHES 1
#endif
constexpr int NPH = 13;
constexpr int N_LAUNCHES = MK_N_LAUNCHES;

__global__ void __launch_bounds__(NWAVES * 64, 2) mega_fwd(Args args) {
    extern __shared__ __attribute__((aligned(16))) unsigned char lds[];
#define MKCTX() Ctx F; F.lds = (LAS unsigned char*)lds; F.tid = threadIdx.x; F.lane = lane_id_v(); F.wave = __builtin_amdgcn_readfirstlane(F.tid >> 6); \
    F.G = gridDim.x; { const int bx = blockIdx.x; F.vcu = (F.G % 8 == 0) ? (bx % 8) * (F.G / 8) + bx / 8 : bx; } F.gw = F.vcu * NWAVES + F.wave; F.NGW = F.G * NWAVES
    const KA ka0 = ka_get();
    unsigned char* ws = ka0.ws();
    gu32* ctl = (gu32*)(ws + WS_CTL);
    for (int u = threadIdx.x; u < (LDS_BYTES - CTLL_OFF) / 4; u += NWAVES * 64) ((LAS unsigned*)((LAS unsigned char*)lds + CTLL_OFF))[u] = 0u;
    __syncthreads();
    XcdBarrier bar; bar.bar = (unsigned*)ctl + CW_BAR; bar.x = 0; bar.st = nullptr;
    if (N_LAUNCHES == 1) bar = xcd_barrier_post((unsigned*)ctl + CW_BAR, (volatile LAS unsigned*)((LAS unsigned char*)lds + CTLL_OFF));
#define GRID_BAR() do { if (N_LAUNCHES == 1) xcd_barrier(bar); } while (0)
#define GRID_BAR2() xcd_barrier(bar)
    const int lo = ka0.lo(), hi = ka0.hi();
#define IN(k) (lo <= (k) && (k) < hi)
#define BOTH(k) (IN(k) && IN((k) + 1))
    bf16* U0 = (bf16*)(ws + WS_U0);

    if (IN(0)) { MKCTX(); p0_prologue(F, ka_get()); if (BOTH(0)) GRID_BAR(); }

    if (IN(1)) {
        pg8::DenseOrder S; S.init(ws + WS_U0, ws + WS_WIN, M, NIN, D, gridDim.x, (int)blockIdx.x);
        pg8::EpiIn E{(bf16*)(ws + WS_U0 + 1 * USZ), (const float*)(ws + WS_RSTD0)};
        pg8::gemm_phase<D, pg8::EpiIn, pg8::DenseOrder, false, true>((LAS unsigned char*)lds + RING_OFF, S, E);
        if (BOTH(1)) GRID_BAR();
    }

    if (IN(2)) {
        { MKCTX(); const KA ka = ka_get();
          lru_pass<false>(F, (const bf16*)(ws + WS_U0 + 4 * USZ), (bf16*)(ws + WS_U0 + 5 * USZ), (float*)(ws + WS_SUMM), (const bf16*)(ws + WS_WLRU), ka.in(9), ka.in(10), ka.in(12), ka.in(14), ka.in(15)); }
        GRID_BAR2();
        { MKCTX(); const KA ka = ka_get();
          lru_pass<true>(F, (const bf16*)(ws + WS_U0 + 4 * USZ), (bf16*)(ws + WS_U0 + 5 * USZ), (float*)(ws + WS_SUMM), (const bf16*)(ws + WS_WLRU), ka.in(9), ka.in(10), ka.in(12), ka.in(14), ka.in(15)); }
        if (BOTH(2)) GRID_BAR();
    }

    if (IN(3)) {
        const bf16* Q = (const bf16*)(ws + WS_U0 + 1 * USZ); const bf16* Kb = (const bf16*)(ws + WS_U0 + 2 * USZ); const bf16* Vb = (const bf16*)(ws + WS_U0 + 3 * USZ);
        bf16* O1 = (bf16*)(ws + WS_U0); bf16* O2 = (bf16*)(ws + WS_U0 + 4 * USZ);
        const int G = gridDim.x, bx = blockIdx.x, vcu = (G % 8 == 0) ? (bx % 8) * (G / 8) + bx / 8 : bx;
        for (int k = vcu; k < 2048; k += G) {
            const int v = k & 255, i = k >> 8, s = v & 7, bh = (v >> 3) + 32 * (i >> 2), j = i & 3;
            const int qb = (j == 0) ? s : (j == 1) ? 15 - s : (j == 2) ? 16 + s : 31 - s;
            const int b = bh >> 5, vu = bh & 31, h = vu >> 2, c = (vu >> 1) & 1, vh = vu & 1;
            attn_body::attn_unit<8>(b, 0, qb, (const attn_body::bf16*)(Q + 128 * h + 64 * c), (const attn_body::bf16*)(Kb + 128 * h + 64 * c), (const attn_body::bf16*)(Vb + 128 * h + 64 * vh),
                                    (attn_body::bf16*)((c ? O2 : O1) + 128 * h + 64 * vh), (char*)lds + RING_OFF);
        }
        if (BOTH(3)) GRID_BAR();
    }

    if (IN(4)) { MKCTX(); p4_combine(F, ka_get()); if (BOTH(4)) GRID_BAR(); }

    if (IN(5)) {
        bf16* mixed = (bf16*)(ws + WS_U0 + 4 * USZ);
        { pg8::DenseOrder S; S.init(ws + WS_U0, ws + WS_WA, M, D, D, gridDim.x, (int)blockIdx.x);
          pg8::EpiMix<true> E{mixed, (const bf16*)(ws + WS_U0 + 6 * USZ)};
          pg8::gemm_phase<D, pg8::EpiMix<true>, pg8::DenseOrder, false, false>((LAS unsigned char*)lds + RING_OFF, S, E); }
        { pg8::DenseOrder S; S.init(ws + WS_U0 + 5 * USZ, ws + WS_WL, M, D, D, gridDim.x, (int)blockIdx.x);
          pg8::EpiMix<false> E{mixed, (const bf16*)(ws + WS_U0 + 7 * USZ)};
          pg8::gemm_phase<D, pg8::EpiMix<false>, pg8::DenseOrder, false, false>((LAS unsigned char*)lds + RING_OFF, S, E); }
        if (BOTH(5)) GRID_BAR();
    }

    if (IN(6)) {
        pg8::DenseOrder S; S.init(ws + WS_U0 + 4 * USZ, ws + WS_WO, M, D, D, gridDim.x, (int)blockIdx.x);
        const KA ka = ka_get(); pg8::EpiOut E{ka.in(0), ka.out(), U0};
        pg8::gemm_phase<D, pg8::EpiOut, pg8::DenseOrder, false, false>((LAS unsigned char*)lds + RING_OFF, S, E);
        if (BOTH(6)) GRID_BAR();
    }

    if (IN(7)) { MKCTX(); p7_router(F, ka_get()); if (BOTH(7)) GRID_BAR(); }

    if (IN(8)) {
        { MKCTX(); moe_tables(F, (const unsigned*)ctl + CW_CNT);
        pg8::MoeOrder<true> S{(const char*)U0, (const char*)(ws + WS_WGU), (size_t)1024 * 1024 * 2, D, F.G, F.vcu, (const LAS int*)(F.lds + CTLL_OFF + 64), (const LAS int*)(F.lds + CTLL_OFF + 256), (const int*)(ws + WS_LIST)};
        pg8::EpiGU E{(bf16*)(ws + WS_HID), (const int*)(ws + WS_LIST), (const i32x4*)(ws + WS_TOKINFO)};
        pg8::gemm_phase<D, pg8::EpiGU, pg8::MoeOrder<true>, true, false>(F.lds + RING_OFF, S, E); }
        if (BOTH(8)) GRID_BAR();
    }

    if (IN(9)) {
        { MKCTX(); moe_tables(F, (const unsigned*)ctl + CW_CNT);
        pg8::MoeOrder<false> S{(const char*)(ws + WS_HID), (const char*)(ws + WS_WD), (size_t)1024 * 512 * 2, FF, F.G, F.vcu, (const LAS int*)(F.lds + CTLL_OFF + 64), (const LAS int*)(F.lds + CTLL_OFF + 256), (const int*)(ws + WS_LIST)};
        pg8::EpiBf E{(bf16*)(ws + WS_Y), D};
        pg8::gemm_phase<FF, pg8::EpiBf, pg8::MoeOrder<false>, false, false>(F.lds + RING_OFF, S, E); }
        if (BOTH(9)) GRID_BAR();
    }

    if (IN(10)) { MKCTX(); moe_tables(F, (const unsigned*)ctl + CW_CNT); p10_combine(F, ka_get()); if (BOTH(10)) GRID_BAR(); }

    if (IN(11)) {
        { pg8::DenseOrder S; S.init(ws + WS_PB, ws + WS_WPP, M, D, PLE, gridDim.x, (int)blockIdx.x);
          pg8::EpiBf E{(bf16*)(ws + WS_PROJ), D};
          pg8::gemm_phase<PLE, pg8::EpiBf, pg8::DenseOrder, false, false>((LAS unsigned char*)lds + RING_OFF, S, E); }
        { pg8::DenseOrder S; S.init(ws + WS_U0, ws + WS_WPG, M, D, D, gridDim.x, (int)blockIdx.x);
          const KA ka = ka_get(); pg8::EpiPle E{ka.out(), (const bf16*)(ws + WS_PROJ), (const float*)(ws + WS_RSTD2)};
          pg8::gemm_phase<D, pg8::EpiPle, pg8::DenseOrder, false, false>((LAS unsigned char*)lds + RING_OFF, S, E); }
        if (BOTH(11)) GRID_BAR();
    }

    if (IN(12)) { MKCTX(); p12_final(F, ka_get()); }
#undef IN
#undef BOTH
}

extern "C" void kernel_launch(void* const* d_in, const int* in_sizes, int n_in, void* d_out, int out_size, void* d_ws, size_t ws_size, hipStream_t stream) {
    static int grid = 0;
    if (grid == 0) {
        if (n_in != 31 || in_sizes[0] != M * D || out_size != M * D || ws_size < WS_END) { fprintf(stderr, "kernel_launch: unexpected shapes (n_in %d, in0 %d, out %d, ws %zu < %zu); nothing launched\n", n_in, n_in > 0 ? in_sizes[0] : -1, out_size, ws_size, (size_t)WS_END); grid = -1; return; }
        int dev = 0, cus = 0, per_cu = 0;
        if (hipGetDevice(&dev) != hipSuccess || hipDeviceGetAttribute(&cus, hipDeviceAttributeMultiprocessorCount, dev) != hipSuccess) { grid = -1; return; }
        if (hipFuncSetAttribute((const void*)mega_fwd, hipFuncAttributeMaxDynamicSharedMemorySize, LDS_BYTES) != hipSuccess) { fprintf(stderr, "kernel_launch: hipFuncSetAttribute failed\n"); grid = -1; return; }
        if (hipOccupancyMaxActiveBlocksPerMultiprocessor(&per_cu, (const void*)mega_fwd, NWAVES * 64, LDS_BYTES) != hipSuccess || per_cu < 1)
            fprintf(stderr, "kernel_launch: note: occupancy query reports %d workgroups per CU\n", per_cu);
        (void)hipGetLastError();
        grid = cus;
    }
    if (grid < 0) return;
    if (hipMemsetAsync((char*)d_ws + WS_CTL, 0, CTL_ZERO_BYTES, stream) != hipSuccess) return;
    Args a{};
    for (int i = 0; i < 31; ++i) a.in[i] = (const float*)d_in[i];
    a.out = (float*)d_out; a.ws = (unsigned char*)d_ws;
    for (int li = 0; li < N_LAUNCHES; ++li) {
        a.ph_lo = (N_LAUNCHES == 1) ? 0 : li; a.ph_hi = (N_LAUNCHES == 1) ? NPH : li + 1;
        hipLaunchKernelGGL(mega_fwd, dim3(grid), dim3(NWAVES * 64), LDS_BYTES, stream, a);
        const hipError_t le = hipPeekAtLastError();
        if (le != hipSuccess) { fprintf(stderr, "kernel_launch: launch %d failed: %s\n", li, hipGetErrorName(le)); break; }
    }
}
```

```cpp
#include <hip/hip_runtime.h>
#include <hip/hip_bf16.h>
#include <cstdio>
#include <cstdint>
#include <cmath>

#define LAS __attribute__((address_space(3)))
#define GAS __attribute__((address_space(1)))
typedef unsigned short bf16;
typedef short bf16x8 __attribute__((ext_vector_type(8)));
typedef float f32x4 __attribute__((ext_vector_type(4)));
typedef float f32x2 __attribute__((ext_vector_type(2)));
typedef float f32x16 __attribute__((ext_vector_type(16)));
typedef unsigned u32x4 __attribute__((ext_vector_type(4)));
typedef unsigned u32x2 __attribute__((ext_vector_type(2)));
typedef int i32x4 __attribute__((ext_vector_type(4)));
typedef GAS unsigned gu32;

constexpr int M = 16384, D = 1024, SEQ = 8192, NBATCH = 2, NIN = 7168, PLE = 256, NEXP = 32, FF = 512, CAP = 16384;
constexpr float C2 = 0.125f * 1.4426950408889634f;
constexpr float LAM_INIT = 0.2f;

constexpr size_t MiB = 1u << 20;
constexpr size_t WS_CTL = 0, CTL_ZERO_BYTES = 64 * 1024;
constexpr size_t WS_RSTD0 = 1 * MiB, WS_RSTD2 = 1 * MiB + 65536, WS_TOKINFO = 1 * MiB + 131072;
constexpr size_t WS_SUMM = 1 * MiB + 655360;
constexpr size_t WS_WR = 2 * MiB, WS_WLRU = 2 * MiB + 262144;
constexpr size_t WS_LIST = 4 * MiB;
constexpr size_t WS_WIN = 8 * MiB, WS_WA = 22 * MiB, WS_WL = 24 * MiB, WS_WO = 26 * MiB, WS_WPG = 28 * MiB, WS_WPP = 30 * MiB;
constexpr size_t WS_U0 = 32 * MiB, USZ = 32 * MiB;
constexpr size_t WS_WGU = WS_U0 + 1 * USZ, WS_WD = WS_U0 + 3 * USZ;
constexpr size_t WS_Y = WS_U0 + 4 * USZ;
constexpr size_t WS_HID = 246 * MiB, WS_PROJ = 246 * MiB;
constexpr size_t WS_PB = 288 * MiB, WS_END = 296 * MiB;
constexpr int CW_TMO = 0, CW_CODE = 1, CW_BAR = 1024, CW_CNT = 8192;

constexpr int RING_OFF = 0, RING_BYTES = 131072, AUX_OFF = 131072, CTLL_OFF = 147456, LDS_BYTES = 149504;
constexpr int NWAVES = 8;

#define RLX_AGENT __ATOMIC_RELAXED, __HIP_MEMORY_SCOPE_AGENT
#define LDS_WAIT() asm volatile("s_waitcnt lgkmcnt(0)" ::: "memory")
#define VM_WAIT() asm volatile("s_waitcnt vmcnt(0)" ::: "memory")
__device__ __forceinline__ unsigned f2bf(float f) { unsigned u = __builtin_bit_cast(unsigned, f); return (u + 0x7fffu + ((u >> 16) & 1u)) >> 16; }
__device__ __forceinline__ unsigned pk2(float lo, float hi) { return f2bf(lo) | (f2bf(hi) << 16); }
__device__ __forceinline__ float bflo(unsigned w) { return __uint_as_float(w << 16); }
__device__ __forceinline__ float bfhi(unsigned w) { return __uint_as_float(w & 0xffff0000u); }
__device__ __forceinline__ float sigmoidf_(float v) { return __builtin_amdgcn_rcpf(1.0f + __builtin_amdgcn_exp2f(-1.4426950408889634f * v)); }
__device__ __forceinline__ float gelu_tanh(float v) { return v * __builtin_amdgcn_rcpf(1.0f + __builtin_amdgcn_exp2f(-2.3022082f * v * (1.0f + 0.044715f * v * v))); }
__device__ __forceinline__ float wave_sum(float v) {
#pragma unroll
    for (int o = 1; o < 64; o <<= 1) v += __shfl_xor(v, o);
    return v;
}
__device__ __forceinline__ int crow16(int r, int hi) { return (r & 3) + 8 * (r >> 2) + 4 * hi; }

namespace pg8 {
constexpr int BM = 256, BK = 64, HALF = 128, HTB = HALF * BK * 2, NXCD = 8, WGM = 8;
__host__ __device__ __forceinline__ int lds_byte(int r, int c) { const int st = (r >> 4) * 2 + (c >> 5), rr = r & 15, cc = c & 31, ob = rr * 64 + cc * 2; return st * 1024 + (ob ^ (((ob >> 9) & 1) << 5)); }
__host__ __device__ __forceinline__ void stage_rc(int b, int& R, int& C) { const int st = b / 1024, sb = b % 1024, swz = sb ^ (((sb >> 9) & 1) << 5); R = (st >> 1) * 16 + swz / 64; C = (st & 1) * 32 + (swz % 64) / 2; }
__host__ __device__ __forceinline__ int perm32(int rho) { const int n = rho >> 4, i = rho & 15; return 8 * (i >> 2) + 4 * n + (i & 3); }

struct Unit { int pm, pn, e, nv, r0; const char* a; const char* b; };

struct DenseOrder {
    const char* A; const char* Bt; int K, nM, nN, nwg, G, c;
    __device__ __forceinline__ void init(const void* A_, const void* Bt_, int M_, int N_, int K_, int G_, int c_) { A = (const char*)A_; Bt = (const char*)Bt_; K = K_; nM = M_ / BM; nN = N_ / BM; nwg = nM * nN; G = G_; c = c_; }
    __device__ __forceinline__ bool next(int i, Unit& u) const {
        const long L = (long)i * G + c; if (L >= nwg) return false;
        int wgid = (int)L; { const int q = nwg / NXCD, r = nwg % NXCD, xcd = wgid % NXCD, off = wgid / NXCD; wgid = (xcd < r ? xcd * (q + 1) : r * (q + 1) + (xcd - r) * q) + off; }
        const int nig = WGM * nN, gid = wgid / nig, fm = gid * WGM, gsz = (nM - fm) < WGM ? (nM - fm) : WGM;
        u.pm = fm + ((wgid % nig) % gsz); u.pn = (wgid % nig) / gsz; u.e = 0; u.nv = BM; u.r0 = 0;
        u.a = A + (size_t)u.pm * BM * K * 2; u.b = Bt + (size_t)u.pn * BM * K * 2; return true;
    }
    __device__ __forceinline__ void rows(const Unit&, const int (&R)[2], const int (&C)[2], unsigned (&ra)[2][2]) const {
#pragma unroll
        for (int h = 0; h < 2; ++h)
#pragma unroll
            for (int i = 0; i < 2; ++i) ra[h][i] = (unsigned)(((h * HALF + R[i]) * K + C[i]) * 2);
    }
};
template <bool GATHER> struct MoeOrder {
    const char* A; const char* Bt; size_t bstride; int K, G, c; const LAS int* tp; const LAS int* cnt; const int* list;
    __device__ __forceinline__ bool next(int i, Unit& u) const {
        const int L = i * G + c; const int T = __builtin_amdgcn_readfirstlane(tp[NEXP]) * 4; if (L >= T) return false;
        const int rt = L >> 2; int e = 0;
        while (e < NEXP - 1 && __builtin_amdgcn_readfirstlane(tp[e + 1]) <= rt) ++e;
        const int lt = rt - __builtin_amdgcn_readfirstlane(tp[e]); const int rem = __builtin_amdgcn_readfirstlane(cnt[e]) - lt * BM;
        u.pm = rt; u.pn = L & 3; u.e = e; u.nv = rem < BM ? rem : BM; u.r0 = lt * BM;
        u.a = GATHER ? A : A + (size_t)rt * BM * K * 2; u.b = Bt + (size_t)e * bstride + (size_t)u.pn * BM * K * 2; return true;
    }
    __device__ __forceinline__ void rows(const Unit& u, const int (&R)[2], const int (&C)[2], unsigned (&ra)[2][2]) const {
#pragma unroll
        for (int h = 0; h < 2; ++h)
#pragma unroll
            for (int i = 0; i < 2; ++i) {
                if (GATHER) { const int lr = h * HALF + R[i]; const int tok = list[(size_t)u.e * CAP + u.r0 + (lr < u.nv ? lr : 0)]; ra[h][i] = (unsigned)((tok * K + C[i]) * 2); }
                else ra[h][i] = (unsigned)(((h * HALF + R[i]) * K + C[i]) * 2);
            }
    }
};

template <int K, class Epi, class Sched, bool GATHER, bool ALIGN_EPI>
__device__ __forceinline__ void gemm_phase(LAS unsigned char* lds, const Sched& S, const Epi& E) {
    const int tid = threadIdx.x, wid = __builtin_amdgcn_readfirstlane(tid >> 6), lane = tid & 63, wr = wid >> 2, wc = wid & 3, fr = lane & 15, fq = lane >> 4;
    constexpr int nt = K / BK;
    int R[2], C[2]; unsigned voffB[2];
#pragma unroll
    for (int i = 0; i < 2; ++i) { stage_rc(tid * 16 + i * 8192, R[i], C[i]); const int Rb = Epi::PERM ? ((R[i] & ~31) + perm32(R[i] & 31)) : R[i]; voffB[i] = (unsigned)(Rb * K + C[i]) * 2u; }
    constexpr size_t kstep = (size_t)(BK * 2);
    constexpr size_t hstepB = (size_t)HALF * K * 2;
    const unsigned ldsw = (unsigned)wid * 1024u;
    const int aoff = lds_byte(wr * 64 + fr, fq * 8), boff = lds_byte(wc * 32 + fr, fq * 8);
#define PG8_SA(b, h) (((b) * 2 + (h)) * HTB)
#define PG8_SB(b, h) ((4 + (b) * 2 + (h)) * HTB)
#define PG8_STAGE_B(bufoff, gbase) do { _Pragma("unroll") for (int _i = 0; _i < 2; ++_i) \
        __builtin_amdgcn_global_load_lds((const unsigned*)((const char*)(gbase) + voffB[_i]), (LAS unsigned*)(lds + (bufoff) + ldsw + _i * 8192), 16, 0, 0); } while (0)
#define PG8_STAGE_A(bufoff, gbase, va, h) do { _Pragma("unroll") for (int _i = 0; _i < 2; ++_i) \
        __builtin_amdgcn_global_load_lds((const unsigned*)((const char*)(gbase) + (va)[h][_i]), (LAS unsigned*)(lds + (bufoff) + ldsw + _i * 8192), 16, 0, 0); } while (0)
#define PG8_LDA(dst, b, h) do { _Pragma("unroll") for (int m = 0; m < 4; ++m) _Pragma("unroll") for (int k = 0; k < 2; ++k) dst[m][k] = *(const LAS bf16x8*)(lds + PG8_SA(b, h) + aoff + m * 2048 + k * 1024); } while (0)
#define PG8_LDB(dst, b, h) do { _Pragma("unroll") for (int n = 0; n < 2; ++n) _Pragma("unroll") for (int k = 0; k < 2; ++k) dst[n][k] = *(const LAS bf16x8*)(lds + PG8_SB(b, h) + boff + n * 2048 + k * 1024); } while (0)
#define PG8_MMA(ai, bj, At, Bt) do { __builtin_amdgcn_s_setprio(1); _Pragma("unroll") for (int m = 0; m < 4; ++m) _Pragma("unroll") for (int n = 0; n < 2; ++n) _Pragma("unroll") for (int k = 0; k < 2; ++k) \
        acc[ai][bj][m][n] = __builtin_amdgcn_mfma_f32_16x16x32_bf16(Bt[n][k], At[m][k], acc[ai][bj][m][n], 0, 0, 0); __builtin_amdgcn_s_setprio(0); } while (0)
#define PG8_WAIT_V(n) asm volatile("s_waitcnt vmcnt(" #n ")" ::: "memory")
#define PG8_WAIT_L(n) asm volatile("s_waitcnt lgkmcnt(" #n ")" ::: "memory")
#define PG8_BAR __builtin_amdgcn_s_barrier()
#define PG8_SCHED __builtin_amdgcn_sched_barrier(0)
    Unit cur, nxt; int ui = 0;
    if (!S.next(0, cur)) return;
    unsigned vAc[2][2], vAn[2][2];
    S.rows(cur, R, C, vAc);
    f32x4 acc[2][2][4][2];
#pragma unroll
    for (int a = 0; a < 2; ++a)
#pragma unroll
        for (int b = 0; b < 2; ++b)
#pragma unroll
            for (int m = 0; m < 4; ++m)
#pragma unroll
                for (int n = 0; n < 2; ++n) acc[a][b][m][n] = (f32x4){0.f, 0.f, 0.f, 0.f};
    bf16x8 At[4][2], B0[2][2], B1[2][2];
    const char* cA = cur.a; const char* cB = cur.b;
    PG8_STAGE_B(PG8_SB(0, 0), cB); PG8_STAGE_B(PG8_SB(0, 1), cB + hstepB); PG8_STAGE_A(PG8_SA(0, 0), cA, vAc, 0); PG8_STAGE_A(PG8_SA(0, 1), cA, vAc, 1);
    if (wr == 1) PG8_BAR;
    PG8_WAIT_V(2); PG8_BAR;
    PG8_STAGE_B(PG8_SB(1, 0), cB + kstep); PG8_STAGE_A(PG8_SA(1, 0), cA + kstep, vAc, 0); PG8_STAGE_B(PG8_SB(1, 1), cB + hstepB + kstep);
    PG8_WAIT_V(6); PG8_BAR;
    for (;;) {
        const bool has_next = S.next(ui + 1, nxt);
        if (GATHER) { if (has_next) S.rows(nxt, R, C, vAn); else {
#pragma unroll
            for (int h = 0; h < 2; ++h)
#pragma unroll
                for (int i = 0; i < 2; ++i) vAn[h][i] = vAc[h][i]; } }
        const char* nA = has_next ? nxt.a : cA; const char* nB = has_next ? nxt.b : cB;
        for (int t = 0; t < nt; t += 2) {
            const bool last = (t == nt - 2);
            const char* a1 = cA + (size_t)(t + 1) * kstep;
            const char* a2 = last ? nA : cA + (size_t)(t + 2) * kstep; const char* b2 = last ? nB : cB + (size_t)(t + 2) * kstep;
            const char* a3 = a2 + kstep; const char* b3 = b2 + kstep;
            unsigned va2[2][2];
#pragma unroll
            for (int h = 0; h < 2; ++h)
#pragma unroll
                for (int i = 0; i < 2; ++i) va2[h][i] = (GATHER && last) ? vAn[h][i] : vAc[h][i];
            PG8_LDB(B0, 0, 0); PG8_LDB(B1, 0, 1); PG8_SCHED; PG8_LDA(At, 0, 0); PG8_STAGE_A(PG8_SA(1, 1), a1, vAc, 1);
            PG8_WAIT_V(8); PG8_WAIT_L(0); PG8_BAR; PG8_MMA(0, 0, At, B0); PG8_MMA(0, 1, At, B1); PG8_BAR; PG8_SCHED;
            PG8_LDA(At, 0, 1); PG8_STAGE_B(PG8_SB(0, 0), b2); PG8_STAGE_B(PG8_SB(0, 1), b2 + hstepB); PG8_STAGE_A(PG8_SA(0, 0), a2, va2, 0);
            PG8_WAIT_V(8); PG8_WAIT_L(0); PG8_BAR; PG8_MMA(1, 0, At, B0); PG8_MMA(1, 1, At, B1); PG8_BAR; PG8_SCHED;
            PG8_LDB(B0, 1, 0); PG8_LDB(B1, 1, 1); PG8_SCHED; PG8_LDA(At, 1, 0); PG8_STAGE_A(PG8_SA(0, 1), a2, va2, 1);
            PG8_WAIT_V(8); PG8_WAIT_L(0); PG8_BAR; PG8_MMA(0, 0, At, B0); PG8_MMA(0, 1, At, B1); PG8_BAR; PG8_SCHED;
            PG8_LDA(At, 1, 1); PG8_STAGE_B(PG8_SB(1, 0), b3); PG8_STAGE_B(PG8_SB(1, 1), b3 + hstepB); PG8_STAGE_A(PG8_SA(1, 0), a3, va2, 0);
            PG8_WAIT_V(8); PG8_WAIT_L(0); PG8_BAR; PG8_MMA(1, 0, At, B0); PG8_MMA(1, 1, At, B1); PG8_BAR; PG8_SCHED;
        }
        if constexpr (ALIGN_EPI) { if (wr == 0) PG8_BAR; }
        E(acc, cur, wr, wc, fr, fq);
        if (!has_next) break;
#pragma unroll
        for (int a = 0; a < 2; ++a)
#pragma unroll
            for (int b = 0; b < 2; ++b)
#pragma unroll
                for (int m = 0; m < 4; ++m)
#pragma unroll
                    for (int n = 0; n < 2; ++n) acc[a][b][m][n] = (f32x4){0.f, 0.f, 0.f, 0.f};
        cur = nxt; cA = nA; cB = nB; ++ui;
        if (GATHER) {
#pragma unroll
            for (int h = 0; h < 2; ++h)
#pragma unroll
                for (int i = 0; i < 2; ++i) vAc[h][i] = vAn[h][i]; }
        if constexpr (ALIGN_EPI) { if (wr == 1) PG8_BAR; }
    }
    PG8_WAIT_V(0);
    if constexpr (!ALIGN_EPI) { if (wr == 0) PG8_BAR; }
    PG8_BAR;
#undef PG8_SA
#undef PG8_SB
#undef PG8_STAGE_A
#undef PG8_STAGE_B
#undef PG8_LDA
#undef PG8_LDB
#undef PG8_MMA
#undef PG8_WAIT_V
#undef PG8_WAIT_L
#undef PG8_BAR
#undef PG8_SCHED
}

__device__ __forceinline__ unsigned cvt_pk_bf16(float lo, float hi) { unsigned r; asm volatile("v_cvt_pk_bf16_f32 %0, %1, %2" : "=v"(r) : "v"(lo), "v"(hi)); return r; }
__device__ __forceinline__ u32x4 pack8(const f32x4& v0, const f32x4& v1) { u32x4 w; w.x = cvt_pk_bf16(v0[0], v0[1]); w.y = cvt_pk_bf16(v0[2], v0[3]); w.z = cvt_pk_bf16(v1[0], v1[1]); w.w = cvt_pk_bf16(v1[2], v1[3]); return w; }
__device__ __forceinline__ void unpack8(const u32x4& w, f32x4& v0, f32x4& v1) { v0 = (f32x4){bflo(w.x), bfhi(w.x), bflo(w.y), bfhi(w.y)}; v1 = (f32x4){bflo(w.z), bfhi(w.z), bflo(w.w), bfhi(w.w)}; }
__device__ __forceinline__ u32x4 ld16_sc1(const void* p) { u32x4 v; asm volatile("global_load_dwordx4 %0, %1, off sc1\n\ts_waitcnt vmcnt(0)" : "=v"(v) : "v"(p) : "memory"); return v; }

__device__ __forceinline__ u32x4 ld16_sc1_nw(const void* p) { u32x4 v; asm volatile("global_load_dwordx4 %0, %1, off sc1" : "=v"(v) : "v"(p) : "memory"); return v; }
__device__ __forceinline__ void wait8(u32x4 (&v)[4][2]) { asm volatile("s_waitcnt vmcnt(0)" : "+v"(v[0][0]), "+v"(v[0][1]), "+v"(v[1][0]), "+v"(v[1][1]), "+v"(v[2][0]), "+v"(v[2][1]), "+v"(v[3][0]), "+v"(v[3][1]) :: "memory"); }
struct EpiIn {
    static constexpr bool PERM = true;
    bf16* base; const float* rstd;
    __device__ __forceinline__ void operator()(const f32x4 (&acc)[2][2][4][2], const Unit& u, int wr, int wc, int fr, int fq) const {
        const int t = u.pn >> 2; bf16* O = base + (size_t)t * M * 1024;
        const int row0 = u.pm * BM + wr * 64 + fr, col0 = (u.pn & 3) * BM + wc * 32 + 8 * fq;
        float rs[2][4];
#pragma unroll
        for (int ai = 0; ai < 2; ++ai)
#pragma unroll
            for (int m = 0; m < 4; ++m) rs[ai][m] = rstd[row0 + ai * HALF + m * 16] * (t == 0 ? C2 : 1.0f);
#pragma unroll
        for (int ai = 0; ai < 2; ++ai)
#pragma unroll
            for (int m = 0; m < 4; ++m) { bf16* rowp = O + (size_t)(row0 + ai * HALF + m * 16) * 1024 + col0;
#pragma unroll
                for (int bj = 0; bj < 2; ++bj) { f32x4 v0 = acc[ai][bj][m][0] * rs[ai][m], v1 = acc[ai][bj][m][1] * rs[ai][m];
                    if (t == 4) {
#pragma unroll
                        for (int q = 0; q < 4; ++q) { v0[q] = gelu_tanh(v0[q]); v1[q] = gelu_tanh(v1[q]); } }
                    else if (t >= 5) {
#pragma unroll
                        for (int q = 0; q < 4; ++q) { v0[q] = sigmoidf_(v0[q]); v1[q] = sigmoidf_(v1[q]); } }
                    *(u32x4*)(rowp + bj * HALF) = pack8(v0, v1); } }
    }
};
struct EpiBf {
    static constexpr bool PERM = true;
    bf16* O; int ldc;
    __device__ __forceinline__ void operator()(const f32x4 (&acc)[2][2][4][2], const Unit& u, int wr, int wc, int fr, int fq) const {
        const int row0 = u.pm * BM + wr * 64 + fr, col0 = u.pn * BM + wc * 32 + 8 * fq;
#pragma unroll
        for (int ai = 0; ai < 2; ++ai)
#pragma unroll
            for (int m = 0; m < 4; ++m) { bf16* rowp = O + (size_t)(row0 + ai * HALF + m * 16) * ldc + col0;
#pragma unroll
                for (int bj = 0; bj < 2; ++bj) *(u32x4*)(rowp + bj * HALF) = pack8(acc[ai][bj][m][0], acc[ai][bj][m][1]); }
    }
};
template <bool FIRST> struct EpiMix {
    static constexpr bool PERM = true;
    bf16* mixed; const bf16* gate;
    __device__ __forceinline__ void operator()(const f32x4 (&acc)[2][2][4][2], const Unit& u, int wr, int wc, int fr, int fq) const {
        const int row0 = u.pm * BM + wr * 64 + fr, col0 = u.pn * BM + wc * 32 + 8 * fq;
#pragma unroll
        for (int ai = 0; ai < 2; ++ai) {
            u32x4 pw[4][2], gw[4][2];
#pragma unroll
            for (int m = 0; m < 4; ++m)
#pragma unroll
                for (int bj = 0; bj < 2; ++bj) { const size_t ro = (size_t)(row0 + ai * HALF + m * 16) * 1024 + col0 + bj * HALF; gw[m][bj] = *(const u32x4*)(gate + ro); if (!FIRST) pw[m][bj] = ld16_sc1_nw(mixed + ro); }
            if (!FIRST) wait8(pw);
#pragma unroll
            for (int m = 0; m < 4; ++m)
#pragma unroll
                for (int bj = 0; bj < 2; ++bj) { const size_t ro = (size_t)(row0 + ai * HALF + m * 16) * 1024 + col0 + bj * HALF; f32x4 g0, g1; unpack8(gw[m][bj], g0, g1);
                    f32x4 v0 = acc[ai][bj][m][0] * g0, v1 = acc[ai][bj][m][1] * g1;
                    if (!FIRST) { f32x4 p0, p1; unpack8(pw[m][bj], p0, p1); v0 += p0; v1 += p1; }
                    *(u32x4*)(mixed + ro) = pack8(v0, v1); }
        }
    }
};
struct EpiOut {
    static constexpr bool PERM = true;
    const float* x; float* out; bf16* xb;
    __device__ __forceinline__ void operator()(const f32x4 (&acc)[2][2][4][2], const Unit& u, int wr, int wc, int fr, int fq) const {
        const int row0 = u.pm * BM + wr * 64 + fr, col0 = u.pn * BM + wc * 32 + 8 * fq;
#pragma unroll
        for (int ai = 0; ai < 2; ++ai)
#pragma unroll
            for (int m = 0; m < 4; ++m) { const size_t ro = (size_t)(row0 + ai * HALF + m * 16) * 1024 + col0;
#pragma unroll
                for (int bj = 0; bj < 2; ++bj) { const f32x4 x0 = *(const f32x4*)(x + ro + bj * HALF), x1 = *(const f32x4*)(x + ro + bj * HALF + 4);
                    const f32x4 v0 = acc[ai][bj][m][0] + x0, v1 = acc[ai][bj][m][1] + x1;
                    *(f32x4*)(out + ro + bj * HALF) = v0; *(f32x4*)(out + ro + bj * HALF + 4) = v1;
                    *(u32x4*)(xb + ro + bj * HALF) = pack8(v0, v1); } }
    }
};
struct EpiGU {
    static constexpr bool PERM = true;
    bf16* hid; const int* list; const i32x4* tokinfo;
    __device__ __forceinline__ void operator()(const f32x4 (&acc)[2][2][4][2], const Unit& u, int wr, int wc, int fr, int fq) const {
        const int lr0 = wr * 64 + fr, col0 = u.pn * HALF + wc * 32 + 8 * fq;
#pragma unroll
        for (int ai = 0; ai < 2; ++ai)
#pragma unroll
            for (int m = 0; m < 4; ++m) { const int lr = lr0 + ai * HALF + m * 16; const bool valid = lr < u.nv;
                const int tok = list[(size_t)u.e * CAP + u.r0 + (valid ? lr : 0)];
                const i32x4 t0 = tokinfo[tok * 2], t1 = tokinfo[tok * 2 + 1];
                const float cw = (t0.x == u.e) ? __int_as_float(t1.x) : __int_as_float(t1.y), rs = __int_as_float(t1.z);
                f32x4 h0, h1;
#pragma unroll
                for (int q = 0; q < 4; ++q) { const float g0 = acc[ai][0][m][0][q] * rs, u0 = acc[ai][1][m][0][q] * rs, g1 = acc[ai][0][m][1][q] * rs, u1 = acc[ai][1][m][1][q] * rs;
                    h0[q] = cw * g0 * sigmoidf_(g0) * u0; h1[q] = cw * g1 * sigmoidf_(g1) * u1; }
                if (valid) *(u32x4*)(hid + (size_t)(u.pm * BM + lr) * FF + col0) = pack8(h0, h1); }
    }
};
struct EpiPle {
    static constexpr bool PERM = true;
    float* out; const bf16* proj; const float* rstd;
    __device__ __forceinline__ void operator()(const f32x4 (&acc)[2][2][4][2], const Unit& u, int wr, int wc, int fr, int fq) const {
        const int row0 = u.pm * BM + wr * 64 + fr, col0 = u.pn * BM + wc * 32 + 8 * fq;
#pragma unroll
        for (int ai = 0; ai < 2; ++ai) {
            u32x4 pw[4][2]; float rs[4];
#pragma unroll
            for (int m = 0; m < 4; ++m) { rs[m] = rstd[row0 + ai * HALF + m * 16];
#pragma unroll
                for (int bj = 0; bj < 2; ++bj) pw[m][bj] = ld16_sc1_nw(proj + (size_t)(row0 + ai * HALF + m * 16) * 1024 + col0 + bj * HALF); }
            wait8(pw);
#pragma unroll
            for (int m = 0; m < 4; ++m)
#pragma unroll
                for (int bj = 0; bj < 2; ++bj) { const size_t ro = (size_t)(row0 + ai * HALF + m * 16) * 1024 + col0 + bj * HALF; f32x4 p0, p1; unpack8(pw[m][bj], p0, p1);
                    const f32x4 x0 = *(const f32x4*)(out + ro), x1 = *(const f32x4*)(out + ro + 4);
                    f32x4 v0, v1;
#pragma unroll
                    for (int q = 0; q < 4; ++q) { v0[q] = x0[q] + sigmoidf_(acc[ai][bj][m][0][q] * rs[m]) * p0[q]; v1[q] = x1[q] + sigmoidf_(acc[ai][bj][m][1][q] * rs[m]) * p1[q]; }
                    *(f32x4*)(out + ro) = v0; *(f32x4*)(out + ro + 4) = v1; }
        }
    }
};
}

namespace attn2 {
typedef short s16x4 __attribute__((ext_vector_type(4)));
typedef short v4i16_t __attribute__((ext_vector_type(4)));
typedef LAS const unsigned char* lds_cptr;
constexpr int DM = 1024, QB = 256, KVB = 64, KSLOT = 8192, VSLOT = 16384;
constexpr int NKS = 5, NVS = 4;
constexpr int L_K = 0, L_V = NKS * KSLOT, L_WS = L_V + NVS * VSLOT, L_Q = L_WS + 2048, L_END = L_Q + 8 * 4096, L_OST = 0, OSTS = 272;
static_assert(8 * 32 * OSTS <= L_WS, "O staging inside the ring area");
static_assert(L_END <= CTLL_OFF, "attention LDS map");
__device__ __forceinline__ void glds16(const void* gbase  , unsigned voff  , unsigned lds_dst) { unsigned keep;
    asm volatile("s_mov_b32 %0, m0\n\ts_mov_b32 m0, %3\n\ts_nop 0\n\tglobal_load_lds_dwordx4 %1, %2\n\ts_mov_b32 m0, %0" : "=&s"(keep) : "v"(voff), "s"(gbase), "s"(lds_dst) : "memory"); }
__device__ __forceinline__ s16x4 vtr(lds_cptr p) { return __builtin_bit_cast(s16x4, __builtin_amdgcn_ds_read_tr16_b64_v4i16((LAS v4i16_t*)p)); }
__device__ __forceinline__ unsigned cvtpk(float lo, float hi) { typedef float f2 __attribute__((ext_vector_type(2))); typedef __bf16 b2 __attribute__((ext_vector_type(2))); f2 v = {lo, hi}; b2 b = __builtin_convertvector(v, b2); return __builtin_bit_cast(unsigned, b); }
__device__ __forceinline__ int lane_now() { int l; asm volatile("v_mbcnt_lo_u32_b32 %0, -1, 0\n\tv_mbcnt_hi_u32_b32 %0, -1, %0" : "=v"(l)); return l; }
#define A2_WAIT_BAR(N) asm volatile("s_waitcnt vmcnt(" #N ") lgkmcnt(0)\n\ts_barrier" ::: "memory")
#define A2_SB() __builtin_amdgcn_sched_barrier(0)

template <int THRL>
__device__ __forceinline__ void unit(long rowbase, int qb, const bf16* Qp, const bf16* Kp, const bf16* Vp, bf16* Op, LAS unsigned char* shm) {
    int tid = threadIdx.x; asm volatile("" : "+v"(tid));
    const int lane = tid & 63, r32 = lane & 31, hi = lane >> 5; const int wid = __builtin_amdgcn_readfirstlane(tid >> 6), half = wid >> 2;
    const int q0 = qb * QB, NT = (q0 + QB) / KVB;
    const bf16* Qw = Qp + (rowbase + q0 + wid * 32) * DM;
    const bf16* Kh = Kp + rowbase * DM; const bf16* Vh = Vp + rowbase * DM;
    const unsigned lds0 = (unsigned)(uintptr_t)shm;
    LAS float* wsf = (LAS float*)(shm + L_WS) + wid * 64;
    const unsigned koff = (unsigned)(lane * DM + wid * 8) * 2u;
    const unsigned voff = (unsigned)((16 * (wid & 3) + (lane >> 2)) * DM + (wid >> 2) * 32 + (lane & 3) * 8) * 2u;
    const unsigned kdst = lds0 + L_K + wid * 1024, vdst = lds0 + L_V + wid * 1024;
#define DMA_K(t, slot) glds16((const char*)Kh + (size_t)(t) * (KVB * DM * 2), koff, (unsigned)__builtin_amdgcn_readfirstlane(kdst + (slot)))
#define DMA_V(t, slot) do { glds16((const char*)Vh + (size_t)(t) * (KVB * DM * 2), voff, (unsigned)__builtin_amdgcn_readfirstlane(vdst + (slot))); glds16((const char*)Vh + (size_t)(t) * (KVB * DM * 2) + 128, voff, (unsigned)__builtin_amdgcn_readfirstlane(vdst + (slot) + 8192)); } while (0)
    const lds_cptr kp0 = shm + L_K + hi * 1024 + r32 * 16;
    const lds_cptr vp0 = shm + L_V + ((lane >> 4) & 1) * 32 + (lane & 3) * 8 + (4 * hi + ((lane & 15) >> 2)) * 64;
    DMA_K(0, 0); DMA_K(1, KSLOT); DMA_K(2, 2 * KSLOT); DMA_K(3, 3 * KSLOT); if (NT > 4) DMA_K(4, 4 * KSLOT); DMA_V(0, 0); DMA_V(1, VSLOT);
    const LAS unsigned char* qst = shm + L_Q + wid * 4096 + hi * 512 + r32 * 16;
    {
#pragma unroll
        for (int d0 = 0; d0 < 4; ++d0) { const bf16x8 q_ = *reinterpret_cast<const bf16x8*>(&Qw[(long)r32 * DM + d0 * 16 + hi * 8]); *(LAS bf16x8*)(shm + L_Q + wid * 4096 + hi * 512 + r32 * 16 + d0 * 1024) = q_; }
    }
    float mhat = 0.f, l_reg = 0.f; float zz_; asm volatile("v_mov_b32 %0, 0" : "=v"(zz_));
    f32x16 o[4];
#pragma unroll
    for (int r = 0; r < 16; ++r) { o[0][r] = zz_; o[1][r] = zz_; o[2][r] = zz_; o[3][r] = zz_; }
    f32x16 SA0, SA1, SB0, SB1; u32x4 PA[4], PB[4];
    bool resc = false;
    int ku = 0, vu = 2 * VSLOT;
#define QKT(S0, S1, kslot) do { const lds_cptr kb_ = kp0 + (kslot); \
        _Pragma("unroll") for (int d0 = 0; d0 < 4; ++d0) { const bf16x8 a0_ = *(const LAS bf16x8*)(kb_ + d0 * 2048), a1_ = *(const LAS bf16x8*)(kb_ + d0 * 2048 + 512), q_ = *(const LAS bf16x8*)(qst + d0 * 1024); \
            if (d0 == 0) { S0 = __builtin_amdgcn_mfma_f32_32x32x16_bf16(a0_, q_, (f32x16){}, 0, 0, 0); S1 = __builtin_amdgcn_mfma_f32_32x32x16_bf16(a1_, q_, (f32x16){}, 0, 0, 0); } \
            else { S0 = __builtin_amdgcn_mfma_f32_32x32x16_bf16(a0_, q_, S0, 0, 0, 0); S1 = __builtin_amdgcn_mfma_f32_32x32x16_bf16(a1_, q_, S1, 0, 0, 0); } } } while (0)
#define VFL(f) do { vl_[(f) % 3] = vtr(vb_ + ((f) & 3) * 4096 + ((f) >> 2) * 1024); vh_[(f) % 3] = vtr(vb_ + ((f) & 3) * 4096 + ((f) >> 2) * 1024 + 512); } while (0)
#define PVF(P, f) do { const bf16x8 pa_ = __builtin_bit_cast(bf16x8, P[(f) >> 2]); const bf16x8 vf_ = (bf16x8){vl_[(f) % 3][0], vl_[(f) % 3][1], vl_[(f) % 3][2], vl_[(f) % 3][3], vh_[(f) % 3][0], vh_[(f) % 3][1], vh_[(f) % 3][2], vh_[(f) % 3][3]}; \
        o[(f) & 3] = __builtin_amdgcn_mfma_f32_32x32x16_bf16(pa_, vf_, o[(f) & 3], 0, 0, 0); } while (0)
#define PVSTEP(P, f) do { PVF(P, f); if ((f) + 3 < 16) VFL((f) + 3); A2_SB(); } while (0)
#define PVALL(P) do { PVSTEP(P, 0); PVSTEP(P, 1); PVSTEP(P, 2); PVSTEP(P, 3); PVSTEP(P, 4); PVSTEP(P, 5); PVSTEP(P, 6); PVSTEP(P, 7); PVSTEP(P, 8); PVSTEP(P, 9); PVSTEP(P, 10); PVSTEP(P, 11); PVSTEP(P, 12); PVSTEP(P, 13); PVSTEP(P, 14); PVSTEP(P, 15); } while (0)
#define PVM(P, vslot) do { const lds_cptr vb_ = vp0 + (vslot); s16x4 vl_[3], vh_[3]; VFL(0); VFL(1); VFL(2); A2_SB(); PVALL(P); } while (0)
#define KQL(d0, j) do { kf_[2 * (j)] = *(const LAS bf16x8*)(kb_ + (d0) * 2048); kf_[2 * (j) + 1] = *(const LAS bf16x8*)(kb_ + (d0) * 2048 + 512); qf_[j] = *(const LAS bf16x8*)(qst + (d0) * 1024); } while (0)
#define XBLOCK(Sn0, Sn1, Pp, HAS_QK, HAS_PV) do { const lds_cptr kb_ = kp0 + ku; const lds_cptr vb_ = vp0 + vu; bf16x8 kf_[4], qf_[2]; s16x4 vl_[3], vh_[3]; \
        if (HAS_QK) { KQL(0, 0); KQL(1, 1); A2_SB(); \
            Sn0 = __builtin_amdgcn_mfma_f32_32x32x16_bf16(kf_[0], qf_[0], (f32x16){}, 0, 0, 0); Sn1 = __builtin_amdgcn_mfma_f32_32x32x16_bf16(kf_[1], qf_[0], (f32x16){}, 0, 0, 0); \
            Sn0 = __builtin_amdgcn_mfma_f32_32x32x16_bf16(kf_[2], qf_[1], Sn0, 0, 0, 0); Sn1 = __builtin_amdgcn_mfma_f32_32x32x16_bf16(kf_[3], qf_[1], Sn1, 0, 0, 0); \
            A2_SB(); KQL(2, 0); KQL(3, 1); A2_SB(); } \
        if (HAS_PV) { VFL(0); VFL(1); VFL(2); A2_SB(); } \
        if (HAS_QK) { Sn0 = __builtin_amdgcn_mfma_f32_32x32x16_bf16(kf_[0], qf_[0], Sn0, 0, 0, 0); Sn1 = __builtin_amdgcn_mfma_f32_32x32x16_bf16(kf_[1], qf_[0], Sn1, 0, 0, 0); \
            Sn0 = __builtin_amdgcn_mfma_f32_32x32x16_bf16(kf_[2], qf_[1], Sn0, 0, 0, 0); Sn1 = __builtin_amdgcn_mfma_f32_32x32x16_bf16(kf_[3], qf_[1], Sn1, 0, 0, 0); A2_SB(); } \
        if (HAS_PV) PVALL(Pp); \
    } while (0)
#define SOFTMAX(S0, S1, P, FIRST, JB) do { \
        if ((JB) >= 0) { const int ln_ = lane_now(); const int qrel_ = wid * 32 + (ln_ & 31); const int kb_ = 64 * (JB) + 4 * (ln_ >> 5); _Pragma("unroll") for (int r = 0; r < 16; ++r) { const int kv_ = kb_ + (r & 3) + 8 * (r >> 2); if (kv_ > qrel_) S0[r] = -INFINITY; if (kv_ + 32 > qrel_) S1[r] = -INFINITY; } } \
        if (!(FIRST)) { _Pragma("unroll") for (int r = 0; r < 16; ++r) { S0[r] -= mhat; S1[r] -= mhat; } } \
        float rm_; { float a_ = fmaxf(fmaxf(S0[0], S0[1]), S1[0]), b_ = fmaxf(fmaxf(S0[2], S0[3]), S1[1]); a_ = fmaxf(fmaxf(a_, S1[2]), S1[3]); \
            _Pragma("unroll") for (int r = 4; r < 16; r += 4) { a_ = fmaxf(fmaxf(a_, S0[r]), S0[r + 1]); b_ = fmaxf(fmaxf(b_, S0[r + 2]), S0[r + 3]); a_ = fmaxf(fmaxf(a_, S1[r]), S1[r + 1]); b_ = fmaxf(fmaxf(b_, S1[r + 2]), S1[r + 3]); } \
            rm_ = fmaxf(a_, b_); auto rr_ = __builtin_amdgcn_permlane32_swap(__float_as_uint(rm_), __float_as_uint(rm_), false, false); rm_ = fmaxf(__uint_as_float(rr_[0]), __uint_as_float(rr_[1])); } \
        if (FIRST) { mhat = rm_; _Pragma("unroll") for (int r = 0; r < 16; ++r) { S0[r] -= rm_; S1[r] -= rm_; } } \
        else if (__builtin_expect(__any(rm_ > (float)THRL), 0)) { const float dl_ = fmaxf(rm_, 0.f); mhat += dl_; \
            _Pragma("unroll") for (int r = 0; r < 16; ++r) { S0[r] -= dl_; S1[r] -= dl_; } \
            const float f_ = __builtin_amdgcn_exp2f(-dl_); l_reg *= f_; wsf[lane_now() & 31] = f_; resc = true; } \
        float sacc_ = 0.f; \
        _Pragma("unroll") for (int r = 0; r < 16; ++r) { S0[r] = __builtin_amdgcn_exp2f(S0[r]); S1[r] = __builtin_amdgcn_exp2f(S1[r]); } \
        _Pragma("unroll") for (int r = 0; r < 16; ++r) sacc_ += S0[r] + S1[r]; \
        l_reg += sacc_; \
        P[0] = (u32x4){cvtpk(S0[0], S0[1]), cvtpk(S0[2], S0[3]), cvtpk(S0[4], S0[5]), cvtpk(S0[6], S0[7])}; P[1] = (u32x4){cvtpk(S0[8], S0[9]), cvtpk(S0[10], S0[11]), cvtpk(S0[12], S0[13]), cvtpk(S0[14], S0[15])}; \
        P[2] = (u32x4){cvtpk(S1[0], S1[1]), cvtpk(S1[2], S1[3]), cvtpk(S1[4], S1[5]), cvtpk(S1[6], S1[7])}; P[3] = (u32x4){cvtpk(S1[8], S1[9]), cvtpk(S1[10], S1[11]), cvtpk(S1[12], S1[13]), cvtpk(S1[14], S1[15])}; \
    } while (0)
#define RESC() do { if (resc) { asm volatile("s_waitcnt lgkmcnt(0)" ::: "memory"); \
        const LAS float* wl_ = wsf + 4 * (lane_now() >> 5); _Pragma("unroll") for (int r = 0; r < 16; ++r) { const float f_ = wl_[crow16(r, 0)]; o[0][r] *= f_; o[1][r] *= f_; o[2][r] *= f_; o[3][r] *= f_; } resc = false; } } while (0)
#define INTERVAL(Sc0, Sc1, Sn0, Sn1, Pp, Pn, ii, HAS_PV, HAS_QK, FIRST, JB, GK, GV, WN) do { \
        if (GK) DMA_K((ii) + 5, kfill_); if (GV) DMA_V((ii) + 2, vfill_); \
        A2_SB(); \
        if (half) { SOFTMAX(Sc0, Sc1, Pn, FIRST, JB); A2_SB(); } \
        XBLOCK(Sn0, Sn1, Pp, HAS_QK, HAS_PV); \
        A2_SB(); \
        if (!half) { SOFTMAX(Sc0, Sc1, Pn, FIRST, JB); A2_SB(); } \
        A2_WAIT_BAR(WN); RESC(); \
    } while (0)
#define ROT() do { ku = (ku == (NKS - 1) * KSLOT) ? 0 : ku + KSLOT; vu = (vu == (NVS - 1) * VSLOT) ? 0 : vu + VSLOT; } while (0)
#define kfill_ ((ku == 0) ? (NKS - 1) * KSLOT : ku - KSLOT)
#define vfill_ ((vu == 0) ? (NVS - 1) * VSLOT : vu - VSLOT)
    asm volatile("s_waitcnt vmcnt(0)\n\ts_barrier" ::: "memory");
    QKT(SA0, SA1, 0);
    asm volatile("s_waitcnt lgkmcnt(0)\n\ts_barrier" ::: "memory");
    ku = KSLOT; vu = (NVS - 1) * VSLOT;
    { const int jb0 = (NT == 4) ? 0 : -1;
      INTERVAL(SA0, SA1, SB0, SB1, PA, PB, 0, false, true, true, jb0, (NT > 5), true, 2); ROT(); }
    int i = 1;
    if (NT > 4) {
        for (; i + 5 < NT; i += 2) {
            INTERVAL(SB0, SB1, SA0, SA1, PB, PA, i, true, true, false, -1, true, true, 6); ROT();
            INTERVAL(SA0, SA1, SB0, SB1, PA, PB, i + 1, true, true, false, -1, true, true, 6); ROT();
        }
        INTERVAL(SB0, SB1, SA0, SA1, PB, PA, i, true, true, false, -1, false, true, 5); ROT(); ++i;
        INTERVAL(SA0, SA1, SB0, SB1, PA, PB, i, true, true, false, 0, false, true, 4); ROT(); ++i;
    }
    INTERVAL(SB0, SB1, SA0, SA1, PB, PA, i, true, true, false, 1, false, true, 4); ROT(); ++i;
    INTERVAL(SA0, SA1, SB0, SB1, PA, PB, i, true, true, false, 2, false, false, 2); ROT(); ++i;
    INTERVAL(SB0, SB1, SA0, SA1, PB, PA, i, true, false, false, 3, false, false, 0); ROT();
    PVM(PA, vu);
    A2_WAIT_BAR(0);
    { auto rr = __builtin_amdgcn_permlane32_swap(__float_as_uint(l_reg), __float_as_uint(l_reg), false, false); l_reg = __uint_as_float(rr[0]) + __uint_as_float(rr[1]); }
    const int lane_q = lane_now();
    wsf[32 + (lane_q & 31)] = l_reg;
    asm volatile("s_waitcnt lgkmcnt(0)" ::: "memory");
    float rli[16];
#pragma unroll
    for (int r = 0; r < 16; ++r) rli[r] = __builtin_amdgcn_rcpf(wsf[32 + crow16(r, lane_q >> 5)]);
    { const int lane_e = lane_q;
      const int r32e = lane_e & 31, hie = lane_e >> 5;
      bf16* Ow = Op + (rowbase + q0 + wid * 32) * DM;
      LAS unsigned char* stg = shm + L_OST + wid * 32 * OSTS;
#pragma unroll
      for (int r = 0; r < 16; ++r) { const int orow = crow16(r, hie);
#pragma unroll
          for (int dq = 0; dq < 4; ++dq) *(LAS unsigned short*)(stg + orow * OSTS + (dq * 32 + r32e) * 2) = (unsigned short)f2bf(o[dq][r] * rli[r]); }
      asm volatile("s_waitcnt lgkmcnt(0)" ::: "memory");
#pragma unroll
      for (int j = 0; j < 8; ++j) { const int row = j * 4 + (lane_e >> 4), pc = lane_e & 15; const u32x4 v = *(const LAS u32x4*)(stg + row * OSTS + pc * 16); *(u32x4*)(Ow + (long)row * DM + pc * 8) = v; } }
    asm volatile("s_waitcnt lgkmcnt(0)\n\ts_barrier" ::: "memory");
#undef DMA_K
#undef DMA_V
#undef QKT
#undef VFL
#undef PVF
#undef PVSTEP
#undef PVALL
#undef KQL
#undef XBLOCK
#undef PVM
#undef SOFTMAX
#undef RESC
#undef INTERVAL
#undef ROT
#undef kfill_
#undef vfill_
}
#undef A2_WAIT_BAR
#undef A2_SB
}
#define XB_TMO      128
#define XB_XCNT(j)  (256  + 64 * (j))
#define XB_XSUB(j)  (1280 + 64 * (j))
#define XB_XGEN(j)  (2304 + 64 * (j))
#define XB_TOP      3328
#define XB_TOPGEN   3392
#define XCD_BAR_WORDS 3456
#define XB_SPIN_CAP (1u << 18)

__device__ __forceinline__ unsigned xb_ld(unsigned* p)              { return __hip_atomic_load(p, __ATOMIC_RELAXED, __HIP_MEMORY_SCOPE_AGENT); }
__device__ __forceinline__ unsigned xb_add(unsigned* p, unsigned v) { return __hip_atomic_fetch_add(p, v, __ATOMIC_RELAXED, __HIP_MEMORY_SCOPE_AGENT); }
__device__ __forceinline__ unsigned xb_xcc_id() { return (unsigned)__builtin_amdgcn_s_getreg((3 << 11) | 20) & 0xFu; }
#define XB_SPIN(cond, bar) do { unsigned _sp = 0; while (cond) { __builtin_amdgcn_s_sleep(1); \
    if ((++_sp & 255u) == 0u) { if (xb_ld(&(bar)[XB_TMO])) break; if (_sp > XB_SPIN_CAP) { atomicAdd(&(bar)[XB_TMO], 1u); break; } } } } while (0)

struct XcdBarrier {
    unsigned* bar; unsigned x;
    volatile LAS unsigned* st;
};

__device__ __forceinline__ XcdBarrier xcd_barrier_post(unsigned* bar, volatile LAS unsigned* st) {
    XcdBarrier b; b.bar = bar; b.x = xb_xcc_id(); b.st = st;
    if (threadIdx.x == 0) (void)xb_add(&bar[XB_XCNT(b.x)], 1u);
    return b;
}
__device__ __forceinline__ void xcd_barrier_complete(unsigned* bar, unsigned x, unsigned& nloc, unsigned& nx) {
    const unsigned G = gridDim.x * gridDim.y * gridDim.z;
    unsigned sum, cnt, mine, sp = 0u;
    for (;;) {
        sum = 0u; cnt = 0u; mine = 0u;
#pragma unroll
        for (unsigned j = 0; j < 16; ++j) { const unsigned c = xb_ld(&bar[XB_XCNT(j)]); sum += c; cnt += (c > 0u) ? 1u : 0u; mine = (j == x) ? c : mine; }
        if (sum == G) break;
        __builtin_amdgcn_s_sleep(1);
        if ((++sp & 255u) == 0u) { if (xb_ld(&bar[XB_TMO])) break; if (sp > XB_SPIN_CAP) { atomicAdd(&bar[XB_TMO], 1u); break; } }
    }
    nloc = mine > 0u ? mine : 1u; nx = cnt > 0u ? cnt : 1u;
}

__device__ __forceinline__ void xcd_barrier(const XcdBarrier& b) {
    asm volatile("s_waitcnt vmcnt(0)" ::: "memory");
    __syncthreads();
    if (threadIdx.x == 0) {
        unsigned* bar = b.bar;
        __builtin_amdgcn_s_waitcnt(0);
        unsigned nloc = b.st[0], nx = b.st[1];
        if (nloc == 0u) { xcd_barrier_complete(bar, b.x, nloc, nx); b.st[0] = nloc; b.st[1] = nx; }
        const unsigned old = xb_add(&bar[XB_XSUB(b.x)], 1u);
        const unsigned gen = old / nloc;
        if (old + 1u == (gen + 1u) * nloc) {
            __builtin_amdgcn_fence(__ATOMIC_RELEASE, "agent");
            asm volatile("s_waitcnt vmcnt(0)" ::: "memory");
            const unsigned og = xb_add(&bar[XB_TOP], 1u);
            const unsigned tg = og / nx;
            if (og + 1u == (tg + 1u) * nx) xb_add(&bar[XB_TOPGEN], 1u);
            else XB_SPIN(xb_ld(&bar[XB_TOPGEN]) == tg, bar);
            __builtin_amdgcn_fence(__ATOMIC_ACQUIRE, "agent");
            xb_add(&bar[XB_XGEN(b.x)], 1u);
            asm volatile("s_waitcnt vmcnt(0)" ::: "memory");
        } else {
            XB_SPIN(xb_ld(&bar[XB_XGEN(b.x)]) == gen, bar);
            __builtin_amdgcn_fence(__ATOMIC_ACQUIRE, "agent");
            asm volatile("s_waitcnt vmcnt(0)" ::: "memory");
        }
    }
    __syncthreads();
}

__device__ __forceinline__ int lane_id_v() { int l; asm volatile("v_mbcnt_lo_u32_b32 %0, -1, 0\n\tv_mbcnt_hi_u32_b32 %0, -1, %0" : "=v"(l)); return l; }
struct Ctx {
    LAS unsigned char* lds; int tid, lane, wave, vcu, G, gw, NGW;
};

struct TrDesc { const float* W; bf16* WT; const float* ksc; int K, N, kmask, mode, item; float kmul; };
struct TrRegs { f32x4 v[8]; float sc[8]; };
__device__ __forceinline__ void tr_load(const TrDesc& d, TrRegs& r, int lane) {
    const int nblk = d.N / 32, kb = d.item / nblk, nb = d.item % nblk, k0 = 64 * kb, n0 = 32 * nb;
#pragma unroll
    for (int i = 0; i < 8; ++i) { const int kk = 8 * i + (lane >> 3); r.v[i] = *(const f32x4*)(d.W + (size_t)(k0 + kk) * d.N + n0 + 4 * (lane & 7)); r.sc[i] = d.ksc ? d.ksc[(k0 + kk) & d.kmask] * d.kmul : 1.0f; }
}
__device__ __forceinline__ void tr_finish(const TrDesc& d, const TrRegs& r, LAS float* scr, int lane) {
    const int nblk = d.N / 32, kb = d.item / nblk, nb = d.item % nblk, k0 = 64 * kb, n0 = 32 * nb;
#pragma unroll
    for (int i = 0; i < 8; ++i) { const int kk = 8 * i + (lane >> 3); LAS float* p = scr + kk * 33 + 4 * (lane & 7); const f32x4 v = r.v[i] * r.sc[i]; p[0] = v.x; p[1] = v.y; p[2] = v.z; p[3] = v.w; }
    LDS_WAIT(); asm volatile("" ::: "memory");
    const int c = lane & 7;
#pragma unroll
    for (int j = 0; j < 4; ++j) { const int n = (lane >> 3) + 8 * j; const LAS float* s = scr + (8 * c) * 33 + n;
        u32x4 o; o.x = pk2(s[0 * 33], s[1 * 33]); o.y = pk2(s[2 * 33], s[3 * 33]); o.z = pk2(s[4 * 33], s[5 * 33]); o.w = pk2(s[6 * 33], s[7 * 33]);
        const int nn = n0 + n; const int dr = d.mode == 0 ? nn : ((nn >> 7) * 256 + (nn & 127) + (d.mode == 2 ? 128 : 0));
        *(GAS u32x4*)(d.WT + (size_t)dr * d.K + k0 + 8 * c) = o; }
    LDS_WAIT(); asm volatile("" ::: "memory");
}

struct Args { const float* in[31]; float* out; unsigned char* ws; int ph_lo, ph_hi; };
#define AS4 __attribute__((address_space(4)))
struct KA { const AS4 char* p;
    __device__ __forceinline__ const float* in(int i) const { return *(const float* const AS4*)(p + 8 * i); }
    __device__ __forceinline__ float* out() const { return *(float* const AS4*)(p + 8 * 31); }
    __device__ __forceinline__ unsigned char* ws() const { return *(unsigned char* const AS4*)(p + 8 * 32); }
    __device__ __forceinline__ int lo() const { return *(const int AS4*)(p + 8 * 33); }
    __device__ __forceinline__ int hi() const { return *(const int AS4*)(p + 8 * 33 + 4); }
};
__device__ __forceinline__ KA ka_get() { const AS4 char* p = (const AS4 char*)__builtin_amdgcn_kernarg_segment_ptr(); asm volatile("" : "+s"(p)); return KA{p}; }

__device__ __forceinline__ void p0_prologue(const Ctx& F, const KA& a) {
    unsigned char* ws = a.ws();
    LAS float* scr = (LAS float*)(F.lds + RING_OFF + F.wave * 16384);
    constexpr int I_IN = (D / 64) * (NIN / 32), I_SQ = (D / 64) * (D / 32), I_PP = (PLE / 64) * (D / 32);
    constexpr int NITEMS = I_IN + 4 * I_SQ + I_PP;
    auto dec0 = [&](int it, TrDesc& d) { int r = it; d.kmul = 1.0f; d.mode = 0; d.ksc = nullptr; d.kmask = 0;
        if (r < I_IN) { d.W = a.in(3); d.K = D; d.N = NIN; d.WT = (bf16*)(ws + WS_WIN); d.ksc = a.in(2); d.kmask = 1023; d.item = r; return; } r -= I_IN;
        if (r < I_SQ) { d.W = a.in(16); d.K = D; d.N = D; d.WT = (bf16*)(ws + WS_WA); d.ksc = a.in(8); d.kmask = 127; d.kmul = 1.0f - LAM_INIT; d.item = r; return; } r -= I_SQ;
        if (r < I_SQ) { d.W = a.in(17); d.K = D; d.N = D; d.WT = (bf16*)(ws + WS_WL); d.item = r; return; } r -= I_SQ;
        if (r < I_SQ) { d.W = a.in(18); d.K = D; d.N = D; d.WT = (bf16*)(ws + WS_WO); d.item = r; return; } r -= I_SQ;
        if (r < I_SQ) { d.W = a.in(28); d.K = D; d.N = D; d.WT = (bf16*)(ws + WS_WPG); d.ksc = a.in(27); d.kmask = 1023; d.item = r; return; } r -= I_SQ;
        d.W = a.in(29); d.K = PLE; d.N = D; d.WT = (bf16*)(ws + WS_WPP); d.item = r; };
    { int it = F.gw; TrDesc dc, dn; TrRegs rc, rn;
      if (it < NITEMS) { dec0(it, dc); tr_load(dc, rc, F.lane); }
      while (it < NITEMS) { const int itn = it + F.NGW; if (itn < NITEMS) { dec0(itn, dn); tr_load(dn, rn, F.lane); }
          tr_finish(dc, rc, scr, F.lane); dc = dn; rc = rn; it = itn; } }
    const int gt = F.gw * 64 + F.lane, NGT = F.NGW * 64;
    { float* Wr = (float*)(ws + WS_WR); const float* gm = a.in(19);
      for (int i = gt; i < 36 * 1024; i += NGT) { const int j = i >> 10, k = i & 1023; const float w = j < 32 ? a.in(22)[(size_t)((j >> 3) * 1024 + k) * 8 + (j & 7)] : a.in(20)[k * 4 + (j - 32)]; Wr[i] = w * gm[k]; } }
    { bf16* Wl = (bf16*)(ws + WS_WLRU);
      for (int i = gt; i < 2 * 65536; i += NGT) { const int gate = i >> 16, n = (i >> 12) & 15, v = (i >> 6) & 63, w = i & 63; const float* src = gate ? a.in(13) : a.in(11); Wl[i] = (bf16)f2bf(src[(n * 64 + w) * 64 + v]); } }
    { const float* x = a.in(0); bf16* xb = (bf16*)(ws + WS_U0); float* rstd0 = (float*)(ws + WS_RSTD0);
      for (int m0 = F.gw; m0 < M; m0 += 4 * F.NGW) { f32x4 v[4][4]; float s[4];
#pragma unroll
          for (int r = 0; r < 4; ++r) { const int m = m0 + r * F.NGW; if (m < M) { const GAS f32x4* xr = (const GAS f32x4*)(x + (size_t)m * D) + F.lane;
#pragma unroll
              for (int j = 0; j < 4; ++j) v[r][j] = xr[64 * j]; } }
#pragma unroll
          for (int r = 0; r < 4; ++r) { s[r] = 0.f;
#pragma unroll
              for (int j = 0; j < 4; ++j) s[r] += (v[r][j].x * v[r][j].x + v[r][j].y * v[r][j].y) + (v[r][j].z * v[r][j].z + v[r][j].w * v[r][j].w); }
#pragma unroll
          for (int o = 1; o < 64; o <<= 1) {
#pragma unroll
              for (int r = 0; r < 4; ++r) s[r] += __shfl_xor(s[r], o); }
#pragma unroll
          for (int r = 0; r < 4; ++r) { const int m = m0 + r * F.NGW; if (m < M) { if (F.lane == 0) rstd0[m] = 1.0f / sqrtf(s[r] * (1.0f / D) + 1e-6f);
              GAS u32x2* o8 = (GAS u32x2*)(xb + (size_t)m * D) + F.lane;
#pragma unroll
              for (int j = 0; j < 4; ++j) o8[64 * j] = (u32x2){pk2(v[r][j].x, v[r][j].y), pk2(v[r][j].z, v[r][j].w)}; } } } }
    { const f32x4* p4 = (const f32x4*)a.in(1); u32x2* pb = (u32x2*)(ws + WS_PB);
      for (int i = gt; i < M * PLE / 4; i += NGT) { const f32x4 v = p4[i]; pb[i] = (u32x2){pk2(v.x, v.y), pk2(v.z, v.w)}; } }
}

template <bool FINAL>
__device__ __forceinline__ void lru_pass(const Ctx& F, const bf16* xr, bf16* gl, float* summ, const bf16* Wlru, const float* w_conv, const float* b_conv, const float* b_rg, const float* b_ig, const float* lam) {
    const int tid = F.tid, lane = F.lane, wave = F.wave, r32 = lane & 31, hi = lane >> 5;
    constexpr int XRS = 144;
    LAS unsigned char* XR = F.lds; LAS unsigned char* XC = F.lds + 37376; LAS unsigned char* GR = F.lds + 74240;
    LAS float* WS = (LAS float*)(F.lds + 111104); LAS float* WCV = (LAS float*)(F.lds + 115200); LAS unsigned char* WG = F.lds + 116480;
    for (int uu = F.vcu; uu < 256; uu += F.G) {
        const int bn = uu >> 3, b = bn >> 4, n = bn & 15, c0 = (uu & 7) * 4;
        const size_t rowb = (size_t)b * SEQ;
        __syncthreads();
        if (tid < 320) { const int j = tid >> 6, c = tid & 63; WCV[tid] = (j < 4) ? w_conv[j * 1024 + 64 * n + c] : b_conv[64 * n + c]; }
        for (int idx = tid; idx < 2 * 64 * 8; idx += 512) { const int gate = idx >> 9, v = (idx >> 3) & 63, pc = idx & 7;
            *(LAS u32x4*)(WG + (gate * 64 + v) * XRS + pc * 16) = *(const u32x4*)(Wlru + ((size_t)(gate * 16 + n) * 64 + v) * 64 + pc * 8); }
        float brg[2], big[2], cdec[2], hc[2], Arun[2];
#pragma unroll
        for (int hf = 0; hf < 2; ++hf) { const int oc = 64 * n + 32 * hf + r32; brg[hf] = b_rg[oc]; big[hf] = b_ig[oc]; cdec[hf] = -8.0f * log1pf(expf(-lam[oc])) * 1.4426950408889634f; hc[hf] = 0.f; Arun[hf] = 1.f;
            if (FINAL) for (int u2 = uu & ~7; u2 < uu; ++u2) { const float A = summ[(u2 * 64 + 32 * hf + r32) * 2], B = summ[(u2 * 64 + 32 * hf + r32) * 2 + 1]; hc[hf] = A * hc[hf] + B; } }
        u32x4 st[5];
#pragma unroll
        for (int k = 0; k < 5; ++k) { const int idx = tid + 512 * k, row = idx >> 3, pc = idx & 7, t = c0 * 256 - 3 + row; st[k] = (u32x4){0u, 0u, 0u, 0u};
            if (idx < 259 * 8 && t >= 0) st[k] = *(const u32x4*)(xr + (rowb + t) * 1024 + 64 * n + 8 * pc); }
        for (int ci = 0; ci < 4; ++ci) {
            const int t0 = (c0 + ci) * 256;
#pragma unroll
            for (int k = 0; k < 5; ++k) { const int idx = tid + 512 * k, row = idx >> 3, pc = idx & 7; if (idx < 259 * 8) *(LAS u32x4*)(XR + row * XRS + pc * 16) = st[k]; }
            bf16* gw_ = gl + (rowb + t0 + 32 * wave) * 1024 + 64 * n;
            LAS unsigned char* GRw = GR + 32 * wave * XRS;
            if (FINAL) {
#pragma unroll
                for (int i = 0; i < 4; ++i) { const int row = (lane >> 3) + 8 * i, pc = lane & 7; *(LAS u32x4*)(GRw + row * XRS + pc * 16) = *(const u32x4*)(gw_ + (size_t)row * 1024 + 8 * pc); } }
            __syncthreads();
            if (ci < 3) {
#pragma unroll
                for (int k = 0; k < 5; ++k) { const int idx = tid + 512 * k, row = idx >> 3, pc = idx & 7, t = t0 + 256 - 3 + row;
                    if (idx < 259 * 8) st[k] = *(const u32x4*)(xr + (rowb + t) * 1024 + 64 * n + 8 * pc); } }
            const int trow = 32 * wave + r32;
            bf16x8 av8[4];
#pragma unroll
            for (int ks = 0; ks < 4; ++ks) { const int c8 = 16 * ks + 8 * hi;
                f32x4 x0 = *(const LAS f32x4*)(WCV + 256 + c8), x1 = *(const LAS f32x4*)(WCV + 256 + c8 + 4);
#pragma unroll
                for (int j = 0; j < 4; ++j) { const u32x4 xv = *(const LAS u32x4*)(XR + (trow + j) * XRS + c8 * 2);
                    const f32x4 w0 = *(const LAS f32x4*)(WCV + j * 64 + c8), w1 = *(const LAS f32x4*)(WCV + j * 64 + c8 + 4);
                    x0 += w0 * (f32x4){bflo(xv.x), bfhi(xv.x), bflo(xv.y), bfhi(xv.y)}; x1 += w1 * (f32x4){bflo(xv.z), bfhi(xv.z), bflo(xv.w), bfhi(xv.w)}; }
                const u32x4 pk = (u32x4){pk2(x0[0], x0[1]), pk2(x0[2], x0[3]), pk2(x1[0], x1[1]), pk2(x1[2], x1[3])};
                av8[ks] = __builtin_bit_cast(bf16x8, pk);
                *(LAS u32x4*)(XC + trow * XRS + c8 * 2) = pk; }
            float av[2][16], uv[2][16], pA[2][4], pB[2][4];
#pragma unroll
            for (int hf = 0; hf < 2; ++hf) {
                f32x16 aR = {}, aI = {};
#pragma unroll
                for (int ks = 0; ks < 4; ++ks) { const bf16x8 bR = *(const LAS bf16x8*)(WG + (0 * 64 + 32 * hf + r32) * XRS + (16 * ks + 8 * hi) * 2), bI = *(const LAS bf16x8*)(WG + (1 * 64 + 32 * hf + r32) * XRS + (16 * ks + 8 * hi) * 2);
                    aR = __builtin_amdgcn_mfma_f32_32x32x16_bf16(av8[ks], bR, aR, 0, 0, 0); aI = __builtin_amdgcn_mfma_f32_32x32x16_bf16(av8[ks], bI, aI, 0, 0, 0); }
#pragma unroll
                for (int r = 0; r < 16; ++r) { const int row = 32 * wave + crow16(r, hi);
                    const float xcv = __uint_as_float((unsigned)(*(const LAS unsigned short*)(XC + row * XRS + (32 * hf + r32) * 2)) << 16);
                    const float rg = sigmoidf_(aR[r] + brg[hf]), ig = sigmoidf_(aI[r] + big[hf]);
                    const float a_ = __builtin_amdgcn_exp2f(cdec[hf] * rg); const float mult = __builtin_amdgcn_sqrtf(fmaxf(1.0f - a_ * a_, 0.f));
                    av[hf][r] = a_; uv[hf][r] = mult * ig * xcv; }
                float AW = 1.f, BW = 0.f, gA[4], gB[4];
#pragma unroll
                for (int j = 0; j < 4; ++j) { float A = 1.f, B = 0.f;
#pragma unroll
                    for (int i = 0; i < 4; ++i) { B = av[hf][4 * j + i] * B + uv[hf][4 * j + i]; A *= av[hf][4 * j + i]; }
                    gA[j] = A; gB[j] = B; pA[hf][j] = __shfl_xor(A, 32); pB[hf][j] = __shfl_xor(B, 32); }
#pragma unroll
                for (int j = 0; j < 4; ++j) { const float fA = hi ? pA[hf][j] : gA[j], fB = hi ? pB[hf][j] : gB[j], sA = hi ? gA[j] : pA[hf][j], sB = hi ? gB[j] : pB[hf][j];
                    BW = fA * BW + fB; AW *= fA; BW = sA * BW + sB; AW *= sA; }
                if (hi == 0) { WS[(wave * 64 + 32 * hf + r32) * 2] = AW; WS[(wave * 64 + 32 * hf + r32) * 2 + 1] = BW; }
            }
            __syncthreads();
#pragma unroll
            for (int hf = 0; hf < 2; ++hf) {
                float h = hc[hf], hin = hc[hf], Ar = Arun[hf];
#pragma unroll
                for (int w = 0; w < 8; ++w) { const float A = WS[(w * 64 + 32 * hf + r32) * 2], B = WS[(w * 64 + 32 * hf + r32) * 2 + 1]; h = A * h + B; Ar *= A; if (w + 1 == wave) hin = h; }
                hc[hf] = h; Arun[hf] = Ar;
                if (FINAL) {
                    h = hin;
#pragma unroll
                    for (int j = 0; j < 4; ++j) { float hh = hi ? pA[hf][j] * h + pB[hf][j] : h;
#pragma unroll
                        for (int i = 0; i < 4; ++i) { hh = av[hf][4 * j + i] * hh + uv[hf][4 * j + i]; uv[hf][4 * j + i] = hh; }
                        h = hi ? hh : pA[hf][j] * hh + pB[hf][j]; }
#pragma unroll
                    for (int r = 0; r < 16; ++r) { LAS unsigned short* g = (LAS unsigned short*)(GRw + crow16(r, hi) * XRS + (32 * hf + r32) * 2);
                        *g = (unsigned short)f2bf(uv[hf][r] * __uint_as_float((unsigned)(*g) << 16)); }
                }
            }
            if (FINAL) {
#pragma unroll
                for (int i = 0; i < 4; ++i) { const int row = (lane >> 3) + 8 * i, pc = lane & 7; *(u32x4*)(gw_ + (size_t)row * 1024 + 8 * pc) = *(const LAS u32x4*)(GRw + row * XRS + pc * 16); } }
        }
        if (!FINAL && hi == 0) {
#pragma unroll
            for (int hf = 0; hf < 2; ++hf) { summ[(uu * 64 + 32 * hf + r32) * 2] = Arun[hf]; summ[(uu * 64 + 32 * hf + r32) * 2 + 1] = hc[hf]; } }
    }
}

__device__ __forceinline__ void p4_combine(const Ctx& F, const KA& a) {
    unsigned char* ws = a.ws();
    float lam;
    { const float s1 = wave_sum(a.in(4)[F.lane] * a.in(5)[F.lane]), s2 = wave_sum(a.in(6)[F.lane] * a.in(7)[F.lane]); lam = expf(s1) - expf(s2) + LAM_INIT; }
    bf16* O1 = (bf16*)(ws + WS_U0); const bf16* O2 = (const bf16*)(ws + WS_U0 + 4 * USZ);
    for (int m0 = F.gw; m0 < M; m0 += 4 * F.NGW) {
        u32x4 aa[4][2], bb[4][2];
#pragma unroll
        for (int r = 0; r < 4; ++r) { const int m = m0 + r * F.NGW; if (m < M) { const u32x4* p1 = (const u32x4*)(O1 + (size_t)m * D) + 2 * F.lane; const u32x4* p2 = (const u32x4*)(O2 + (size_t)m * D) + 2 * F.lane;
            aa[r][0] = p1[0]; aa[r][1] = p1[1]; bb[r][0] = p2[0]; bb[r][1] = p2[1]; } }
#pragma unroll
        for (int r = 0; r < 4; ++r) { const int m = m0 + r * F.NGW; if (m < M) {
            f32x4 o[4], q[4]; pg8::unpack8(aa[r][0], o[0], o[1]); pg8::unpack8(aa[r][1], o[2], o[3]); pg8::unpack8(bb[r][0], q[0], q[1]); pg8::unpack8(bb[r][1], q[2], q[3]);
            float ss = 0.f;
#pragma unroll
            for (int j = 0; j < 4; ++j) { o[j] = o[j] - lam * q[j]; ss += (o[j].x * o[j].x + o[j].y * o[j].y) + (o[j].z * o[j].z + o[j].w * o[j].w); }
            ss += __shfl_xor(ss, 1); ss += __shfl_xor(ss, 2); ss += __shfl_xor(ss, 4);
            const float rs = 1.0f / sqrtf(ss * (1.0f / 128.0f) + 1e-5f);
            u32x4 w0, w1; w0 = (u32x4){pk2(o[0].x * rs, o[0].y * rs), pk2(o[0].z * rs, o[0].w * rs), pk2(o[1].x * rs, o[1].y * rs), pk2(o[1].z * rs, o[1].w * rs)};
            w1 = (u32x4){pk2(o[2].x * rs, o[2].y * rs), pk2(o[2].z * rs, o[2].w * rs), pk2(o[3].x * rs, o[3].y * rs), pk2(o[3].z * rs, o[3].w * rs)};
            u32x4* po = (u32x4*)(O1 + (size_t)m * D) + 2 * F.lane; po[0] = w0; po[1] = w1; } }
    }
    LAS float* scr = (LAS float*)(F.lds + RING_OFF + F.wave * 16384);
    constexpr int I_GU = (D / 64) * (FF / 32), I_DN = (FF / 64) * (D / 32);
    auto dec4 = [&](int it, TrDesc& d) { const int e = it / (2 * I_GU + I_DN); int r = it % (2 * I_GU + I_DN); d.kmul = 1.0f; d.ksc = nullptr; d.kmask = 0;
        if (r < I_GU) { d.W = a.in(24) + (size_t)e * D * FF; d.K = D; d.N = FF; d.WT = (bf16*)(ws + WS_WGU) + (size_t)e * 1024 * 1024; d.ksc = a.in(19); d.kmask = 1023; d.mode = 1; d.item = r; return; } r -= I_GU;
        if (r < I_GU) { d.W = a.in(25) + (size_t)e * D * FF; d.K = D; d.N = FF; d.WT = (bf16*)(ws + WS_WGU) + (size_t)e * 1024 * 1024; d.ksc = a.in(19); d.kmask = 1023; d.mode = 2; d.item = r; return; } r -= I_GU;
        d.W = a.in(26) + (size_t)e * FF * D; d.K = FF; d.N = D; d.WT = (bf16*)(ws + WS_WD) + (size_t)e * 1024 * 512; d.mode = 0; d.item = r; };
    { constexpr int NIT = NEXP * (2 * I_GU + I_DN); int it = F.gw; TrDesc dc, dn; TrRegs rc, rn;
      if (it < NIT) { dec4(it, dc); tr_load(dc, rc, F.lane); }
      while (it < NIT) { const int itn = it + F.NGW; if (itn < NIT) { dec4(itn, dn); tr_load(dn, rn, F.lane); }
          tr_finish(dc, rc, scr, F.lane); dc = dn; rc = rn; it = itn; } }
}

__device__ __forceinline__ void p7_router(const Ctx& F, const KA& a) {
    unsigned char* ws = a.ws();
    const float* x1 = a.out(); const float* Wr = (const float*)(ws + WS_WR);
    LAS float* WL = (LAS float*)F.lds;
    for (int i = F.tid; i < 36 * 256; i += NWAVES * 64) ((LAS f32x4*)WL)[i] = ((const f32x4*)Wr)[i];
    __syncthreads();
    int* list = (int*)(ws + WS_LIST); unsigned* cnt = (unsigned*)(ws + WS_CTL) + CW_CNT; i32x4* tokinfo = (i32x4*)(ws + WS_TOKINFO);
    const float* bg = a.in(21); const float* bfe = a.in(23);
    for (int m0 = F.gw; m0 < M; m0 += 2 * F.NGW) {
        f32x4 v[2][4]; float s[2], gl[2][4], fl[2][8]; int gi[2];
#pragma unroll
        for (int r = 0; r < 2; ++r) { const int m = (m0 + r * F.NGW < M) ? m0 + r * F.NGW : m0; const GAS f32x4* xr = (const GAS f32x4*)(x1 + (size_t)m * D) + F.lane;
#pragma unroll
            for (int j = 0; j < 4; ++j) v[r][j] = xr[64 * j]; }
#pragma unroll
        for (int r = 0; r < 2; ++r) { s[r] = 0.f;
#pragma unroll
            for (int j = 0; j < 4; ++j) s[r] += (v[r][j].x * v[r][j].x + v[r][j].y * v[r][j].y) + (v[r][j].z * v[r][j].z + v[r][j].w * v[r][j].w); }
#pragma unroll
        for (int g = 0; g < 4; ++g) { gl[0][g] = 0.f; gl[1][g] = 0.f;
#pragma unroll
            for (int j = 0; j < 4; ++j) { const f32x4 w = *(const LAS f32x4*)(WL + (32 + g) * 1024 + 4 * F.lane + 256 * j);
#pragma unroll
                for (int r = 0; r < 2; ++r) gl[r][g] += (v[r][j].x * w.x + v[r][j].y * w.y) + (v[r][j].z * w.z + v[r][j].w * w.w); } }
#pragma unroll
        for (int o = 1; o < 64; o <<= 1) {
#pragma unroll
            for (int r = 0; r < 2; ++r) { s[r] += __shfl_xor(s[r], o);
#pragma unroll
                for (int g = 0; g < 4; ++g) gl[r][g] += __shfl_xor(gl[r][g], o); } }
        float rstd[2], gwt[2];
#pragma unroll
        for (int r = 0; r < 2; ++r) { rstd[r] = 1.0f / sqrtf(s[r] * (1.0f / D) + 1e-6f);
#pragma unroll
            for (int g = 0; g < 4; ++g) gl[r][g] = gl[r][g] * rstd[r] + bg[g];
            int gg = 0; float gmax = gl[r][0];
#pragma unroll
            for (int g = 1; g < 4; ++g) if (gl[r][g] > gmax) { gmax = gl[r][g]; gg = g; }
            float gs = 0.f;
#pragma unroll
            for (int g = 0; g < 4; ++g) gs += expf(gl[r][g] - gmax);
            gwt[r] = 1.0f / gs; gi[r] = __builtin_amdgcn_readfirstlane(gg); }
#pragma unroll
        for (int r = 0; r < 2; ++r)
#pragma unroll
            for (int e = 0; e < 8; ++e) { float d = 0.f;
#pragma unroll
                for (int j = 0; j < 4; ++j) { const f32x4 w = *(const LAS f32x4*)(WL + (gi[r] * 8 + e) * 1024 + 4 * F.lane + 256 * j); d += (v[r][j].x * w.x + v[r][j].y * w.y) + (v[r][j].z * w.z + v[r][j].w * w.w); }
                fl[r][e] = d; }
#pragma unroll
        for (int o = 1; o < 64; o <<= 1) {
#pragma unroll
            for (int r = 0; r < 2; ++r)
#pragma unroll
                for (int e = 0; e < 8; ++e) fl[r][e] += __shfl_xor(fl[r][e], o); }
#pragma unroll
        for (int r = 0; r < 2; ++r) { const int m = m0 + r * F.NGW; if (m < M) {
#pragma unroll
            for (int e = 0; e < 8; ++e) fl[r][e] = fl[r][e] * rstd[r] + bfe[gi[r] * 8 + e];
            int i0 = 0; float l0 = fl[r][0];
#pragma unroll
            for (int e = 1; e < 8; ++e) if (fl[r][e] > l0) { l0 = fl[r][e]; i0 = e; }
            int i1 = -1; float l1 = -INFINITY;
#pragma unroll
            for (int e = 0; e < 8; ++e) if (e != i0 && fl[r][e] > l1) { l1 = fl[r][e]; i1 = e; }
            const float ex = expf(l1 - l0), w0 = 1.0f / (1.0f + ex), w1 = ex * w0;
            if (F.lane == 0) { const int e0 = gi[r] * 8 + i0, e1 = gi[r] * 8 + i1;
                const int p0 = (int)atomicAdd(cnt + e0, 1u), p1 = (int)atomicAdd(cnt + e1, 1u);
                list[(size_t)e0 * CAP + p0] = m; list[(size_t)e1 * CAP + p1] = m;
                tokinfo[m * 2] = (i32x4){e0, e1, p0, p1}; tokinfo[m * 2 + 1] = (i32x4){__float_as_int(gwt[r] * w0), __float_as_int(gwt[r] * w1), __float_as_int(rstd[r]), 0}; } } }
    }
}

__device__ __forceinline__ void moe_tables(const Ctx& F, const unsigned* cnt) {
    LAS int* tp = (LAS int*)(F.lds + CTLL_OFF + 64); LAS int* cn = (LAS int*)(F.lds + CTLL_OFF + 256);
    if (F.tid == 0) { int acc = 0; for (int e = 0; e < NEXP; ++e) { const int c = (int)__hip_atomic_load(cnt + e, RLX_AGENT); cn[e] = c; tp[e] = acc; acc += (c + 255) >> 8; } tp[NEXP] = acc; }
    __syncthreads();
}

__device__ __forceinline__ void p10_combine(const Ctx& F, const KA& a) {
    unsigned char* ws = a.ws();
    const LAS int* tp = (const LAS int*)(F.lds + CTLL_OFF + 64);
    const i32x4* tokinfo = (const i32x4*)(ws + WS_TOKINFO); const bf16* Y = (const bf16*)(ws + WS_Y); bf16* x2b = (bf16*)(ws + WS_U0); float* rstd2 = (float*)(ws + WS_RSTD2);
    for (int m0 = F.gw; m0 < M; m0 += 4 * F.NGW) {
        i32x4 t0[4]; f32x4 v[4][4]; u32x2 py[4][4], qy[4][4]; float s[4];
#pragma unroll
        for (int r = 0; r < 4; ++r) { const int m = m0 + r * F.NGW; if (m < M) t0[r] = tokinfo[m * 2]; }
#pragma unroll
        for (int r = 0; r < 4; ++r) { const int m = m0 + r * F.NGW; if (m < M) {
            const int s0 = tp[t0[r].x] * 256 + t0[r].z, s1 = tp[t0[r].y] * 256 + t0[r].w;
            const GAS f32x4* xr = (const GAS f32x4*)(a.out() + (size_t)m * D) + F.lane; const u32x2* y0 = (const u32x2*)(Y + (size_t)s0 * D) + F.lane; const u32x2* y1 = (const u32x2*)(Y + (size_t)s1 * D) + F.lane;
#pragma unroll
            for (int j = 0; j < 4; ++j) { v[r][j] = xr[64 * j]; py[r][j] = y0[64 * j]; qy[r][j] = y1[64 * j]; } } }
#pragma unroll
        for (int r = 0; r < 4; ++r) { s[r] = 0.f;
#pragma unroll
            for (int j = 0; j < 4; ++j) { const u32x2 p = py[r][j], q = qy[r][j];
                v[r][j].x += bflo(p.x) + bflo(q.x); v[r][j].y += bfhi(p.x) + bfhi(q.x); v[r][j].z += bflo(p.y) + bflo(q.y); v[r][j].w += bfhi(p.y) + bfhi(q.y);
                s[r] += (v[r][j].x * v[r][j].x + v[r][j].y * v[r][j].y) + (v[r][j].z * v[r][j].z + v[r][j].w * v[r][j].w); } }
#pragma unroll
        for (int o = 1; o < 64; o <<= 1) {
#pragma unroll
            for (int r = 0; r < 4; ++r) s[r] += __shfl_xor(s[r], o); }
#pragma unroll
        for (int r = 0; r < 4; ++r) { const int m = m0 + r * F.NGW; if (m < M) { if (F.lane == 0) rstd2[m] = 1.0f / sqrtf(s[r] * (1.0f / D) + 1e-6f);
            GAS f32x4* xr = (GAS f32x4*)(a.out() + (size_t)m * D) + F.lane; GAS u32x2* o8 = (GAS u32x2*)(x2b + (size_t)m * D) + F.lane;
#pragma unroll
            for (int j = 0; j < 4; ++j) { xr[64 * j] = v[r][j]; o8[64 * j] = (u32x2){pk2(v[r][j].x, v[r][j].y), pk2(v[r][j].z, v[r][j].w)}; } } }
    }
}

__device__ __forceinline__ void p12_final(const Ctx& F, const KA& a) {
    const f32x4* g4 = (const f32x4*)a.in(30);
    f32x4 g[4];
#pragma unroll
    for (int j = 0; j < 4; ++j) g[j] = g4[F.lane + 64 * j];
    for (int m0 = F.gw; m0 < M; m0 += 4 * F.NGW) { f32x4 v[4][4]; float s[4];
#pragma unroll
        for (int r = 0; r < 4; ++r) { const int m = m0 + r * F.NGW; if (m < M) { const GAS f32x4* xr = (const GAS f32x4*)(a.out() + (size_t)m * D) + F.lane;
#pragma unroll
            for (int j = 0; j < 4; ++j) v[r][j] = xr[64 * j]; } }
#pragma unroll
        for (int r = 0; r < 4; ++r) { s[r] = 0.f;
#pragma unroll
            for (int j = 0; j < 4; ++j) s[r] += (v[r][j].x * v[r][j].x + v[r][j].y * v[r][j].y) + (v[r][j].z * v[r][j].z + v[r][j].w * v[r][j].w); }
#pragma unroll
        for (int o = 1; o < 64; o <<= 1) {
#pragma unroll
            for (int r = 0; r < 4; ++r) s[r] += __shfl_xor(s[r], o); }
#pragma unroll
        for (int r = 0; r < 4; ++r) { const int m = m0 + r * F.NGW; if (m < M) { const float rs = 1.0f / sqrtf(s[r] * (1.0f / D) + 1e-6f); GAS f32x4* xr = (GAS f32x4*)(a.out() + (size_t)m * D) + F.lane;
#pragma unroll
            for (int j = 0; j < 4; ++j) xr[64 * j] = v[r][j] * rs * g[j]; } }
    }
}

#ifndef MK_N_LAUNCHES
#define MK_N_LAUNCHES 1
#endif
constexpr int NPH = 13;
constexpr int N_LAUNCHES = MK_N_LAUNCHES;

__global__ void __launch_bounds__(NWAVES * 64, 2) mega_fwd(Args args) {
    extern __shared__ __attribute__((aligned(16))) unsigned char lds[];
#define MKCTX() Ctx F; F.lds = (LAS unsigned char*)lds; F.tid = threadIdx.x; F.lane = lane_id_v(); F.wave = __builtin_amdgcn_readfirstlane(F.tid >> 6); \
    F.G = gridDim.x; { const int bx = blockIdx.x; F.vcu = (F.G % 8 == 0) ? (bx % 8) * (F.G / 8) + bx / 8 : bx; } F.gw = F.vcu * NWAVES + F.wave; F.NGW = F.G * NWAVES
    const KA ka0 = ka_get();
    unsigned char* ws = ka0.ws();
    gu32* ctl = (gu32*)(ws + WS_CTL);
    for (int u = threadIdx.x; u < (LDS_BYTES - CTLL_OFF) / 4; u += NWAVES * 64) ((LAS unsigned*)((LAS unsigned char*)lds + CTLL_OFF))[u] = 0u;
    __syncthreads();
    XcdBarrier bar; bar.bar = (unsigned*)ctl + CW_BAR; bar.x = 0; bar.st = nullptr;
    if (N_LAUNCHES == 1) bar = xcd_barrier_post((unsigned*)ctl + CW_BAR, (volatile LAS unsigned*)((LAS unsigned char*)lds + CTLL_OFF));
#define GRID_BAR() do { if (N_LAUNCHES == 1) xcd_barrier(bar); } while (0)
#define GRID_BAR2() xcd_barrier(bar)
    const int lo = ka0.lo(), hi = ka0.hi();
#define IN(k) (lo <= (k) && (k) < hi)
#define BOTH(k) (IN(k) && IN((k) + 1))
    bf16* U0 = (bf16*)(ws + WS_U0);

    if (IN(0)) { MKCTX(); p0_prologue(F, ka_get()); if (BOTH(0)) GRID_BAR(); }

    if (IN(1)) {
        pg8::DenseOrder S; S.init(ws + WS_U0, ws + WS_WIN, M, NIN, D, gridDim.x, (int)blockIdx.x);
        pg8::EpiIn E{(bf16*)(ws + WS_U0 + 1 * USZ), (const float*)(ws + WS_RSTD0)};
        pg8::gemm_phase<D, pg8::EpiIn, pg8::DenseOrder, false, true>((LAS unsigned char*)lds + RING_OFF, S, E);
        if (BOTH(1)) GRID_BAR();
    }

    if (IN(2)) {
        { MKCTX(); const KA ka = ka_get();
          lru_pass<false>(F, (const bf16*)(ws + WS_U0 + 4 * USZ), (bf16*)(ws + WS_U0 + 5 * USZ), (float*)(ws + WS_SUMM), (const bf16*)(ws + WS_WLRU), ka.in(9), ka.in(10), ka.in(12), ka.in(14), ka.in(15)); }
        GRID_BAR2();
        { MKCTX(); const KA ka = ka_get();
          lru_pass<true>(F, (const bf16*)(ws + WS_U0 + 4 * USZ), (bf16*)(ws + WS_U0 + 5 * USZ), (float*)(ws + WS_SUMM), (const bf16*)(ws + WS_WLRU), ka.in(9), ka.in(10), ka.in(12), ka.in(14), ka.in(15)); }
        if (BOTH(2)) GRID_BAR();
    }

    if (IN(3)) {
        const bf16* Q = (const bf16*)(ws + WS_U0 + 1 * USZ); const bf16* Kb = (const bf16*)(ws + WS_U0 + 2 * USZ); const bf16* Vb = (const bf16*)(ws + WS_U0 + 3 * USZ);
        bf16* O1 = (bf16*)(ws + WS_U0); bf16* O2 = (bf16*)(ws + WS_U0 + 4 * USZ);
        const int G = gridDim.x, bx = blockIdx.x, vcu = (G % 8 == 0) ? (bx % 8) * (G / 8) + bx / 8 : bx;
        for (int k = vcu; k < 1024; k += G) {
            const int v = k & 255, j = k >> 8, xc = v >> 5, jc = v & 31, bh = 4 * xc + j;
            const int rot = (jc + 16) & 31;
            const int qb = (j == 0) ? jc : (j == 1) ? 31 - jc : (j == 2) ? rot : 31 - rot;
            const int b = bh >> 4, h = (bh >> 1) & 7, c = bh & 1;
            attn2::unit<8>((long)b * SEQ, qb, Q + 128 * h + 64 * c, Kb + 128 * h + 64 * c, Vb + 128 * h, (c ? O2 : O1) + 128 * h, (LAS unsigned char*)lds);
        }
        if (BOTH(3)) GRID_BAR();
    }

    if (IN(4)) { MKCTX(); p4_combine(F, ka_get()); if (BOTH(4)) GRID_BAR(); }

    if (IN(5)) {
        bf16* mixed = (bf16*)(ws + WS_U0 + 4 * USZ);
        { pg8::DenseOrder S; S.init(ws + WS_U0, ws + WS_WA, M, D, D, gridDim.x, (int)blockIdx.x);
          pg8::EpiMix<true> E{mixed, (const bf16*)(ws + WS_U0 + 6 * USZ)};
          pg8::gemm_phase<D, pg8::EpiMix<true>, pg8::DenseOrder, false, false>((LAS unsigned char*)lds + RING_OFF, S, E); }
        { pg8::DenseOrder S; S.init(ws + WS_U0 + 5 * USZ, ws + WS_WL, M, D, D, gridDim.x, (int)blockIdx.x);
          pg8::EpiMix<false> E{mixed, (const bf16*)(ws + WS_U0 + 7 * USZ)};
          pg8::gemm_phase<D, pg8::EpiMix<false>, pg8::DenseOrder, false, false>((LAS unsigned char*)lds + RING_OFF, S, E); }
        if (BOTH(5)) GRID_BAR();
    }

    if (IN(6)) {
        pg8::DenseOrder S; S.init(ws + WS_U0 + 4 * USZ, ws + WS_WO, M, D, D, gridDim.x, (int)blockIdx.x);
        const KA ka = ka_get(); pg8::EpiOut E{ka.in(0), ka.out(), U0};
        pg8::gemm_phase<D, pg8::EpiOut, pg8::DenseOrder, false, false>((LAS unsigned char*)lds + RING_OFF, S, E);
        if (BOTH(6)) GRID_BAR();
    }

    if (IN(7)) { MKCTX(); p7_router(F, ka_get()); if (BOTH(7)) GRID_BAR(); }

    if (IN(8)) {
        { MKCTX(); moe_tables(F, (const unsigned*)ctl + CW_CNT);
        pg8::MoeOrder<true> S{(const char*)U0, (const char*)(ws + WS_WGU), (size_t)1024 * 1024 * 2, D, F.G, F.vcu, (const LAS int*)(F.lds + CTLL_OFF + 64), (const LAS int*)(F.lds + CTLL_OFF + 256), (const int*)(ws + WS_LIST)};
        pg8::EpiGU E{(bf16*)(ws + WS_HID), (const int*)(ws + WS_LIST), (const i32x4*)(ws + WS_TOKINFO)};
        pg8::gemm_phase<D, pg8::EpiGU, pg8::MoeOrder<true>, true, false>(F.lds + RING_OFF, S, E); }
        if (BOTH(8)) GRID_BAR();
    }

    if (IN(9)) {
        { MKCTX(); moe_tables(F, (const unsigned*)ctl + CW_CNT);
        pg8::MoeOrder<false> S{(const char*)(ws + WS_HID), (const char*)(ws + WS_WD), (size_t)1024 * 512 * 2, FF, F.G, F.vcu, (const LAS int*)(F.lds + CTLL_OFF + 64), (const LAS int*)(F.lds + CTLL_OFF + 256), (const int*)(ws + WS_LIST)};
        pg8::EpiBf E{(bf16*)(ws + WS_Y), D};
        pg8::gemm_phase<FF, pg8::EpiBf, pg8::MoeOrder<false>, false, false>(F.lds + RING_OFF, S, E); }
        if (BOTH(9)) GRID_BAR();
    }

    if (IN(10)) { MKCTX(); moe_tables(F, (const unsigned*)ctl + CW_CNT); p10_combine(F, ka_get()); if (BOTH(10)) GRID_BAR(); }

    if (IN(11)) {
        { pg8::DenseOrder S; S.init(ws + WS_PB, ws + WS_WPP, M, D, PLE, gridDim.x, (int)blockIdx.x);
          pg8::EpiBf E{(bf16*)(ws + WS_PROJ), D};
          pg8::gemm_phase<PLE, pg8::EpiBf, pg8::DenseOrder, false, false>((LAS unsigned char*)lds + RING_OFF, S, E); }
        { pg8::DenseOrder S; S.init(ws + WS_U0, ws + WS_WPG, M, D, D, gridDim.x, (int)blockIdx.x);
          const KA ka = ka_get(); pg8::EpiPle E{ka.out(), (const bf16*)(ws + WS_PROJ), (const float*)(ws + WS_RSTD2)};
          pg8::gemm_phase<D, pg8::EpiPle, pg8::DenseOrder, false, false>((LAS unsigned char*)lds + RING_OFF, S, E); }
        if (BOTH(11)) GRID_BAR();
    }

    if (IN(12)) { MKCTX(); p12_final(F, ka_get()); }
#undef IN
#undef BOTH
}

extern "C" void kernel_launch(void* const* d_in, const int* in_sizes, int n_in, void* d_out, int out_size, void* d_ws, size_t ws_size, hipStream_t stream) {
    static int grid = 0;
    if (grid == 0) {
        if (n_in != 31 || in_sizes[0] != M * D || out_size != M * D || ws_size < WS_END) { fprintf(stderr, "kernel_launch: unexpected shapes (n_in %d, in0 %d, out %d, ws %zu < %zu); nothing launched\n", n_in, n_in > 0 ? in_sizes[0] : -1, out_size, ws_size, (size_t)WS_END); grid = -1; return; }
        int dev = 0, cus = 0, per_cu = 0;
        if (hipGetDevice(&dev) != hipSuccess || hipDeviceGetAttribute(&cus, hipDeviceAttributeMultiprocessorCount, dev) != hipSuccess) { grid = -1; return; }
        if (hipFuncSetAttribute((const void*)mega_fwd, hipFuncAttributeMaxDynamicSharedMemorySize, LDS_BYTES) != hipSuccess) { fprintf(stderr, "kernel_launch: hipFuncSetAttribute failed\n"); grid = -1; return; }
        if (hipOccupancyMaxActiveBlocksPerMultiprocessor(&per_cu, (const void*)mega_fwd, NWAVES * 64, LDS_BYTES) != hipSuccess || per_cu < 1)
            fprintf(stderr, "kernel_launch: note: occupancy query reports %d workgroups per CU\n", per_cu);
        (void)hipGetLastError();
        grid = cus;
    }
    if (grid < 0) return;
    if (hipMemsetAsync((char*)d_ws + WS_CTL, 0, CTL_ZERO_BYTES, stream) != hipSuccess) return;
    Args a{};
    for (int i = 0; i < 31; ++i) a.in[i] = (const float*)d_in[i];
    a.out = (float*)d_out; a.ws = (unsigned char*)d_ws;
    for (int li = 0; li < N_LAUNCHES; ++li) {
        a.ph_lo = (N_LAUNCHES == 1) ? 0 : li; a.ph_hi = (N_LAUNCHES == 1) ? NPH : li + 1;
        hipLaunchKernelGGL(mega_fwd, dim3(grid), dim3(NWAVES * 64), LDS_BYTES, stream, a);
        const hipError_t le = hipPeekAtLastError();
        if (le != hipSuccess) { fprintf(stderr, "kernel_launch: launch %d failed: %s\n", li, hipGetErrorName(le)); break; }
    }
}
```

```cpp
#include <hip/hip_runtime.h>
#include <hip/hip_bf16.h>
#include <cstdio>
#include <cstdint>
#include <cmath>

#define LAS __attribute__((address_space(3)))
#define GAS __attribute__((address_space(1)))
typedef unsigned short bf16;
typedef short bf16x8 __attribute__((ext_vector_type(8)));
typedef float f32x4 __attribute__((ext_vector_type(4)));
typedef float f32x2 __attribute__((ext_vector_type(2)));
typedef float f32x16 __attribute__((ext_vector_type(16)));
typedef unsigned u32x4 __attribute__((ext_vector_type(4)));
typedef unsigned u32x2 __attribute__((ext_vector_type(2)));
typedef int i32x4 __attribute__((ext_vector_type(4)));
typedef GAS unsigned gu32;

constexpr int M = 16384, D = 1024, SEQ = 8192, NBATCH = 2, NIN = 7168, PLE = 256, NEXP = 32, FF = 512, CAP = 16384;
constexpr float C2 = 0.125f * 1.4426950408889634f;
constexpr float LAM_INIT = 0.2f;

constexpr size_t MiB = 1u << 20;
constexpr size_t WS_CTL = 0, CTL_ZERO_BYTES = 64 * 1024;
constexpr size_t WS_RSTD0 = 1 * MiB, WS_RSTD2 = 1 * MiB + 65536, WS_TOKINFO = 1 * MiB + 131072;
constexpr size_t WS_SUMM = 1 * MiB + 655360;
constexpr size_t WS_WR = 2 * MiB, WS_WLRU = 2 * MiB + 262144;
constexpr size_t WS_LIST = 4 * MiB;
constexpr size_t WS_WIN = 8 * MiB, WS_WA = 22 * MiB, WS_WL = 24 * MiB, WS_WO = 26 * MiB, WS_WPG = 28 * MiB, WS_WPP = 30 * MiB;
constexpr size_t WS_U0 = 32 * MiB, USZ = 32 * MiB;
constexpr size_t WS_WGU = WS_U0 + 1 * USZ, WS_WD = WS_U0 + 3 * USZ;
constexpr size_t WS_Y = WS_U0 + 4 * USZ;
constexpr size_t WS_HID = 246 * MiB, WS_PROJ = 246 * MiB;
constexpr size_t WS_PB = 288 * MiB, WS_END = 296 * MiB;
constexpr int CW_TMO = 0, CW_CODE = 1, CW_BAR = 1024, CW_CNT = 8192;

constexpr int RING_OFF = 0, RING_BYTES = 131072, AUX_OFF = 131072, CTLL_OFF = 147456, LDS_BYTES = 149504;
constexpr int NWAVES = 8;

#define RLX_AGENT __ATOMIC_RELAXED, __HIP_MEMORY_SCOPE_AGENT
#define LDS_WAIT() asm volatile("s_waitcnt lgkmcnt(0)" ::: "memory")
#define VM_WAIT() asm volatile("s_waitcnt vmcnt(0)" ::: "memory")
__device__ __forceinline__ unsigned f2bf(float f) { unsigned u = __builtin_bit_cast(unsigned, f); return (u + 0x7fffu + ((u >> 16) & 1u)) >> 16; }
__device__ __forceinline__ unsigned pk2(float lo, float hi) { return f2bf(lo) | (f2bf(hi) << 16); }
__device__ __forceinline__ float bflo(unsigned w) { return __uint_as_float(w << 16); }
__device__ __forceinline__ float bfhi(unsigned w) { return __uint_as_float(w & 0xffff0000u); }
__device__ __forceinline__ float sigmoidf_(float v) { return __builtin_amdgcn_rcpf(1.0f + __builtin_amdgcn_exp2f(-1.4426950408889634f * v)); }
__device__ __forceinline__ float gelu_tanh(float v) { return v * __builtin_amdgcn_rcpf(1.0f + __builtin_amdgcn_exp2f(-2.3022082f * v * (1.0f + 0.044715f * v * v))); }
__device__ __forceinline__ float wave_sum(float v) {
#pragma unroll
    for (int o = 1; o < 64; o <<= 1) v += __shfl_xor(v, o);
    return v;
}
__device__ __forceinline__ int crow16(int r, int hi) { return (r & 3) + 8 * (r >> 2) + 4 * hi; }

namespace pg8 {
constexpr int BM = 256, BK = 64, HALF = 128, HTB = HALF * BK * 2, NXCD = 8, WGM = 8;
__host__ __device__ __forceinline__ int lds_byte(int r, int c) { const int st = (r >> 4) * 2 + (c >> 5), rr = r & 15, cc = c & 31, ob = rr * 64 + cc * 2; return st * 1024 + (ob ^ (((ob >> 9) & 1) << 5)); }
__host__ __device__ __forceinline__ void stage_rc(int b, int& R, int& C) { const int st = b / 1024, sb = b % 1024, swz = sb ^ (((sb >> 9) & 1) << 5); R = (st >> 1) * 16 + swz / 64; C = (st & 1) * 32 + (swz % 64) / 2; }
__host__ __device__ __forceinline__ int perm32(int rho) { const int n = rho >> 4, i = rho & 15; return 8 * (i >> 2) + 4 * n + (i & 3); }

struct Unit { int pm, pn, e, nv, r0; const char* a; const char* b; };

struct DenseOrder {
    const char* A; const char* Bt; int K, nM, nN, nwg, G, c;
    __device__ __forceinline__ void init(const void* A_, const void* Bt_, int M_, int N_, int K_, int G_, int c_) { A = (const char*)A_; Bt = (const char*)Bt_; K = K_; nM = M_ / BM; nN = N_ / BM; nwg = nM * nN; G = G_; c = c_; }
    __device__ __forceinline__ bool next(int i, Unit& u) const {
        const long L = (long)i * G + c; if (L >= nwg) return false;
        int wgid = (int)L; { const int q = nwg / NXCD, r = nwg % NXCD, xcd = wgid % NXCD, off = wgid / NXCD; wgid = (xcd < r ? xcd * (q + 1) : r * (q + 1) + (xcd - r) * q) + off; }
        const int nig = WGM * nN, gid = wgid / nig, fm = gid * WGM, gsz = (nM - fm) < WGM ? (nM - fm) : WGM;
        u.pm = fm + ((wgid % nig) % gsz); u.pn = (wgid % nig) / gsz; u.e = 0; u.nv = BM; u.r0 = 0;
        u.a = A + (size_t)u.pm * BM * K * 2; u.b = Bt + (size_t)u.pn * BM * K * 2; return true;
    }
    __device__ __forceinline__ void rows(const Unit&, const int (&R)[2], const int (&C)[2], unsigned (&ra)[2][2]) const {
#pragma unroll
        for (int h = 0; h < 2; ++h)
#pragma unroll
            for (int i = 0; i < 2; ++i) ra[h][i] = (unsigned)(((h * HALF + R[i]) * K + C[i]) * 2);
    }
};
template <bool GATHER> struct MoeOrder {
    const char* A; const char* Bt; size_t bstride; int K, G, c; const LAS int* tp; const LAS int* cnt; const int* list;
    __device__ __forceinline__ bool next(int i, Unit& u) const {
        const int L = i * G + c; const int T = __builtin_amdgcn_readfirstlane(tp[NEXP]) * 4; if (L >= T) return false;
        const int rt = L >> 2; int e = 0;
        while (e < NEXP - 1 && __builtin_amdgcn_readfirstlane(tp[e + 1]) <= rt) ++e;
        const int lt = rt - __builtin_amdgcn_readfirstlane(tp[e]); const int rem = __builtin_amdgcn_readfirstlane(cnt[e]) - lt * BM;
        u.pm = rt; u.pn = L & 3; u.e = e; u.nv = rem < BM ? rem : BM; u.r0 = lt * BM;
        u.a = GATHER ? A : A + (size_t)rt * BM * K * 2; u.b = Bt + (size_t)e * bstride + (size_t)u.pn * BM * K * 2; return true;
    }
    __device__ __forceinline__ void rows(const Unit& u, const int (&R)[2], const int (&C)[2], unsigned (&ra)[2][2]) const {
#pragma unroll
        for (int h = 0; h < 2; ++h)
#pragma unroll
            for (int i = 0; i < 2; ++i) {
                if (GATHER) { const int lr = h * HALF + R[i]; const int tok = list[(size_t)u.e * CAP + u.r0 + (lr < u.nv ? lr : 0)]; ra[h][i] = (unsigned)((tok * K + C[i]) * 2); }
                else ra[h][i] = (unsigned)(((h * HALF + R[i]) * K + C[i]) * 2);
            }
    }
};

template <int K, class Epi, class Sched, bool GATHER, bool ALIGN_EPI>
__device__ __forceinline__ void gemm_phase(LAS unsigned char* lds, const Sched& S, const Epi& E) {
    const int tid = threadIdx.x, wid = __builtin_amdgcn_readfirstlane(tid >> 6), lane = tid & 63, wr = wid >> 2, wc = wid & 3, fr = lane & 15, fq = lane >> 4;
    constexpr int nt = K / BK;
    int R[2], C[2]; unsigned voffB[2];
#pragma unroll
    for (int i = 0; i < 2; ++i) { stage_rc(tid * 16 + i * 8192, R[i], C[i]); const int Rb = Epi::PERM ? ((R[i] & ~31) + perm32(R[i] & 31)) : R[i]; voffB[i] = (unsigned)(Rb * K + C[i]) * 2u; }
    constexpr size_t kstep = (size_t)(BK * 2);
    constexpr size_t hstepB = (size_t)HALF * K * 2;
    const unsigned ldsw = (unsigned)wid * 1024u;
    const int aoff = lds_byte(wr * 64 + fr, fq * 8), boff = lds_byte(wc * 32 + fr, fq * 8);
#define PG8_SA(b, h) (((b) * 2 + (h)) * HTB)
#define PG8_SB(b, h) ((4 + (b) * 2 + (h)) * HTB)
#define PG8_STAGE_B(bufoff, gbase) do { _Pragma("unroll") for (int _i = 0; _i < 2; ++_i) \
        __builtin_amdgcn_global_load_lds((const unsigned*)((const char*)(gbase) + voffB[_i]), (LAS unsigned*)(lds + (bufoff) + ldsw + _i * 8192), 16, 0, 0); } while (0)
#define PG8_STAGE_A(bufoff, gbase, va, h) do { _Pragma("unroll") for (int _i = 0; _i < 2; ++_i) \
        __builtin_amdgcn_global_load_lds((const unsigned*)((const char*)(gbase) + (va)[h][_i]), (LAS unsigned*)(lds + (bufoff) + ldsw + _i * 8192), 16, 0, 0); } while (0)
#define PG8_LDA(dst, b, h) do { _Pragma("unroll") for (int m = 0; m < 4; ++m) _Pragma("unroll") for (int k = 0; k < 2; ++k) dst[m][k] = *(const LAS bf16x8*)(lds + PG8_SA(b, h) + aoff + m * 2048 + k * 1024); } while (0)
#define PG8_LDB(dst, b, h) do { _Pragma("unroll") for (int n = 0; n < 2; ++n) _Pragma("unroll") for (int k = 0; k < 2; ++k) dst[n][k] = *(const LAS bf16x8*)(lds + PG8_SB(b, h) + boff + n * 2048 + k * 1024); } while (0)
#define PG8_MMA(ai, bj, At, Bt) do { __builtin_amdgcn_s_setprio(1); _Pragma("unroll") for (int m = 0; m < 4; ++m) _Pragma("unroll") for (int n = 0; n < 2; ++n) _Pragma("unroll") for (int k = 0; k < 2; ++k) \
        acc[ai][bj][m][n] = __builtin_amdgcn_mfma_f32_16x16x32_bf16(Bt[n][k], At[m][k], acc[ai][bj][m][n], 0, 0, 0); __builtin_amdgcn_s_setprio(0); } while (0)
#define PG8_WAIT_V(n) asm volatile("s_waitcnt vmcnt(" #n ")" ::: "memory")
#define PG8_WAIT_L(n) asm volatile("s_waitcnt lgkmcnt(" #n ")" ::: "memory")
#define PG8_BAR __builtin_amdgcn_s_barrier()
#define PG8_SCHED __builtin_amdgcn_sched_barrier(0)
    Unit cur, nxt; int ui = 0;
    if (!S.next(0, cur)) return;
    unsigned vAc[2][2], vAn[2][2];
    S.rows(cur, R, C, vAc);
    f32x4 acc[2][2][4][2];
#pragma unroll
    for (int a = 0; a < 2; ++a)
#pragma unroll
        for (int b = 0; b < 2; ++b)
#pragma unroll
            for (int m = 0; m < 4; ++m)
#pragma unroll
                for (int n = 0; n < 2; ++n) acc[a][b][m][n] = (f32x4){0.f, 0.f, 0.f, 0.f};
    bf16x8 At[4][2], B0[2][2], B1[2][2];
    const char* cA = cur.a; const char* cB = cur.b;
    PG8_STAGE_B(PG8_SB(0, 0), cB); PG8_STAGE_B(PG8_SB(0, 1), cB + hstepB); PG8_STAGE_A(PG8_SA(0, 0), cA, vAc, 0); PG8_STAGE_A(PG8_SA(0, 1), cA, vAc, 1);
    if (wr == 1) PG8_BAR;
    PG8_WAIT_V(2); PG8_BAR;
    PG8_STAGE_B(PG8_SB(1, 0), cB + kstep); PG8_STAGE_A(PG8_SA(1, 0), cA + kstep, vAc, 0); PG8_STAGE_B(PG8_SB(1, 1), cB + hstepB + kstep);
    PG8_WAIT_V(6); PG8_BAR;
    for (;;) {
        const bool has_next = S.next(ui + 1, nxt);
        if (GATHER) { if (has_next) S.rows(nxt, R, C, vAn); else {
#pragma unroll
            for (int h = 0; h < 2; ++h)
#pragma unroll
                for (int i = 0; i < 2; ++i) vAn[h][i] = vAc[h][i]; } }
        const char* nA = has_next ? nxt.a : cA; const char* nB = has_next ? nxt.b : cB;
        for (int t = 0; t < nt; t += 2) {
            const bool last = (t == nt - 2);
            const char* a1 = cA + (size_t)(t + 1) * kstep;
            const char* a2 = last ? nA : cA + (size_t)(t + 2) * kstep; const char* b2 = last ? nB : cB + (size_t)(t + 2) * kstep;
            const char* a3 = a2 + kstep; const char* b3 = b2 + kstep;
            unsigned va2[2][2];
#pragma unroll
            for (int h = 0; h < 2; ++h)
#pragma unroll
                for (int i = 0; i < 2; ++i) va2[h][i] = (GATHER && last) ? vAn[h][i] : vAc[h][i];
            PG8_LDB(B0, 0, 0); PG8_LDB(B1, 0, 1); PG8_SCHED; PG8_LDA(At, 0, 0); PG8_STAGE_A(PG8_SA(1, 1), a1, vAc, 1);
            PG8_WAIT_V(8); PG8_WAIT_L(0); PG8_BAR; PG8_MMA(0, 0, At, B0); PG8_MMA(0, 1, At, B1); PG8_BAR; PG8_SCHED;
            PG8_LDA(At, 0, 1); PG8_STAGE_B(PG8_SB(0, 0), b2); PG8_STAGE_B(PG8_SB(0, 1), b2 + hstepB); PG8_STAGE_A(PG8_SA(0, 0), a2, va2, 0);
            PG8_WAIT_V(8); PG8_WAIT_L(0); PG8_BAR; PG8_MMA(1, 0, At, B0); PG8_MMA(1, 1, At, B1); PG8_BAR; PG8_SCHED;
            PG8_LDB(B0, 1, 0); PG8_LDB(B1, 1, 1); PG8_SCHED; PG8_LDA(At, 1, 0); PG8_STAGE_A(PG8_SA(0, 1), a2, va2, 1);
            PG8_WAIT_V(8); PG8_WAIT_L(0); PG8_BAR; PG8_MMA(0, 0, At, B0); PG8_MMA(0, 1, At, B1); PG8_BAR; PG8_SCHED;
            PG8_LDA(At, 1, 1); PG8_STAGE_B(PG8_SB(1, 0), b3); PG8_STAGE_B(PG8_SB(1, 1), b3 + hstepB); PG8_STAGE_A(PG8_SA(1, 0), a3, va2, 0);
            PG8_WAIT_V(8); PG8_WAIT_L(0); PG8_BAR; PG8_MMA(1, 0, At, B0); PG8_MMA(1, 1, At, B1); PG8_BAR; PG8_SCHED;
        }
        if constexpr (ALIGN_EPI) { if (wr == 0) PG8_BAR; }
        E(acc, cur, wr, wc, fr, fq);
        if (!has_next) break;
#pragma unroll
        for (int a = 0; a < 2; ++a)
#pragma unroll
            for (int b = 0; b < 2; ++b)
#pragma unroll
                for (int m = 0; m < 4; ++m)
#pragma unroll
                    for (int n = 0; n < 2; ++n) acc[a][b][m][n] = (f32x4){0.f, 0.f, 0.f, 0.f};
        cur = nxt; cA = nA; cB = nB; ++ui;
        if (GATHER) {
#pragma unroll
            for (int h = 0; h < 2; ++h)
#pragma unroll
                for (int i = 0; i < 2; ++i) vAc[h][i] = vAn[h][i]; }
        if constexpr (ALIGN_EPI) { if (wr == 1) PG8_BAR; }
    }
    PG8_WAIT_V(0);
    if constexpr (!ALIGN_EPI) { if (wr == 0) PG8_BAR; }
    PG8_BAR;
#undef PG8_SA
#undef PG8_SB
#undef PG8_STAGE_A
#undef PG8_STAGE_B
#undef PG8_LDA
#undef PG8_LDB
#undef PG8_MMA
#undef PG8_WAIT_V
#undef PG8_WAIT_L
#undef PG8_BAR
#undef PG8_SCHED
}

__device__ __forceinline__ unsigned cvt_pk_bf16(float lo, float hi) { unsigned r; asm volatile("v_cvt_pk_bf16_f32 %0, %1, %2" : "=v"(r) : "v"(lo), "v"(hi)); return r; }
__device__ __forceinline__ u32x4 pack8(const f32x4& v0, const f32x4& v1) { u32x4 w; w.x = cvt_pk_bf16(v0[0], v0[1]); w.y = cvt_pk_bf16(v0[2], v0[3]); w.z = cvt_pk_bf16(v1[0], v1[1]); w.w = cvt_pk_bf16(v1[2], v1[3]); return w; }
__device__ __forceinline__ void unpack8(const u32x4& w, f32x4& v0, f32x4& v1) { v0 = (f32x4){bflo(w.x), bfhi(w.x), bflo(w.y), bfhi(w.y)}; v1 = (f32x4){bflo(w.z), bfhi(w.z), bflo(w.w), bfhi(w.w)}; }
__device__ __forceinline__ u32x4 ld16_sc1(const void* p) { u32x4 v; asm volatile("global_load_dwordx4 %0, %1, off sc1\n\ts_waitcnt vmcnt(0)" : "=v"(v) : "v"(p) : "memory"); return v; }

__device__ __forceinline__ u32x4 ld16_sc1_nw(const void* p) { u32x4 v; asm volatile("global_load_dwordx4 %0, %1, off sc1" : "=v"(v) : "v"(p) : "memory"); return v; }
__device__ __forceinline__ void wait8(u32x4 (&v)[4][2]) { asm volatile("s_waitcnt vmcnt(0)" : "+v"(v[0][0]), "+v"(v[0][1]), "+v"(v[1][0]), "+v"(v[1][1]), "+v"(v[2][0]), "+v"(v[2][1]), "+v"(v[3][0]), "+v"(v[3][1]) :: "memory"); }
struct EpiIn {
    static constexpr bool PERM = true;
    bf16* base; const float* rstd;
    __device__ __forceinline__ void operator()(const f32x4 (&acc)[2][2][4][2], const Unit& u, int wr, int wc, int fr, int fq) const {
        const int t = u.pn >> 2; bf16* O = base + (size_t)t * M * 1024;
        const int row0 = u.pm * BM + wr * 64 + fr, col0 = (u.pn & 3) * BM + wc * 32 + 8 * fq;
        float rs[2][4];
#pragma unroll
        for (int ai = 0; ai < 2; ++ai)
#pragma unroll
            for (int m = 0; m < 4; ++m) rs[ai][m] = rstd[row0 + ai * HALF + m * 16] * (t == 0 ? C2 : 1.0f);
#pragma unroll
        for (int ai = 0; ai < 2; ++ai)
#pragma unroll
            for (int m = 0; m < 4; ++m) { bf16* rowp = O + (size_t)(row0 + ai * HALF + m * 16) * 1024 + col0;
#pragma unroll
                for (int bj = 0; bj < 2; ++bj) { f32x4 v0 = acc[ai][bj][m][0] * rs[ai][m], v1 = acc[ai][bj][m][1] * rs[ai][m];
                    if (t == 4) {
#pragma unroll
                        for (int q = 0; q < 4; ++q) { v0[q] = gelu_tanh(v0[q]); v1[q] = gelu_tanh(v1[q]); } }
                    else if (t >= 5) {
#pragma unroll
                        for (int q = 0; q < 4; ++q) { v0[q] = sigmoidf_(v0[q]); v1[q] = sigmoidf_(v1[q]); } }
                    const u32x4 pk_ = pack8(v0, v1);
                    if (t == 1 || t == 2) {
                        const int row = row0 + ai * HALF + m * 16, b_ = row >> 13, s_ = row & 8191, tile = s_ >> 6, key = s_ & 63, cc = col0 + bj * HALF;
                        size_t off;
                        if (t == 1) off = ((size_t)((b_ * 16 + (cc >> 6)) * 128 + tile)) * 8192 + ((cc & 63) >> 3) * 1024 + key * 16;
                        else off = ((size_t)((b_ * 8 + (cc >> 7)) * 128 + tile)) * 16384 + ((cc & 127) >> 5) * 4096 + key * 64 + ((cc & 31) >> 3) * 16;
                        *(u32x4*)((char*)O + off) = pk_;
                    } else *(u32x4*)(rowp + bj * HALF) = pk_; } }
    }
};
struct EpiBf {
    static constexpr bool PERM = true;
    bf16* O; int ldc;
    __device__ __forceinline__ void operator()(const f32x4 (&acc)[2][2][4][2], const Unit& u, int wr, int wc, int fr, int fq) const {
        const int row0 = u.pm * BM + wr * 64 + fr, col0 = u.pn * BM + wc * 32 + 8 * fq;
#pragma unroll
        for (int ai = 0; ai < 2; ++ai)
#pragma unroll
            for (int m = 0; m < 4; ++m) { bf16* rowp = O + (size_t)(row0 + ai * HALF + m * 16) * ldc + col0;
#pragma unroll
                for (int bj = 0; bj < 2; ++bj) *(u32x4*)(rowp + bj * HALF) = pack8(acc[ai][bj][m][0], acc[ai][bj][m][1]); }
    }
};
template <bool FIRST> struct EpiMix {
    static constexpr bool PERM = true;
    bf16* mixed; const bf16* gate;
    __device__ __forceinline__ void operator()(const f32x4 (&acc)[2][2][4][2], const Unit& u, int wr, int wc, int fr, int fq) const {
        const int row0 = u.pm * BM + wr * 64 + fr, col0 = u.pn * BM + wc * 32 + 8 * fq;
#pragma unroll
        for (int ai = 0; ai < 2; ++ai) {
            u32x4 pw[4][2], gw[4][2];
#pragma unroll
            for (int m = 0; m < 4; ++m)
#pragma unroll
                for (int bj = 0; bj < 2; ++bj) { const size_t ro = (size_t)(row0 + ai * HALF + m * 16) * 1024 + col0 + bj * HALF; gw[m][bj] = *(const u32x4*)(gate + ro); if (!FIRST) pw[m][bj] = ld16_sc1_nw(mixed + ro); }
            if (!FIRST) wait8(pw);
#pragma unroll
            for (int m = 0; m < 4; ++m)
#pragma unroll
                for (int bj = 0; bj < 2; ++bj) { const size_t ro = (size_t)(row0 + ai * HALF + m * 16) * 1024 + col0 + bj * HALF; f32x4 g0, g1; unpack8(gw[m][bj], g0, g1);
                    f32x4 v0 = acc[ai][bj][m][0] * g0, v1 = acc[ai][bj][m][1] * g1;
                    if (!FIRST) { f32x4 p0, p1; unpack8(pw[m][bj], p0, p1); v0 += p0; v1 += p1; }
                    *(u32x4*)(mixed + ro) = pack8(v0, v1); }
        }
    }
};
struct EpiOut {
    static constexpr bool PERM = true;
    const float* x; float* out; bf16* xb;
    __device__ __forceinline__ void operator()(const f32x4 (&acc)[2][2][4][2], const Unit& u, int wr, int wc, int fr, int fq) const {
        const int row0 = u.pm * BM + wr * 64 + fr, col0 = u.pn * BM + wc * 32 + 8 * fq;
#pragma unroll
        for (int ai = 0; ai < 2; ++ai)
#pragma unroll
            for (int m = 0; m < 4; ++m) { const size_t ro = (size_t)(row0 + ai * HALF + m * 16) * 1024 + col0;
#pragma unroll
                for (int bj = 0; bj < 2; ++bj) { const f32x4 x0 = *(const f32x4*)(x + ro + bj * HALF), x1 = *(const f32x4*)(x + ro + bj * HALF + 4);
                    const f32x4 v0 = acc[ai][bj][m][0] + x0, v1 = acc[ai][bj][m][1] + x1;
                    *(f32x4*)(out + ro + bj * HALF) = v0; *(f32x4*)(out + ro + bj * HALF + 4) = v1;
                    *(u32x4*)(xb + ro + bj * HALF) = pack8(v0, v1); } }
    }
};
struct EpiGU {
    static constexpr bool PERM = true;
    bf16* hid; const int* list; const i32x4* tokinfo;
    __device__ __forceinline__ void operator()(const f32x4 (&acc)[2][2][4][2], const Unit& u, int wr, int wc, int fr, int fq) const {
        const int lr0 = wr * 64 + fr, col0 = u.pn * HALF + wc * 32 + 8 * fq;
#pragma unroll
        for (int ai = 0; ai < 2; ++ai)
#pragma unroll
            for (int m = 0; m < 4; ++m) { const int lr = lr0 + ai * HALF + m * 16; const bool valid = lr < u.nv;
                const int tok = list[(size_t)u.e * CAP + u.r0 + (valid ? lr : 0)];
                const i32x4 t0 = tokinfo[tok * 2], t1 = tokinfo[tok * 2 + 1];
                const float cw = (t0.x == u.e) ? __int_as_float(t1.x) : __int_as_float(t1.y), rs = __int_as_float(t1.z);
                f32x4 h0, h1;
#pragma unroll
                for (int q = 0; q < 4; ++q) { const float g0 = acc[ai][0][m][0][q] * rs, u0 = acc[ai][1][m][0][q] * rs, g1 = acc[ai][0][m][1][q] * rs, u1 = acc[ai][1][m][1][q] * rs;
                    h0[q] = cw * g0 * sigmoidf_(g0) * u0; h1[q] = cw * g1 * sigmoidf_(g1) * u1; }
                if (valid) *(u32x4*)(hid + (size_t)(u.pm * BM + lr) * FF + col0) = pack8(h0, h1); }
    }
};
struct EpiPle {
    static constexpr bool PERM = true;
    float* out; const bf16* proj; const float* rstd;
    __device__ __forceinline__ void operator()(const f32x4 (&acc)[2][2][4][2], const Unit& u, int wr, int wc, int fr, int fq) const {
        const int row0 = u.pm * BM + wr * 64 + fr, col0 = u.pn * BM + wc * 32 + 8 * fq;
#pragma unroll
        for (int ai = 0; ai < 2; ++ai) {
            u32x4 pw[4][2]; float rs[4];
#pragma unroll
            for (int m = 0; m < 4; ++m) { rs[m] = rstd[row0 + ai * HALF + m * 16];
#pragma unroll
                for (int bj = 0; bj < 2; ++bj) pw[m][bj] = ld16_sc1_nw(proj + (size_t)(row0 + ai * HALF + m * 16) * 1024 + col0 + bj * HALF); }
            wait8(pw);
#pragma unroll
            for (int m = 0; m < 4; ++m)
#pragma unroll
                for (int bj = 0; bj < 2; ++bj) { const size_t ro = (size_t)(row0 + ai * HALF + m * 16) * 1024 + col0 + bj * HALF; f32x4 p0, p1; unpack8(pw[m][bj], p0, p1);
                    const f32x4 x0 = *(const f32x4*)(out + ro), x1 = *(const f32x4*)(out + ro + 4);
                    f32x4 v0, v1;
#pragma unroll
                    for (int q = 0; q < 4; ++q) { v0[q] = x0[q] + sigmoidf_(acc[ai][bj][m][0][q] * rs[m]) * p0[q]; v1[q] = x1[q] + sigmoidf_(acc[ai][bj][m][1][q] * rs[m]) * p1[q]; }
                    *(f32x4*)(out + ro) = v0; *(f32x4*)(out + ro + 4) = v1; }
        }
    }
};
}

namespace attn3 {
typedef short s16x4 __attribute__((ext_vector_type(4)));
typedef short v4i16_t __attribute__((ext_vector_type(4)));
typedef LAS const unsigned char* lds_cptr;
constexpr int DM = 1024, QB = 256, KVB = 64, KSLOT = 8192, VSLOT = 16384;
constexpr int NKS = 5, NVS = 4;
constexpr int L_K = 0, L_V = NKS * KSLOT, L_WS = L_V + NVS * VSLOT, L_Q = L_WS + 2048, L_END = L_Q + 8 * 4096, L_OST = 0, OSTS = 272;
static_assert(8 * 32 * OSTS <= L_WS, "O staging inside the ring area");
static_assert(L_END <= CTLL_OFF, "attention LDS map");
__device__ __forceinline__ void glds16(const void* gbase  , unsigned voff  , unsigned lds_dst) { unsigned keep;
    asm volatile("s_mov_b32 %0, m0\n\ts_mov_b32 m0, %3\n\ts_nop 0\n\tglobal_load_lds_dwordx4 %1, %2\n\ts_mov_b32 m0, %0" : "=&s"(keep) : "v"(voff), "s"(gbase), "s"(lds_dst) : "memory"); }
__device__ __forceinline__ s16x4 vtr(lds_cptr p) { return __builtin_bit_cast(s16x4, __builtin_amdgcn_ds_read_tr16_b64_v4i16((LAS v4i16_t*)p)); }
__device__ __forceinline__ unsigned cvtpk(float lo, float hi) { typedef float f2 __attribute__((ext_vector_type(2))); typedef __bf16 b2 __attribute__((ext_vector_type(2))); f2 v = {lo, hi}; b2 b = __builtin_convertvector(v, b2); return __builtin_bit_cast(unsigned, b); }
__device__ __forceinline__ int lane_now() { int l; asm volatile("v_mbcnt_lo_u32_b32 %0, -1, 0\n\tv_mbcnt_hi_u32_b32 %0, -1, %0" : "=v"(l)); return l; }
#define A2_WAIT_BAR(N) asm volatile("s_waitcnt vmcnt(" #N ") lgkmcnt(0)\n\ts_barrier" ::: "memory")
#define A2_SB() __builtin_amdgcn_sched_barrier(0)

template <int THRL>
__device__ __forceinline__ void unit(long rowbase, int qb, const bf16* Qp, const bf16* Kp, const bf16* Vp, bf16* Op, LAS unsigned char* shm) {
    int tid = threadIdx.x; asm volatile("" : "+v"(tid));
    const int lane = tid & 63, r32 = lane & 31, hi = lane >> 5; const int wid = __builtin_amdgcn_readfirstlane(tid >> 6), half = wid >> 2;
    const int q0 = qb * QB, NT = (q0 + QB) / KVB;
    const bf16* Qw = Qp + (rowbase + q0 + wid * 32) * DM;
    const char* Kh = (const char*)Kp; const char* Vh = (const char*)Vp;
    const unsigned lds0 = (unsigned)(uintptr_t)shm;
    LAS float* wsf = (LAS float*)(shm + L_WS) + wid * 64;
    const unsigned koff = (unsigned)(wid * 1024 + lane * 16);
    const unsigned voff = koff;
    const unsigned kdst = lds0 + L_K + wid * 1024, vdst = lds0 + L_V + wid * 1024;
#define DMA_K(t, slot) glds16(Kh + (size_t)(t) * KSLOT, koff, (unsigned)__builtin_amdgcn_readfirstlane(kdst + (slot)))
#define DMA_V(t, slot) do { glds16(Vh + (size_t)(t) * VSLOT, voff, (unsigned)__builtin_amdgcn_readfirstlane(vdst + (slot))); glds16(Vh + (size_t)(t) * VSLOT + 8192, voff, (unsigned)__builtin_amdgcn_readfirstlane(vdst + (slot) + 8192)); } while (0)
    const lds_cptr kp0 = shm + L_K + hi * 1024 + r32 * 16;
    const lds_cptr vp0 = shm + L_V + ((lane >> 4) & 1) * 32 + (lane & 3) * 8 + (4 * hi + ((lane & 15) >> 2)) * 64;
    DMA_K(0, 0); DMA_K(1, KSLOT); DMA_K(2, 2 * KSLOT); DMA_K(3, 3 * KSLOT); if (NT > 4) DMA_K(4, 4 * KSLOT); DMA_V(0, 0); DMA_V(1, VSLOT);
    const LAS unsigned char* qst = shm + L_Q + wid * 4096 + hi * 512 + r32 * 16;
    {
#pragma unroll
        for (int d0 = 0; d0 < 4; ++d0) { const bf16x8 q_ = *reinterpret_cast<const bf16x8*>(&Qw[(long)r32 * DM + d0 * 16 + hi * 8]); *(LAS bf16x8*)(shm + L_Q + wid * 4096 + hi * 512 + r32 * 16 + d0 * 1024) = q_; }
    }
    float mhat = 0.f, l_reg = 0.f; float zz_; asm volatile("v_mov_b32 %0, 0" : "=v"(zz_));
    f32x16 o[4];
#pragma unroll
    for (int r = 0; r < 16; ++r) { o[0][r] = zz_; o[1][r] = zz_; o[2][r] = zz_; o[3][r] = zz_; }
    f32x16 SA0, SA1, SB0, SB1; u32x4 PA[4], PB[4];
    bool resc = false;
    int ku = 0, vu = 2 * VSLOT;
#define QKT(S0, S1, kslot) do { const lds_cptr kb_ = kp0 + (kslot); \
        _Pragma("unroll") for (int d0 = 0; d0 < 4; ++d0) { const bf16x8 a0_ = *(const LAS bf16x8*)(kb_ + d0 * 2048), a1_ = *(const LAS bf16x8*)(kb_ + d0 * 2048 + 512), q_ = *(const LAS bf16x8*)(qst + d0 * 1024); \
            if (d0 == 0) { S0 = __builtin_amdgcn_mfma_f32_32x32x16_bf16(a0_, q_, (f32x16){}, 0, 0, 0); S1 = __builtin_amdgcn_mfma_f32_32x32x16_bf16(a1_, q_, (f32x16){}, 0, 0, 0); } \
            else { S0 = __builtin_amdgcn_mfma_f32_32x32x16_bf16(a0_, q_, S0, 0, 0, 0); S1 = __builtin_amdgcn_mfma_f32_32x32x16_bf16(a1_, q_, S1, 0, 0, 0); } } } while (0)
#define VFL(f) do { vl_[(f) % 3] = vtr(vb_ + ((f) & 3) * 4096 + ((f) >> 2) * 1024); vh_[(f) % 3] = vtr(vb_ + ((f) & 3) * 4096 + ((f) >> 2) * 1024 + 512); } while (0)
#define PVF(P, f) do { const bf16x8 pa_ = __builtin_bit_cast(bf16x8, P[(f) >> 2]); const bf16x8 vf_ = (bf16x8){vl_[(f) % 3][0], vl_[(f) % 3][1], vl_[(f) % 3][2], vl_[(f) % 3][3], vh_[(f) % 3][0], vh_[(f) % 3][1], vh_[(f) % 3][2], vh_[(f) % 3][3]}; \
        o[(f) & 3] = __builtin_amdgcn_mfma_f32_32x32x16_bf16(pa_, vf_, o[(f) & 3], 0, 0, 0); } while (0)
#define PVSTEP(P, f) do { PVF(P, f); if ((f) + 3 < 16) VFL((f) + 3); A2_SB(); } while (0)
#define PVALL(P) do { PVSTEP(P, 0); PVSTEP(P, 1); PVSTEP(P, 2); PVSTEP(P, 3); PVSTEP(P, 4); PVSTEP(P, 5); PVSTEP(P, 6); PVSTEP(P, 7); PVSTEP(P, 8); PVSTEP(P, 9); PVSTEP(P, 10); PVSTEP(P, 11); PVSTEP(P, 12); PVSTEP(P, 13); PVSTEP(P, 14); PVSTEP(P, 15); } while (0)
#define PVM(P, vslot) do { const lds_cptr vb_ = vp0 + (vslot); s16x4 vl_[3], vh_[3]; VFL(0); VFL(1); VFL(2); A2_SB(); PVALL(P); } while (0)
#define KQL(d0, j) do { kf_[2 * (j)] = *(const LAS bf16x8*)(kb_ + (d0) * 2048); kf_[2 * (j) + 1] = *(const LAS bf16x8*)(kb_ + (d0) * 2048 + 512); qf_[j] = *(const LAS bf16x8*)(qst + (d0) * 1024); } while (0)
#define PIN(x) asm volatile("" : "+v"(x))
#define RESC() do { if (resc) { asm volatile("s_waitcnt lgkmcnt(0)" ::: "memory"); \
        const LAS float* wl_ = wsf + 4 * (lane_now() >> 5); _Pragma("unroll") for (int r = 0; r < 16; ++r) { const float f_ = wl_[crow16(r, 0)]; o[0][r] *= f_; o[1][r] *= f_; o[2][r] *= f_; o[3][r] *= f_; } resc = false; } } while (0)
#define DECIDE(S0, S1, FIRST, JB) do { \
        if ((JB) >= 0) { const int ln_ = lane_now(); const int qrel_ = wid * 32 + (ln_ & 31); const int kb2_ = 64 * (JB) + 4 * (ln_ >> 5); _Pragma("unroll") for (int r = 0; r < 16; ++r) { const int kv_ = kb2_ + (r & 3) + 8 * (r >> 2); if (kv_ > qrel_) S0[r] = -INFINITY; if (kv_ + 32 > qrel_) S1[r] = -INFINITY; } } \
        float rm_; { float a_ = fmaxf(fmaxf(S0[0], S0[1]), S1[0]), b_ = fmaxf(fmaxf(S0[2], S0[3]), S1[1]); a_ = fmaxf(fmaxf(a_, S1[2]), S1[3]); \
            _Pragma("unroll") for (int r = 4; r < 16; r += 4) { a_ = fmaxf(fmaxf(a_, S0[r]), S0[r + 1]); b_ = fmaxf(fmaxf(b_, S0[r + 2]), S0[r + 3]); a_ = fmaxf(fmaxf(a_, S1[r]), S1[r + 1]); b_ = fmaxf(fmaxf(b_, S1[r + 2]), S1[r + 3]); } \
            rm_ = fmaxf(a_, b_); auto rr_ = __builtin_amdgcn_permlane32_swap(__float_as_uint(rm_), __float_as_uint(rm_), false, false); rm_ = fmaxf(__uint_as_float(rr_[0]), __uint_as_float(rr_[1])); } \
        if (FIRST) { mhat = rm_; } \
        else if (__builtin_expect(__any(rm_ - mhat > (float)THRL), 0)) { const float dl_ = fmaxf(rm_ - mhat, 0.f); mhat += dl_; \
            const float f_ = __builtin_amdgcn_exp2f(-dl_); l_reg *= f_; wsf[lane_now() & 31] = f_; resc = true; } \
        sacc = 0.f; } while (0)
#define EXP2S(S, r) do { S[r] = __builtin_amdgcn_exp2f(S[r] - mhat); S[(r) + 1] = __builtin_amdgcn_exp2f(S[(r) + 1] - mhat); } while (0)
#define EXPSL(S0, S1, f) do { if ((f) < 8) { EXP2S(S0, 2 * (f)); PIN(S0); } else { EXP2S(S1, 2 * ((f) - 8)); PIN(S1); } } while (0)
#define SUMPK(S0, S1, P, g) do { if ((g) < 4) { sacc += (S0[4 * (g)] + S0[4 * (g) + 1]) + (S0[4 * (g) + 2] + S0[4 * (g) + 3]); P[(g) >> 1][2 * ((g) & 1)] = cvtpk(S0[4 * (g)], S0[4 * (g) + 1]); P[(g) >> 1][2 * ((g) & 1) + 1] = cvtpk(S0[4 * (g) + 2], S0[4 * (g) + 3]); } \
        else { sacc += (S1[4 * ((g) - 4)] + S1[4 * ((g) - 4) + 1]) + (S1[4 * ((g) - 4) + 2] + S1[4 * ((g) - 4) + 3]); P[(g) >> 1][2 * ((g) & 1)] = cvtpk(S1[4 * ((g) - 4)], S1[4 * ((g) - 4) + 1]); P[(g) >> 1][2 * ((g) & 1) + 1] = cvtpk(S1[4 * ((g) - 4) + 2], S1[4 * ((g) - 4) + 3]); } \
        PIN(sacc); PIN(P[(g) >> 1]); } while (0)
#define PVX(Pp, Sc0, Sc1, f, HAS_PV) do { if (HAS_PV) { PVF(Pp, f); if ((f) + 3 < 16) VFL((f) + 3); } EXPSL(Sc0, Sc1, f); A2_SB(); } while (0)
#define QKM(Sn0, Sn1, j, first) do { if (first) { Sn0 = __builtin_amdgcn_mfma_f32_32x32x16_bf16(kf_[2 * ((j) & 1)], qf_[(j) & 1], (f32x16){}, 0, 0, 0); } else { Sn0 = __builtin_amdgcn_mfma_f32_32x32x16_bf16(kf_[2 * ((j) & 1)], qf_[(j) & 1], Sn0, 0, 0, 0); } } while (0)
#define QKM1(Sn0, Sn1, j, first) do { if (first) { Sn1 = __builtin_amdgcn_mfma_f32_32x32x16_bf16(kf_[2 * ((j) & 1) + 1], qf_[(j) & 1], (f32x16){}, 0, 0, 0); } else { Sn1 = __builtin_amdgcn_mfma_f32_32x32x16_bf16(kf_[2 * ((j) & 1) + 1], qf_[(j) & 1], Sn1, 0, 0, 0); } } while (0)
#define INTERVAL(Sc0, Sc1, Sn0, Sn1, Pp, Pn, ii, HAS_PV, HAS_QK, FIRST, JB, GK, GV, WN) do { \
        if (GK) DMA_K((ii) + 5, kfill_); if (GV) DMA_V((ii) + 2, vfill_); \
        const lds_cptr kb_ = kp0 + ku; const lds_cptr vb_ = vp0 + vu; bf16x8 kf_[4], qf_[2]; s16x4 vl_[3], vh_[3]; float sacc; \
        if (HAS_PV) { VFL(0); VFL(1); VFL(2); } \
        A2_SB(); \
        DECIDE(Sc0, Sc1, FIRST, JB); \
        A2_SB(); \
        PVX(Pp, Sc0, Sc1, 0, HAS_PV); PVX(Pp, Sc0, Sc1, 1, HAS_PV); PVX(Pp, Sc0, Sc1, 2, HAS_PV); PVX(Pp, Sc0, Sc1, 3, HAS_PV); PVX(Pp, Sc0, Sc1, 4, HAS_PV); PVX(Pp, Sc0, Sc1, 5, HAS_PV); PVX(Pp, Sc0, Sc1, 6, HAS_PV); PVX(Pp, Sc0, Sc1, 7, HAS_PV); \
        PVX(Pp, Sc0, Sc1, 8, HAS_PV); PVX(Pp, Sc0, Sc1, 9, HAS_PV); PVX(Pp, Sc0, Sc1, 10, HAS_PV); PVX(Pp, Sc0, Sc1, 11, HAS_PV); PVX(Pp, Sc0, Sc1, 12, HAS_PV); \
        if (HAS_QK) { KQL(0, 0); KQL(1, 1); } \
        PVX(Pp, Sc0, Sc1, 13, HAS_PV); PVX(Pp, Sc0, Sc1, 14, HAS_PV); PVX(Pp, Sc0, Sc1, 15, HAS_PV); \
        if (HAS_QK) { \
            QKM(Sn0, Sn1, 0, true); SUMPK(Sc0, Sc1, Pn, 0); A2_SB(); QKM1(Sn0, Sn1, 0, true); SUMPK(Sc0, Sc1, Pn, 1); A2_SB(); \
            QKM(Sn0, Sn1, 1, false); SUMPK(Sc0, Sc1, Pn, 2); A2_SB(); QKM1(Sn0, Sn1, 1, false); KQL(2, 0); KQL(3, 1); SUMPK(Sc0, Sc1, Pn, 3); A2_SB(); \
            QKM(Sn0, Sn1, 0, false); SUMPK(Sc0, Sc1, Pn, 4); A2_SB(); QKM1(Sn0, Sn1, 0, false); SUMPK(Sc0, Sc1, Pn, 5); A2_SB(); \
            QKM(Sn0, Sn1, 1, false); SUMPK(Sc0, Sc1, Pn, 6); A2_SB(); QKM1(Sn0, Sn1, 1, false); SUMPK(Sc0, Sc1, Pn, 7); A2_SB(); \
        } else { SUMPK(Sc0, Sc1, Pn, 0); SUMPK(Sc0, Sc1, Pn, 1); SUMPK(Sc0, Sc1, Pn, 2); SUMPK(Sc0, Sc1, Pn, 3); SUMPK(Sc0, Sc1, Pn, 4); SUMPK(Sc0, Sc1, Pn, 5); SUMPK(Sc0, Sc1, Pn, 6); SUMPK(Sc0, Sc1, Pn, 7); } \
        l_reg += sacc; \
        A2_WAIT_BAR(WN); RESC(); \
    } while (0)
#define ROT() do { ku = (ku == (NKS - 1) * KSLOT) ? 0 : ku + KSLOT; vu = (vu == (NVS - 1) * VSLOT) ? 0 : vu + VSLOT; } while (0)
#define kfill_ ((ku == 0) ? (NKS - 1) * KSLOT : ku - KSLOT)
#define vfill_ ((vu == 0) ? (NVS - 1) * VSLOT : vu - VSLOT)
    asm volatile("s_waitcnt vmcnt(0)\n\ts_barrier" ::: "memory");
    QKT(SA0, SA1, 0);
    asm volatile("s_waitcnt lgkmcnt(0)\n\ts_barrier" ::: "memory");
    ku = KSLOT; vu = (NVS - 1) * VSLOT;
    { const int jb0 = (NT == 4) ? 0 : -1;
      INTERVAL(SA0, SA1, SB0, SB1, PA, PB, 0, false, true, true, jb0, (NT > 5), true, 2); ROT(); }
    int i = 1;
    if (NT > 4) {
        for (; i + 5 < NT; i += 2) {
            INTERVAL(SB0, SB1, SA0, SA1, PB, PA, i, true, true, false, -1, true, true, 6); ROT();
            INTERVAL(SA0, SA1, SB0, SB1, PA, PB, i + 1, true, true, false, -1, true, true, 6); ROT();
        }
        INTERVAL(SB0, SB1, SA0, SA1, PB, PA, i, true, true, false, -1, false, true, 5); ROT(); ++i;
        INTERVAL(SA0, SA1, SB0, SB1, PA, PB, i, true, true, false, 0, false, true, 4); ROT(); ++i;
    }
    INTERVAL(SB0, SB1, SA0, SA1, PB, PA, i, true, true, false, 1, false, true, 4); ROT(); ++i;
    INTERVAL(SA0, SA1, SB0, SB1, PA, PB, i, true, true, false, 2, false, false, 2); ROT(); ++i;
    INTERVAL(SB0, SB1, SA0, SA1, PB, PA, i, true, false, false, 3, false, false, 0); ROT();
    PVM(PA, vu);
    A2_WAIT_BAR(0);
    { auto rr = __builtin_amdgcn_permlane32_swap(__float_as_uint(l_reg), __float_as_uint(l_reg), false, false); l_reg = __uint_as_float(rr[0]) + __uint_as_float(rr[1]); }
    const int lane_q = lane_now();
    wsf[32 + (lane_q & 31)] = l_reg;
    asm volatile("s_waitcnt lgkmcnt(0)" ::: "memory");
    float rli[16];
#pragma unroll
    for (int r = 0; r < 16; ++r) rli[r] = __builtin_amdgcn_rcpf(wsf[32 + crow16(r, lane_q >> 5)]);
    { const int lane_e = lane_q;
      const int r32e = lane_e & 31, hie = lane_e >> 5;
      bf16* Ow = Op + (rowbase + q0 + wid * 32) * DM;
      LAS unsigned char* stg = shm + L_OST + wid * 32 * OSTS;
#pragma unroll
      for (int r = 0; r < 16; ++r) { const int orow = crow16(r, hie);
#pragma unroll
          for (int dq = 0; dq < 4; ++dq) *(LAS unsigned short*)(stg + orow * OSTS + (dq * 32 + r32e) * 2) = (unsigned short)f2bf(o[dq][r] * rli[r]); }
      asm volatile("s_waitcnt lgkmcnt(0)" ::: "memory");
#pragma unroll
      for (int j = 0; j < 8; ++j) { const int row = j * 4 + (lane_e >> 4), pc = lane_e & 15; const u32x4 v = *(const LAS u32x4*)(stg + row * OSTS + pc * 16); *(u32x4*)(Ow + (long)row * DM + pc * 8) = v; } }
    asm volatile("s_waitcnt lgkmcnt(0)\n\ts_barrier" ::: "memory");
#undef DMA_K
#undef DMA_V
#undef QKT
#undef VFL
#undef PVF
#undef PVSTEP
#undef PVALL
#undef KQL
#undef PIN
#undef DECIDE
#undef EXP2S
#undef EXPSL
#undef SUMPK
#undef PVX
#undef QKM
#undef QKM1
#undef PVM
#undef RESC
#undef INTERVAL
#undef ROT
#undef kfill_
#undef vfill_
}
#undef A2_WAIT_BAR
#undef A2_SB
}
#define XB_TMO      128
#define XB_XCNT(j)  (256  + 64 * (j))
#define XB_XSUB(j)  (1280 + 64 * (j))
#define XB_XGEN(j)  (2304 + 64 * (j))
#define XB_TOP      3328
#define XB_TOPGEN   3392
#define XCD_BAR_WORDS 3456
#define XB_SPIN_CAP (1u << 18)

__device__ __forceinline__ unsigned xb_ld(unsigned* p)              { return __hip_atomic_load(p, __ATOMIC_RELAXED, __HIP_MEMORY_SCOPE_AGENT); }
__device__ __forceinline__ unsigned xb_add(unsigned* p, unsigned v) { return __hip_atomic_fetch_add(p, v, __ATOMIC_RELAXED, __HIP_MEMORY_SCOPE_AGENT); }
__device__ __forceinline__ unsigned xb_xcc_id() { return (unsigned)__builtin_amdgcn_s_getreg((3 << 11) | 20) & 0xFu; }
#define XB_SPIN(cond, bar) do { unsigned _sp = 0; while (cond) { __builtin_amdgcn_s_sleep(1); \
    if ((++_sp & 255u) == 0u) { if (xb_ld(&(bar)[XB_TMO])) break; if (_sp > XB_SPIN_CAP) { atomicAdd(&(bar)[XB_TMO], 1u); break; } } } } while (0)

struct XcdBarrier {
    unsigned* bar; unsigned x;
    volatile LAS unsigned* st;
};

__device__ __forceinline__ XcdBarrier xcd_barrier_post(unsigned* bar, volatile LAS unsigned* st) {
    XcdBarrier b; b.bar = bar; b.x = xb_xcc_id(); b.st = st;
    if (threadIdx.x == 0) (void)xb_add(&bar[XB_XCNT(b.x)], 1u);
    return b;
}
__device__ __forceinline__ void xcd_barrier_complete(unsigned* bar, unsigned x, unsigned& nloc, unsigned& nx) {
    const unsigned G = gridDim.x * gridDim.y * gridDim.z;
    unsigned sum, cnt, mine, sp = 0u;
    for (;;) {
        sum = 0u; cnt = 0u; mine = 0u;
#pragma unroll
        for (unsigned j = 0; j < 16; ++j) { const unsigned c = xb_ld(&bar[XB_XCNT(j)]); sum += c; cnt += (c > 0u) ? 1u : 0u; mine = (j == x) ? c : mine; }
        if (sum == G) break;
        __builtin_amdgcn_s_sleep(1);
        if ((++sp & 255u) == 0u) { if (xb_ld(&bar[XB_TMO])) break; if (sp > XB_SPIN_CAP) { atomicAdd(&bar[XB_TMO], 1u); break; } }
    }
    nloc = mine > 0u ? mine : 1u; nx = cnt > 0u ? cnt : 1u;
}

__device__ __forceinline__ void xcd_barrier(const XcdBarrier& b) {
    asm volatile("s_waitcnt vmcnt(0)" ::: "memory");
    __syncthreads();
    if (threadIdx.x == 0) {
        unsigned* bar = b.bar;
        __builtin_amdgcn_s_waitcnt(0);
        unsigned nloc = b.st[0], nx = b.st[1];
        if (nloc == 0u) { xcd_barrier_complete(bar, b.x, nloc, nx); b.st[0] = nloc; b.st[1] = nx; }
        const unsigned old = xb_add(&bar[XB_XSUB(b.x)], 1u);
        const unsigned gen = old / nloc;
        if (old + 1u == (gen + 1u) * nloc) {
            __builtin_amdgcn_fence(__ATOMIC_RELEASE, "agent");
            asm volatile("s_waitcnt vmcnt(0)" ::: "memory");
            const unsigned og = xb_add(&bar[XB_TOP], 1u);
            const unsigned tg = og / nx;
            if (og + 1u == (tg + 1u) * nx) xb_add(&bar[XB_TOPGEN], 1u);
            else XB_SPIN(xb_ld(&bar[XB_TOPGEN]) == tg, bar);
            __builtin_amdgcn_fence(__ATOMIC_ACQUIRE, "agent");
            xb_add(&bar[XB_XGEN(b.x)], 1u);
            asm volatile("s_waitcnt vmcnt(0)" ::: "memory");
        } else {
            XB_SPIN(xb_ld(&bar[XB_XGEN(b.x)]) == gen, bar);
            __builtin_amdgcn_fence(__ATOMIC_ACQUIRE, "agent");
            asm volatile("s_waitcnt vmcnt(0)" ::: "memory");
        }
    }
    __syncthreads();
}

__device__ __forceinline__ int lane_id_v() { int l; asm volatile("v_mbcnt_lo_u32_b32 %0, -1, 0\n\tv_mbcnt_hi_u32_b32 %0, -1, %0" : "=v"(l)); return l; }
struct Ctx {
    LAS unsigned char* lds; int tid, lane, wave, vcu, G, gw, NGW;
};

struct TrDesc { const float* W; bf16* WT; const float* ksc; int K, N, kmask, mode, item; float kmul; };
struct TrRegs { f32x4 v[8]; float sc[8]; };
__device__ __forceinline__ void tr_load(const TrDesc& d, TrRegs& r, int lane) {
    const int nblk = d.N / 32, kb = d.item / nblk, nb = d.item % nblk, k0 = 64 * kb, n0 = 32 * nb;
#pragma unroll
    for (int i = 0; i < 8; ++i) { const int kk = 8 * i + (lane >> 3); r.v[i] = *(const f32x4*)(d.W + (size_t)(k0 + kk) * d.N + n0 + 4 * (lane & 7)); r.sc[i] = d.ksc ? d.ksc[(k0 + kk) & d.kmask] * d.kmul : 1.0f; }
}
__device__ __forceinline__ void tr_finish(const TrDesc& d, const TrRegs& r, LAS float* scr, int lane) {
    const int nblk = d.N / 32, kb = d.item / nblk, nb = d.item % nblk, k0 = 64 * kb, n0 = 32 * nb;
#pragma unroll
    for (int i = 0; i < 8; ++i) { const int kk = 8 * i + (lane >> 3); LAS float* p = scr + kk * 33 + 4 * (lane & 7); const f32x4 v = r.v[i] * r.sc[i]; p[0] = v.x; p[1] = v.y; p[2] = v.z; p[3] = v.w; }
    LDS_WAIT(); asm volatile("" ::: "memory");
    const int c = lane & 7;
#pragma unroll
    for (int j = 0; j < 4; ++j) { const int n = (lane >> 3) + 8 * j; const LAS float* s = scr + (8 * c) * 33 + n;
        u32x4 o; o.x = pk2(s[0 * 33], s[1 * 33]); o.y = pk2(s[2 * 33], s[3 * 33]); o.z = pk2(s[4 * 33], s[5 * 33]); o.w = pk2(s[6 * 33], s[7 * 33]);
        const int nn = n0 + n; const int dr = d.mode == 0 ? nn : ((nn >> 7) * 256 + (nn & 127) + (d.mode == 2 ? 128 : 0));
        *(GAS u32x4*)(d.WT + (size_t)dr * d.K + k0 + 8 * c) = o; }
    LDS_WAIT(); asm volatile("" ::: "memory");
}

struct Args { const float* in[31]; float* out; unsigned char* ws; int ph_lo, ph_hi; };
#define AS4 __attribute__((address_space(4)))
struct KA { const AS4 char* p;
    __device__ __forceinline__ const float* in(int i) const { return *(const float* const AS4*)(p + 8 * i); }
    __device__ __forceinline__ float* out() const { return *(float* const AS4*)(p + 8 * 31); }
    __device__ __forceinline__ unsigned char* ws() const { return *(unsigned char* const AS4*)(p + 8 * 32); }
    __device__ __forceinline__ int lo() const { return *(const int AS4*)(p + 8 * 33); }
    __device__ __forceinline__ int hi() const { return *(const int AS4*)(p + 8 * 33 + 4); }
};
__device__ __forceinline__ KA ka_get() { const AS4 char* p = (const AS4 char*)__builtin_amdgcn_kernarg_segment_ptr(); asm volatile("" : "+s"(p)); return KA{p}; }

__device__ __forceinline__ void p0_prologue(const Ctx& F, const KA& a) {
    unsigned char* ws = a.ws();
    LAS float* scr = (LAS float*)(F.lds + RING_OFF + F.wave * 16384);
    constexpr int I_IN = (D / 64) * (NIN / 32), I_SQ = (D / 64) * (D / 32), I_PP = (PLE / 64) * (D / 32);
    constexpr int NITEMS = I_IN + 4 * I_SQ + I_PP;
    auto dec0 = [&](int it, TrDesc& d) { int r = it; d.kmul = 1.0f; d.mode = 0; d.ksc = nullptr; d.kmask = 0;
        if (r < I_IN) { d.W = a.in(3); d.K = D; d.N = NIN; d.WT = (bf16*)(ws + WS_WIN); d.ksc = a.in(2); d.kmask = 1023; d.item = r; return; } r -= I_IN;
        if (r < I_SQ) { d.W = a.in(16); d.K = D; d.N = D; d.WT = (bf16*)(ws + WS_WA); d.ksc = a.in(8); d.kmask = 127; d.kmul = 1.0f - LAM_INIT; d.item = r; return; } r -= I_SQ;
        if (r < I_SQ) { d.W = a.in(17); d.K = D; d.N = D; d.WT = (bf16*)(ws + WS_WL); d.item = r; return; } r -= I_SQ;
        if (r < I_SQ) { d.W = a.in(18); d.K = D; d.N = D; d.WT = (bf16*)(ws + WS_WO); d.item = r; return; } r -= I_SQ;
        if (r < I_SQ) { d.W = a.in(28); d.K = D; d.N = D; d.WT = (bf16*)(ws + WS_WPG); d.ksc = a.in(27); d.kmask = 1023; d.item = r; return; } r -= I_SQ;
        d.W = a.in(29); d.K = PLE; d.N = D; d.WT = (bf16*)(ws + WS_WPP); d.item = r; };
    { int it = F.gw; TrDesc dc, dn; TrRegs rc, rn;
      if (it < NITEMS) { dec0(it, dc); tr_load(dc, rc, F.lane); }
      while (it < NITEMS) { const int itn = it + F.NGW; if (itn < NITEMS) { dec0(itn, dn); tr_load(dn, rn, F.lane); }
          tr_finish(dc, rc, scr, F.lane); dc = dn; rc = rn; it = itn; } }
    const int gt = F.gw * 64 + F.lane, NGT = F.NGW * 64;
    { float* Wr = (float*)(ws + WS_WR); const float* gm = a.in(19);
      for (int i = gt; i < 36 * 1024; i += NGT) { const int j = i >> 10, k = i & 1023; const float w = j < 32 ? a.in(22)[(size_t)((j >> 3) * 1024 + k) * 8 + (j & 7)] : a.in(20)[k * 4 + (j - 32)]; Wr[i] = w * gm[k]; } }
    { bf16* Wl = (bf16*)(ws + WS_WLRU);
      for (int i = gt; i < 2 * 65536; i += NGT) { const int gate = i >> 16, n = (i >> 12) & 15, v = (i >> 6) & 63, w = i & 63; const float* src = gate ? a.in(13) : a.in(11); Wl[i] = (bf16)f2bf(src[(n * 64 + w) * 64 + v]); } }
    { const float* x = a.in(0); bf16* xb = (bf16*)(ws + WS_U0); float* rstd0 = (float*)(ws + WS_RSTD0);
      for (int m0 = F.gw; m0 < M; m0 += 4 * F.NGW) { f32x4 v[4][4]; float s[4];
#pragma unroll
          for (int r = 0; r < 4; ++r) { const int m = m0 + r * F.NGW; if (m < M) { const GAS f32x4* xr = (const GAS f32x4*)(x + (size_t)m * D) + F.lane;
#pragma unroll
              for (int j = 0; j < 4; ++j) v[r][j] = xr[64 * j]; } }
#pragma unroll
          for (int r = 0; r < 4; ++r) { s[r] = 0.f;
#pragma unroll
              for (int j = 0; j < 4; ++j) s[r] += (v[r][j].x * v[r][j].x + v[r][j].y * v[r][j].y) + (v[r][j].z * v[r][j].z + v[r][j].w * v[r][j].w); }
#pragma unroll
          for (int o = 1; o < 64; o <<= 1) {
#pragma unroll
              for (int r = 0; r < 4; ++r) s[r] += __shfl_xor(s[r], o); }
#pragma unroll
          for (int r = 0; r < 4; ++r) { const int m = m0 + r * F.NGW; if (m < M) { if (F.lane == 0) rstd0[m] = 1.0f / sqrtf(s[r] * (1.0f / D) + 1e-6f);
              GAS u32x2* o8 = (GAS u32x2*)(xb + (size_t)m * D) + F.lane;
#pragma unroll
              for (int j = 0; j < 4; ++j) o8[64 * j] = (u32x2){pk2(v[r][j].x, v[r][j].y), pk2(v[r][j].z, v[r][j].w)}; } } } }
    { const f32x4* p4 = (const f32x4*)a.in(1); u32x2* pb = (u32x2*)(ws + WS_PB);
      for (int i = gt; i < M * PLE / 4; i += NGT) { const f32x4 v = p4[i]; pb[i] = (u32x2){pk2(v.x, v.y), pk2(v.z, v.w)}; } }
}

template <bool FINAL>
__device__ __forceinline__ void lru_pass(const Ctx& F, const bf16* xr, bf16* gl, float* summ, const bf16* Wlru, const float* w_conv, const float* b_conv, const float* b_rg, const float* b_ig, const float* lam) {
    const int tid = F.tid, lane = F.lane, wave = F.wave, r32 = lane & 31, hi = lane >> 5;
    constexpr int XRS = 144;
    LAS unsigned char* XR = F.lds; LAS unsigned char* XC = F.lds + 37376; LAS unsigned char* GR = F.lds + 74240;
    LAS float* WS = (LAS float*)(F.lds + 111104); LAS float* WCV = (LAS float*)(F.lds + 115200); LAS unsigned char* WG = F.lds + 116480;
    for (int uu = F.vcu; uu < 256; uu += F.G) {
        const int bn = uu >> 3, b = bn >> 4, n = bn & 15, c0 = (uu & 7) * 4;
        const size_t rowb = (size_t)b * SEQ;
        __syncthreads();
        if (tid < 320) { const int j = tid >> 6, c = tid & 63; WCV[tid] = (j < 4) ? w_conv[j * 1024 + 64 * n + c] : b_conv[64 * n + c]; }
        for (int idx = tid; idx < 2 * 64 * 8; idx += 512) { const int gate = idx >> 9, v = (idx >> 3) & 63, pc = idx & 7;
            *(LAS u32x4*)(WG + (gate * 64 + v) * XRS + pc * 16) = *(const u32x4*)(Wlru + ((size_t)(gate * 16 + n) * 64 + v) * 64 + pc * 8); }
        float brg[2], big[2], cdec[2], hc[2], Arun[2];
#pragma unroll
        for (int hf = 0; hf < 2; ++hf) { const int oc = 64 * n + 32 * hf + r32; brg[hf] = b_rg[oc]; big[hf] = b_ig[oc]; cdec[hf] = -8.0f * log1pf(expf(-lam[oc])) * 1.4426950408889634f; hc[hf] = 0.f; Arun[hf] = 1.f;
            if (FINAL) for (int u2 = uu & ~7; u2 < uu; ++u2) { const float A = summ[(u2 * 64 + 32 * hf + r32) * 2], B = summ[(u2 * 64 + 32 * hf + r32) * 2 + 1]; hc[hf] = A * hc[hf] + B; } }
        u32x4 st[5];
#pragma unroll
        for (int k = 0; k < 5; ++k) { const int idx = tid + 512 * k, row = idx >> 3, pc = idx & 7, t = c0 * 256 - 3 + row; st[k] = (u32x4){0u, 0u, 0u, 0u};
            if (idx < 259 * 8 && t >= 0) st[k] = *(const u32x4*)(xr + (rowb + t) * 1024 + 64 * n + 8 * pc); }
        for (int ci = 0; ci < 4; ++ci) {
            const int t0 = (c0 + ci) * 256;
#pragma unroll
            for (int k = 0; k < 5; ++k) { const int idx = tid + 512 * k, row = idx >> 3, pc = idx & 7; if (idx < 259 * 8) *(LAS u32x4*)(XR + row * XRS + pc * 16) = st[k]; }
            bf16* gw_ = gl + (rowb + t0 + 32 * wave) * 1024 + 64 * n;
            LAS unsigned char* GRw = GR + 32 * wave * XRS;
            if (FINAL) {
#pragma unroll
                for (int i = 0; i < 4; ++i) { const int row = (lane >> 3) + 8 * i, pc = lane & 7; *(LAS u32x4*)(GRw + row * XRS + pc * 16) = *(const u32x4*)(gw_ + (size_t)row * 1024 + 8 * pc); } }
            __syncthreads();
            if (ci < 3) {
#pragma unroll
                for (int k = 0; k < 5; ++k) { const int idx = tid + 512 * k, row = idx >> 3, pc = idx & 7, t = t0 + 256 - 3 + row;
                    if (idx < 259 * 8) st[k] = *(const u32x4*)(xr + (rowb + t) * 1024 + 64 * n + 8 * pc); } }
            const int trow = 32 * wave + r32;
            bf16x8 av8[4];
#pragma unroll
            for (int ks = 0; ks < 4; ++ks) { const int c8 = 16 * ks + 8 * hi;
                f32x4 x0 = *(const LAS f32x4*)(WCV + 256 + c8), x1 = *(const LAS f32x4*)(WCV + 256 + c8 + 4);
#pragma unroll
                for (int j = 0; j < 4; ++j) { const u32x4 xv = *(const LAS u32x4*)(XR + (trow + j) * XRS + c8 * 2);
                    const f32x4 w0 = *(const LAS f32x4*)(WCV + j * 64 + c8), w1 = *(const LAS f32x4*)(WCV + j * 64 + c8 + 4);
                    x0 += w0 * (f32x4){bflo(xv.x), bfhi(xv.x), bflo(xv.y), bfhi(xv.y)}; x1 += w1 * (f32x4){bflo(xv.z), bfhi(xv.z), bflo(xv.w), bfhi(xv.w)}; }
                const u32x4 pk = (u32x4){pk2(x0[0], x0[1]), pk2(x0[2], x0[3]), pk2(x1[0], x1[1]), pk2(x1[2], x1[3])};
                av8[ks] = __builtin_bit_cast(bf16x8, pk);
                *(LAS u32x4*)(XC + trow * XRS + c8 * 2) = pk; }
            float av[2][16], uv[2][16], pA[2][4], pB[2][4];
#pragma unroll
            for (int hf = 0; hf < 2; ++hf) {
                f32x16 aR = {}, aI = {};
#pragma unroll
                for (int ks = 0; ks < 4; ++ks) { const bf16x8 bR = *(const LAS bf16x8*)(WG + (0 * 64 + 32 * hf + r32) * XRS + (16 * ks + 8 * hi) * 2), bI = *(const LAS bf16x8*)(WG + (1 * 64 + 32 * hf + r32) * XRS + (16 * ks + 8 * hi) * 2);
                    aR = __builtin_amdgcn_mfma_f32_32x32x16_bf16(av8[ks], bR, aR, 0, 0, 0); aI = __builtin_amdgcn_mfma_f32_32x32x16_bf16(av8[ks], bI, aI, 0, 0, 0); }
#pragma unroll
                for (int r = 0; r < 16; ++r) { const int row = 32 * wave + crow16(r, hi);
                    const float xcv = __uint_as_float((unsigned)(*(const LAS unsigned short*)(XC + row * XRS + (32 * hf + r32) * 2)) << 16);
                    const float rg = sigmoidf_(aR[r] + brg[hf]), ig = sigmoidf_(aI[r] + big[hf]);
                    const float a_ = __builtin_amdgcn_exp2f(cdec[hf] * rg); const float mult = __builtin_amdgcn_sqrtf(fmaxf(1.0f - a_ * a_, 0.f));
                    av[hf][r] = a_; uv[hf][r] = mult * ig * xcv; }
                float AW = 1.f, BW = 0.f, gA[4], gB[4];
#pragma unroll
                for (int j = 0; j < 4; ++j) { float A = 1.f, B = 0.f;
#pragma unroll
                    for (int i = 0; i < 4; ++i) { B = av[hf][4 * j + i] * B + uv[hf][4 * j + i]; A *= av[hf][4 * j + i]; }
                    gA[j] = A; gB[j] = B; pA[hf][j] = __shfl_xor(A, 32); pB[hf][j] = __shfl_xor(B, 32); }
#pragma unroll
                for (int j = 0; j < 4; ++j) { const float fA = hi ? pA[hf][j] : gA[j], fB = hi ? pB[hf][j] : gB[j], sA = hi ? gA[j] : pA[hf][j], sB = hi ? gB[j] : pB[hf][j];
                    BW = fA * BW + fB; AW *= fA; BW = sA * BW + sB; AW *= sA; }
                if (hi == 0) { WS[(wave * 64 + 32 * hf + r32) * 2] = AW; WS[(wave * 64 + 32 * hf + r32) * 2 + 1] = BW; }
            }
            __syncthreads();
#pragma unroll
            for (int hf = 0; hf < 2; ++hf) {
                float h = hc[hf], hin = hc[hf], Ar = Arun[hf];
#pragma unroll
                for (int w = 0; w < 8; ++w) { const float A = WS[(w * 64 + 32 * hf + r32) * 2], B = WS[(w * 64 + 32 * hf + r32) * 2 + 1]; h = A * h + B; Ar *= A; if (w + 1 == wave) hin = h; }
                hc[hf] = h; Arun[hf] = Ar;
                if (FINAL) {
                    h = hin;
#pragma unroll
                    for (int j = 0; j < 4; ++j) { float hh = hi ? pA[hf][j] * h + pB[hf][j] : h;
#pragma unroll
                        for (int i = 0; i < 4; ++i) { hh = av[hf][4 * j + i] * hh + uv[hf][4 * j + i]; uv[hf][4 * j + i] = hh; }
                        h = hi ? hh : pA[hf][j] * hh + pB[hf][j]; }
#pragma unroll
                    for (int r = 0; r < 16; ++r) { LAS unsigned short* g = (LAS unsigned short*)(GRw + crow16(r, hi) * XRS + (32 * hf + r32) * 2);
                        *g = (unsigned short)f2bf(uv[hf][r] * __uint_as_float((unsigned)(*g) << 16)); }
                }
            }
            if (FINAL) {
#pragma unroll
                for (int i = 0; i < 4; ++i) { const int row = (lane >> 3) + 8 * i, pc = lane & 7; *(u32x4*)(gw_ + (size_t)row * 1024 + 8 * pc) = *(const LAS u32x4*)(GRw + row * XRS + pc * 16); } }
        }
        if (!FINAL && hi == 0) {
#pragma unroll
            for (int hf = 0; hf < 2; ++hf) { summ[(uu * 64 + 32 * hf + r32) * 2] = Arun[hf]; summ[(uu * 64 + 32 * hf + r32) * 2 + 1] = hc[hf]; } }
    }
}

__device__ __forceinline__ void p4_combine(const Ctx& F, const KA& a) {
    unsigned char* ws = a.ws();
    float lam;
    { const float s1 = wave_sum(a.in(4)[F.lane] * a.in(5)[F.lane]), s2 = wave_sum(a.in(6)[F.lane] * a.in(7)[F.lane]); lam = expf(s1) - expf(s2) + LAM_INIT; }
    bf16* O1 = (bf16*)(ws + WS_U0); const bf16* O2 = (const bf16*)(ws + WS_U0 + 4 * USZ);
    for (int m0 = F.gw; m0 < M; m0 += 4 * F.NGW) {
        u32x4 aa[4][2], bb[4][2];
#pragma unroll
        for (int r = 0; r < 4; ++r) { const int m = m0 + r * F.NGW; if (m < M) { const u32x4* p1 = (const u32x4*)(O1 + (size_t)m * D) + 2 * F.lane; const u32x4* p2 = (const u32x4*)(O2 + (size_t)m * D) + 2 * F.lane;
            aa[r][0] = p1[0]; aa[r][1] = p1[1]; bb[r][0] = p2[0]; bb[r][1] = p2[1]; } }
#pragma unroll
        for (int r = 0; r < 4; ++r) { const int m = m0 + r * F.NGW; if (m < M) {
            f32x4 o[4], q[4]; pg8::unpack8(aa[r][0], o[0], o[1]); pg8::unpack8(aa[r][1], o[2], o[3]); pg8::unpack8(bb[r][0], q[0], q[1]); pg8::unpack8(bb[r][1], q[2], q[3]);
            float ss = 0.f;
#pragma unroll
            for (int j = 0; j < 4; ++j) { o[j] = o[j] - lam * q[j]; ss += (o[j].x * o[j].x + o[j].y * o[j].y) + (o[j].z * o[j].z + o[j].w * o[j].w); }
            ss += __shfl_xor(ss, 1); ss += __shfl_xor(ss, 2); ss += __shfl_xor(ss, 4);
            const float rs = 1.0f / sqrtf(ss * (1.0f / 128.0f) + 1e-5f);
            u32x4 w0, w1; w0 = (u32x4){pk2(o[0].x * rs, o[0].y * rs), pk2(o[0].z * rs, o[0].w * rs), pk2(o[1].x * rs, o[1].y * rs), pk2(o[1].z * rs, o[1].w * rs)};
            w1 = (u32x4){pk2(o[2].x * rs, o[2].y * rs), pk2(o[2].z * rs, o[2].w * rs), pk2(o[3].x * rs, o[3].y * rs), pk2(o[3].z * rs, o[3].w * rs)};
            u32x4* po = (u32x4*)(O1 + (size_t)m * D) + 2 * F.lane; po[0] = w0; po[1] = w1; } }
    }
    LAS float* scr = (LAS float*)(F.lds + RING_OFF + F.wave * 16384);
    constexpr int I_GU = (D / 64) * (FF / 32), I_DN = (FF / 64) * (D / 32);
    auto dec4 = [&](int it, TrDesc& d) { const int e = it / (2 * I_GU + I_DN); int r = it % (2 * I_GU + I_DN); d.kmul = 1.0f; d.ksc = nullptr; d.kmask = 0;
        if (r < I_GU) { d.W = a.in(24) + (size_t)e * D * FF; d.K = D; d.N = FF; d.WT = (bf16*)(ws + WS_WGU) + (size_t)e * 1024 * 1024; d.ksc = a.in(19); d.kmask = 1023; d.mode = 1; d.item = r; return; } r -= I_GU;
        if (r < I_GU) { d.W = a.in(25) + (size_t)e * D * FF; d.K = D; d.N = FF; d.WT = (bf16*)(ws + WS_WGU) + (size_t)e * 1024 * 1024; d.ksc = a.in(19); d.kmask = 1023; d.mode = 2; d.item = r; return; } r -= I_GU;
        d.W = a.in(26) + (size_t)e * FF * D; d.K = FF; d.N = D; d.WT = (bf16*)(ws + WS_WD) + (size_t)e * 1024 * 512; d.mode = 0; d.item = r; };
    { constexpr int NIT = NEXP * (2 * I_GU + I_DN); int it = F.gw; TrDesc dc, dn; TrRegs rc, rn;
      if (it < NIT) { dec4(it, dc); tr_load(dc, rc, F.lane); }
      while (it < NIT) { const int itn = it + F.NGW; if (itn < NIT) { dec4(itn, dn); tr_load(dn, rn, F.lane); }
          tr_finish(dc, rc, scr, F.lane); dc = dn; rc = rn; it = itn; } }
}

__device__ __forceinline__ void p7_router(const Ctx& F, const KA& a) {
    unsigned char* ws = a.ws();
    const float* x1 = a.out(); const float* Wr = (const float*)(ws + WS_WR);
    LAS float* WL = (LAS float*)F.lds;
    for (int i = F.tid; i < 36 * 256; i += NWAVES * 64) ((LAS f32x4*)WL)[i] = ((const f32x4*)Wr)[i];
    __syncthreads();
    int* list = (int*)(ws + WS_LIST); unsigned* cnt = (unsigned*)(ws + WS_CTL) + CW_CNT; i32x4* tokinfo = (i32x4*)(ws + WS_TOKINFO);
    const float* bg = a.in(21); const float* bfe = a.in(23);
    for (int m0 = F.gw; m0 < M; m0 += 2 * F.NGW) {
        f32x4 v[2][4]; float s[2], gl[2][4], fl[2][8]; int gi[2];
#pragma unroll
        for (int r = 0; r < 2; ++r) { const int m = (m0 + r * F.NGW < M) ? m0 + r * F.NGW : m0; const GAS f32x4* xr = (const GAS f32x4*)(x1 + (size_t)m * D) + F.lane;
#pragma unroll
            for (int j = 0; j < 4; ++j) v[r][j] = xr[64 * j]; }
#pragma unroll
        for (int r = 0; r < 2; ++r) { s[r] = 0.f;
#pragma unroll
            for (int j = 0; j < 4; ++j) s[r] += (v[r][j].x * v[r][j].x + v[r][j].y * v[r][j].y) + (v[r][j].z * v[r][j].z + v[r][j].w * v[r][j].w); }
#pragma unroll
        for (int g = 0; g < 4; ++g) { gl[0][g] = 0.f; gl[1][g] = 0.f;
#pragma unroll
            for (int j = 0; j < 4; ++j) { const f32x4 w = *(const LAS f32x4*)(WL + (32 + g) * 1024 + 4 * F.lane + 256 * j);
#pragma unroll
                for (int r = 0; r < 2; ++r) gl[r][g] += (v[r][j].x * w.x + v[r][j].y * w.y) + (v[r][j].z * w.z + v[r][j].w * w.w); } }
#pragma unroll
        for (int o = 1; o < 64; o <<= 1) {
#pragma unroll
            for (int r = 0; r < 2; ++r) { s[r] += __shfl_xor(s[r], o);
#pragma unroll
                for (int g = 0; g < 4; ++g) gl[r][g] += __shfl_xor(gl[r][g], o); } }
        float rstd[2], gwt[2];
#pragma unroll
        for (int r = 0; r < 2; ++r) { rstd[r] = 1.0f / sqrtf(s[r] * (1.0f / D) + 1e-6f);
#pragma unroll
            for (int g = 0; g < 4; ++g) gl[r][g] = gl[r][g] * rstd[r] + bg[g];
            int gg = 0; float gmax = gl[r][0];
#pragma unroll
            for (int g = 1; g < 4; ++g) if (gl[r][g] > gmax) { gmax = gl[r][g]; gg = g; }
            float gs = 0.f;
#pragma unroll
            for (int g = 0; g < 4; ++g) gs += expf(gl[r][g] - gmax);
            gwt[r] = 1.0f / gs; gi[r] = __builtin_amdgcn_readfirstlane(gg); }
#pragma unroll
        for (int r = 0; r < 2; ++r)
#pragma unroll
            for (int e = 0; e < 8; ++e) { float d = 0.f;
#pragma unroll
                for (int j = 0; j < 4; ++j) { const f32x4 w = *(const LAS f32x4*)(WL + (gi[r] * 8 + e) * 1024 + 4 * F.lane + 256 * j); d += (v[r][j].x * w.x + v[r][j].y * w.y) + (v[r][j].z * w.z + v[r][j].w * w.w); }
                fl[r][e] = d; }
#pragma unroll
        for (int o = 1; o < 64; o <<= 1) {
#pragma unroll
            for (int r = 0; r < 2; ++r)
#pragma unroll
                for (int e = 0; e < 8; ++e) fl[r][e] += __shfl_xor(fl[r][e], o); }
#pragma unroll
        for (int r = 0; r < 2; ++r) { const int m = m0 + r * F.NGW; if (m < M) {
#pragma unroll
            for (int e = 0; e < 8; ++e) fl[r][e] = fl[r][e] * rstd[r] + bfe[gi[r] * 8 + e];
            int i0 = 0; float l0 = fl[r][0];
#pragma unroll
            for (int e = 1; e < 8; ++e) if (fl[r][e] > l0) { l0 = fl[r][e]; i0 = e; }
            int i1 = -1; float l1 = -INFINITY;
#pragma unroll
            for (int e = 0; e < 8; ++e) if (e != i0 && fl[r][e] > l1) { l1 = fl[r][e]; i1 = e; }
            const float ex = expf(l1 - l0), w0 = 1.0f / (1.0f + ex), w1 = ex * w0;
            if (F.lane == 0) { const int e0 = gi[r] * 8 + i0, e1 = gi[r] * 8 + i1;
                const int p0 = (int)atomicAdd(cnt + e0, 1u), p1 = (int)atomicAdd(cnt + e1, 1u);
                list[(size_t)e0 * CAP + p0] = m; list[(size_t)e1 * CAP + p1] = m;
                tokinfo[m * 2] = (i32x4){e0, e1, p0, p1}; tokinfo[m * 2 + 1] = (i32x4){__float_as_int(gwt[r] * w0), __float_as_int(gwt[r] * w1), __float_as_int(rstd[r]), 0}; } } }
    }
}

__device__ __forceinline__ void moe_tables(const Ctx& F, const unsigned* cnt) {
    LAS int* tp = (LAS int*)(F.lds + CTLL_OFF + 64); LAS int* cn = (LAS int*)(F.lds + CTLL_OFF + 256);
    if (F.tid == 0) { int acc = 0; for (int e = 0; e < NEXP; ++e) { const int c = (int)__hip_atomic_load(cnt + e, RLX_AGENT); cn[e] = c; tp[e] = acc; acc += (c + 255) >> 8; } tp[NEXP] = acc; }
    __syncthreads();
}

__device__ __forceinline__ void p10_combine(const Ctx& F, const KA& a) {
    unsigned char* ws = a.ws();
    const LAS int* tp = (const LAS int*)(F.lds + CTLL_OFF + 64);
    const i32x4* tokinfo = (const i32x4*)(ws + WS_TOKINFO); const bf16* Y = (const bf16*)(ws + WS_Y); bf16* x2b = (bf16*)(ws + WS_U0); float* rstd2 = (float*)(ws + WS_RSTD2);
    for (int m0 = F.gw; m0 < M; m0 += 4 * F.NGW) {
        i32x4 t0[4]; f32x4 v[4][4]; u32x2 py[4][4], qy[4][4]; float s[4];
#pragma unroll
        for (int r = 0; r < 4; ++r) { const int m = m0 + r * F.NGW; if (m < M) t0[r] = tokinfo[m * 2]; }
#pragma unroll
        for (int r = 0; r < 4; ++r) { const int m = m0 + r * F.NGW; if (m < M) {
            const int s0 = tp[t0[r].x] * 256 + t0[r].z, s1 = tp[t0[r].y] * 256 + t0[r].w;
            const GAS f32x4* xr = (const GAS f32x4*)(a.out() + (size_t)m * D) + F.lane; const u32x2* y0 = (const u32x2*)(Y + (size_t)s0 * D) + F.lane; const u32x2* y1 = (const u32x2*)(Y + (size_t)s1 * D) + F.lane;
#pragma unroll
            for (int j = 0; j < 4; ++j) { v[r][j] = xr[64 * j]; py[r][j] = y0[64 * j]; qy[r][j] = y1[64 * j]; } } }
#pragma unroll
        for (int r = 0; r < 4; ++r) { s[r] = 0.f;
#pragma unroll
            for (int j = 0; j < 4; ++j) { const u32x2 p = py[r][j], q = qy[r][j];
                v[r][j].x += bflo(p.x) + bflo(q.x); v[r][j].y += bfhi(p.x) + bfhi(q.x); v[r][j].z += bflo(p.y) + bflo(q.y); v[r][j].w += bfhi(p.y) + bfhi(q.y);
                s[r] += (v[r][j].x * v[r][j].x + v[r][j].y * v[r][j].y) + (v[r][j].z * v[r][j].z + v[r][j].w * v[r][j].w); } }
#pragma unroll
        for (int o = 1; o < 64; o <<= 1) {
#pragma unroll
            for (int r = 0; r < 4; ++r) s[r] += __shfl_xor(s[r], o); }
#pragma unroll
        for (int r = 0; r < 4; ++r) { const int m = m0 + r * F.NGW; if (m < M) { if (F.lane == 0) rstd2[m] = 1.0f / sqrtf(s[r] * (1.0f / D) + 1e-6f);
            GAS f32x4* xr = (GAS f32x4*)(a.out() + (size_t)m * D) + F.lane; GAS u32x2* o8 = (GAS u32x2*)(x2b + (size_t)m * D) + F.lane;
#pragma unroll
            for (int j = 0; j < 4; ++j) { xr[64 * j] = v[r][j]; o8[64 * j] = (u32x2){pk2(v[r][j].x, v[r][j].y), pk2(v[r][j].z, v[r][j].w)}; } } }
    }
}

__device__ __forceinline__ void p12_final(const Ctx& F, const KA& a) {
    const f32x4* g4 = (const f32x4*)a.in(30);
    f32x4 g[4];
#pragma unroll
    for (int j = 0; j < 4; ++j) g[j] = g4[F.lane + 64 * j];
    for (int m0 = F.gw; m0 < M; m0 += 4 * F.NGW) { f32x4 v[4][4]; float s[4];
#pragma unroll
        for (int r = 0; r < 4; ++r) { const int m = m0 + r * F.NGW; if (m < M) { const GAS f32x4* xr = (const GAS f32x4*)(a.out() + (size_t)m * D) + F.lane;
#pragma unroll
            for (int j = 0; j < 4; ++j) v[r][j] = xr[64 * j]; } }
#pragma unroll
        for (int r = 0; r < 4; ++r) { s[r] = 0.f;
#pragma unroll
            for (int j = 0; j < 4; ++j) s[r] += (v[r][j].x * v[r][j].x + v[r][j].y * v[r][j].y) + (v[r][j].z * v[r][j].z + v[r][j].w * v[r][j].w); }
#pragma unroll
        for (int o = 1; o < 64; o <<= 1) {
#pragma unroll
            for (int r = 0; r < 4; ++r) s[r] += __shfl_xor(s[r], o); }
#pragma unroll
        for (int r = 0; r < 4; ++r) { const int m = m0 + r * F.NGW; if (m < M) { const float rs = 1.0f / sqrtf(s[r] * (1.0f / D) + 1e-6f); GAS f32x4* xr = (GAS f32x4*)(a.out() + (size_t)m * D) + F.lane;
#pragma unroll
            for (int j = 0; j < 4; ++j) xr[64 * j] = v[r][j] * rs * g[j]; } }
    }
}

#ifndef MK_N_LAUNCHES
#define MK_N_LAUNCHES 1
#endif
constexpr int NPH = 13;
constexpr int N_LAUNCHES = MK_N_LAUNCHES;

__global__ void __launch_bounds__(NWAVES * 64, 2) mega_fwd(Args args) {
    extern __shared__ __attribute__((aligned(16))) unsigned char lds[];
#define MKCTX() Ctx F; F.lds = (LAS unsigned char*)lds; F.tid = threadIdx.x; F.lane = lane_id_v(); F.wave = __builtin_amdgcn_readfirstlane(F.tid >> 6); \
    F.G = gridDim.x; { const int bx = blockIdx.x; F.vcu = (F.G % 8 == 0) ? (bx % 8) * (F.G / 8) + bx / 8 : bx; } F.gw = F.vcu * NWAVES + F.wave; F.NGW = F.G * NWAVES
    const KA ka0 = ka_get();
    unsigned char* ws = ka0.ws();
    gu32* ctl = (gu32*)(ws + WS_CTL);
    for (int u = threadIdx.x; u < (LDS_BYTES - CTLL_OFF) / 4; u += NWAVES * 64) ((LAS unsigned*)((LAS unsigned char*)lds + CTLL_OFF))[u] = 0u;
    __syncthreads();
    XcdBarrier bar; bar.bar = (unsigned*)ctl + CW_BAR; bar.x = 0; bar.st = nullptr;
    if (N_LAUNCHES == 1) bar = xcd_barrier_post((unsigned*)ctl + CW_BAR, (volatile LAS unsigned*)((LAS unsigned char*)lds + CTLL_OFF));
#define GRID_BAR() do { if (N_LAUNCHES == 1) xcd_barrier(bar); } while (0)
#define GRID_BAR2() xcd_barrier(bar)
    const int lo = ka0.lo(), hi = ka0.hi();
#define IN(k) (lo <= (k) && (k) < hi)
#define BOTH(k) (IN(k) && IN((k) + 1))
    bf16* U0 = (bf16*)(ws + WS_U0);

    if (IN(0)) { MKCTX(); p0_prologue(F, ka_get()); if (BOTH(0)) GRID_BAR(); }

    if (IN(1)) {
        pg8::DenseOrder S; S.init(ws + WS_U0, ws + WS_WIN, M, NIN, D, gridDim.x, (int)blockIdx.x);
        pg8::EpiIn E{(bf16*)(ws + WS_U0 + 1 * USZ), (const float*)(ws + WS_RSTD0)};
        pg8::gemm_phase<D, pg8::EpiIn, pg8::DenseOrder, false, true>((LAS unsigned char*)lds + RING_OFF, S, E);
        if (BOTH(1)) GRID_BAR();
    }

    if (IN(2)) {
        { MKCTX(); const KA ka = ka_get();
          lru_pass<false>(F, (const bf16*)(ws + WS_U0 + 4 * USZ), (bf16*)(ws + WS_U0 + 5 * USZ), (float*)(ws + WS_SUMM), (const bf16*)(ws + WS_WLRU), ka.in(9), ka.in(10), ka.in(12), ka.in(14), ka.in(15)); }
        GRID_BAR2();
        { MKCTX(); const KA ka = ka_get();
          lru_pass<true>(F, (const bf16*)(ws + WS_U0 + 4 * USZ), (bf16*)(ws + WS_U0 + 5 * USZ), (float*)(ws + WS_SUMM), (const bf16*)(ws + WS_WLRU), ka.in(9), ka.in(10), ka.in(12), ka.in(14), ka.in(15)); }
        if (BOTH(2)) GRID_BAR();
    }

    if (IN(3)) {
        const bf16* Q = (const bf16*)(ws + WS_U0 + 1 * USZ); const bf16* Kb = (const bf16*)(ws + WS_U0 + 2 * USZ); const bf16* Vb = (const bf16*)(ws + WS_U0 + 3 * USZ);
        bf16* O1 = (bf16*)(ws + WS_U0); bf16* O2 = (bf16*)(ws + WS_U0 + 4 * USZ);
        const int G = gridDim.x, bx = blockIdx.x, vcu = (G % 8 == 0) ? (bx % 8) * (G / 8) + bx / 8 : bx;
        for (int k = vcu; k < 1024; k += G) {
            const int v = k & 255, j = k >> 8, xc = v >> 5, jc = v & 31, bh = 4 * xc + j;
            const int rot = (jc + 16) & 31;
            const int qb = (j == 0) ? jc : (j == 1) ? 31 - jc : (j == 2) ? rot : 31 - rot;
            const int b = bh >> 4, h = (bh >> 1) & 7, c = bh & 1;
            attn3::unit<8>((long)b * SEQ, qb, Q + 128 * h + 64 * c, (const bf16*)((const char*)Kb + (size_t)((b * 16 + h * 2 + c) * 128) * 8192), (const bf16*)((const char*)Vb + (size_t)((b * 8 + h) * 128) * 16384), (c ? O2 : O1) + 128 * h, (LAS unsigned char*)lds);
        }
        if (BOTH(3)) GRID_BAR();
    }

    if (IN(4)) { MKCTX(); p4_combine(F, ka_get()); if (BOTH(4)) GRID_BAR(); }

    if (IN(5)) {
        bf16* mixed = (bf16*)(ws + WS_U0 + 4 * USZ);
        { pg8::DenseOrder S; S.init(ws + WS_U0, ws + WS_WA, M, D, D, gridDim.x, (int)blockIdx.x);
          pg8::EpiMix<true> E{mixed, (const bf16*)(ws + WS_U0 + 6 * USZ)};
          pg8::gemm_phase<D, pg8::EpiMix<true>, pg8::DenseOrder, false, false>((LAS unsigned char*)lds + RING_OFF, S, E); }
        { pg8::DenseOrder S; S.init(ws + WS_U0 + 5 * USZ, ws + WS_WL, M, D, D, gridDim.x, (int)blockIdx.x);
          pg8::EpiMix<false> E{mixed, (const bf16*)(ws + WS_U0 + 7 * USZ)};
          pg8::gemm_phase<D, pg8::EpiMix<false>, pg8::DenseOrder, false, false>((LAS unsigned char*)lds + RING_OFF, S, E); }
        if (BOTH(5)) GRID_BAR();
    }

    if (IN(6)) {
        pg8::DenseOrder S; S.init(ws + WS_U0 + 4 * USZ, ws + WS_WO, M, D, D, gridDim.x, (int)blockIdx.x);
        const KA ka = ka_get(); pg8::EpiOut E{ka.in(0), ka.out(), U0};
        pg8::gemm_phase<D, pg8::EpiOut, pg8::DenseOrder, false, false>((LAS unsigned char*)lds + RING_OFF, S, E);
        if (BOTH(6)) GRID_BAR();
    }

    if (IN(7)) { MKCTX(); p7_router(F, ka_get()); if (BOTH(7)) GRID_BAR(); }

    if (IN(8)) {
        { MKCTX(); moe_tables(F, (const unsigned*)ctl + CW_CNT);
        pg8::MoeOrder<true> S{(const char*)U0, (const char*)(ws + WS_WGU), (size_t)1024 * 1024 * 2, D, F.G, F.vcu, (const LAS int*)(F.lds + CTLL_OFF + 64), (const LAS int*)(F.lds + CTLL_OFF + 256), (const int*)(ws + WS_LIST)};
        pg8::EpiGU E{(bf16*)(ws + WS_HID), (const int*)(ws + WS_LIST), (const i32x4*)(ws + WS_TOKINFO)};
        pg8::gemm_phase<D, pg8::EpiGU, pg8::MoeOrder<true>, true, false>(F.lds + RING_OFF, S, E); }
        if (BOTH(8)) GRID_BAR();
    }

    if (IN(9)) {
        { MKCTX(); moe_tables(F, (const unsigned*)ctl + CW_CNT);
        pg8::MoeOrder<false> S{(const char*)(ws + WS_HID), (const char*)(ws + WS_WD), (size_t)1024 * 512 * 2, FF, F.G, F.vcu, (const LAS int*)(F.lds + CTLL_OFF + 64), (const LAS int*)(F.lds + CTLL_OFF + 256), (const int*)(ws + WS_LIST)};
        pg8::EpiBf E{(bf16*)(ws + WS_Y), D};
        pg8::gemm_phase<FF, pg8::EpiBf, pg8::MoeOrder<false>, false, false>(F.lds + RING_OFF, S, E); }
        if (BOTH(9)) GRID_BAR();
    }

    if (IN(10)) { MKCTX(); moe_tables(F, (const unsigned*)ctl + CW_CNT); p10_combine(F, ka_get()); if (BOTH(10)) GRID_BAR(); }

    if (IN(11)) {
        { pg8::DenseOrder S; S.init(ws + WS_PB, ws + WS_WPP, M, D, PLE, gridDim.x, (int)blockIdx.x);
          pg8::EpiBf E{(bf16*)(ws + WS_PROJ), D};
          pg8::gemm_phase<PLE, pg8::EpiBf, pg8::DenseOrder, false, false>((LAS unsigned char*)lds + RING_OFF, S, E); }
        { pg8::DenseOrder S; S.init(ws + WS_U0, ws + WS_WPG, M, D, D, gridDim.x, (int)blockIdx.x);
          const KA ka = ka_get(); pg8::EpiPle E{ka.out(), (const bf16*)(ws + WS_PROJ), (const float*)(ws + WS_RSTD2)};
          pg8::gemm_phase<D, pg8::EpiPle, pg8::DenseOrder, false, false>((LAS unsigned char*)lds + RING_OFF, S, E); }
        if (BOTH(11)) GRID_BAR();
    }

    if (IN(12)) { MKCTX(); p12_final(F, ka_get()); }
#undef IN
#undef BOTH
}

extern "C" void kernel_launch(void* const* d_in, const int* in_sizes, int n_in, void* d_out, int out_size, void* d_ws, size_t ws_size, hipStream_t stream) {
    static int grid = 0;
    if (grid == 0) {
        if (n_in != 31 || in_sizes[0] != M * D || out_size != M * D || ws_size < WS_END) { fprintf(stderr, "kernel_launch: unexpected shapes (n_in %d, in0 %d, out %d, ws %zu < %zu); nothing launched\n", n_in, n_in > 0 ? in_sizes[0] : -1, out_size, ws_size, (size_t)WS_END); grid = -1; return; }
        int dev = 0, cus = 0, per_cu = 0;
        if (hipGetDevice(&dev) != hipSuccess || hipDeviceGetAttribute(&cus, hipDeviceAttributeMultiprocessorCount, dev) != hipSuccess) { grid = -1; return; }
        if (hipFuncSetAttribute((const void*)mega_fwd, hipFuncAttributeMaxDynamicSharedMemorySize, LDS_BYTES) != hipSuccess) { fprintf(stderr, "kernel_launch: hipFuncSetAttribute failed\n"); grid = -1; return; }
        if (hipOccupancyMaxActiveBlocksPerMultiprocessor(&per_cu, (const void*)mega_fwd, NWAVES * 64, LDS_BYTES) != hipSuccess || per_cu < 1)
            fprintf(stderr, "kernel_launch: note: occupancy query reports %d workgroups per CU\n", per_cu);
        (void)hipGetLastError();
        grid = cus;
    }
    if (grid < 0) return;
    if (hipMemsetAsync((char*)d_ws + WS_CTL, 0, CTL_ZERO_BYTES, stream) != hipSuccess) return;
    Args a{};
    for (int i = 0; i < 31; ++i) a.in[i] = (const float*)d_in[i];
    a.out = (float*)d_out; a.ws = (unsigned char*)d_ws;
    for (int li = 0; li < N_LAUNCHES; ++li) {
        a.ph_lo = (N_LAUNCHES == 1) ? 0 : li; a.ph_hi = (N_LAUNCHES == 1) ? NPH : li + 1;
        hipLaunchKernelGGL(mega_fwd, dim3(grid), dim3(NWAVES * 64), LDS_BYTES, stream, a);
        const hipError_t le = hipPeekAtLastError();
        if (le != hipSuccess) { fprintf(stderr, "kernel_launch: launch %d failed: %s\n", li, hipGetErrorName(le)); break; }
    }
}
```

```cpp
#include <hip/hip_runtime.h>
#include <hip/hip_bf16.h>
#include <cstdio>
#include <cstdint>
#include <cmath>

#define LAS __attribute__((address_space(3)))
#define GAS __attribute__((address_space(1)))
typedef unsigned short bf16;
typedef short bf16x8 __attribute__((ext_vector_type(8)));
typedef float f32x4 __attribute__((ext_vector_type(4)));
typedef float f32x2 __attribute__((ext_vector_type(2)));
typedef float f32x16 __attribute__((ext_vector_type(16)));
typedef unsigned u32x4 __attribute__((ext_vector_type(4)));
typedef unsigned u32x2 __attribute__((ext_vector_type(2)));
typedef int i32x4 __attribute__((ext_vector_type(4)));
typedef GAS unsigned gu32;

constexpr int M = 16384, D = 1024, SEQ = 8192, NBATCH = 2, NIN = 7168, PLE = 256, NEXP = 32, FF = 512, CAP = 16384;
constexpr float C2 = 0.125f * 1.4426950408889634f;
constexpr float LAM_INIT = 0.2f;

constexpr size_t MiB = 1u << 20;
constexpr size_t WS_CTL = 0, CTL_ZERO_BYTES = 64 * 1024;
constexpr size_t WS_RSTD0 = 1 * MiB, WS_RSTD2 = 1 * MiB + 65536, WS_TOKINFO = 1 * MiB + 131072;
constexpr size_t WS_SUMM = 1 * MiB + 655360;
constexpr size_t WS_WR = 2 * MiB, WS_WLRU = 2 * MiB + 262144;
constexpr size_t WS_LIST = 4 * MiB;
constexpr size_t WS_WIN = 8 * MiB, WS_WA = 22 * MiB, WS_WL = 24 * MiB, WS_WO = 26 * MiB, WS_WPG = 28 * MiB, WS_WPP = 30 * MiB;
constexpr size_t WS_U0 = 32 * MiB, USZ = 32 * MiB;
constexpr size_t WS_WGU = WS_U0 + 1 * USZ, WS_WD = WS_U0 + 3 * USZ;
constexpr size_t WS_Y = WS_U0 + 4 * USZ;
constexpr size_t WS_HID = 246 * MiB, WS_PROJ = 246 * MiB;
constexpr size_t WS_PB = 288 * MiB, WS_END = 296 * MiB;
constexpr int CW_TMO = 0, CW_CODE = 1, CW_BAR = 1024, CW_CNT = 8192;

constexpr int RING_OFF = 0, RING_BYTES = 131072, AUX_OFF = 131072, CTLL_OFF = 147456, LDS_BYTES = 149504;
constexpr int NWAVES = 8;

#define RLX_AGENT __ATOMIC_RELAXED, __HIP_MEMORY_SCOPE_AGENT
#define LDS_WAIT() asm volatile("s_waitcnt lgkmcnt(0)" ::: "memory")
#define VM_WAIT() asm volatile("s_waitcnt vmcnt(0)" ::: "memory")
__device__ __forceinline__ unsigned f2bf(float f) { unsigned u = __builtin_bit_cast(unsigned, f); return (u + 0x7fffu + ((u >> 16) & 1u)) >> 16; }
__device__ __forceinline__ unsigned pk2(float lo, float hi) { return f2bf(lo) | (f2bf(hi) << 16); }
__device__ __forceinline__ float bflo(unsigned w) { return __uint_as_float(w << 16); }
__device__ __forceinline__ float bfhi(unsigned w) { return __uint_as_float(w & 0xffff0000u); }
__device__ __forceinline__ float sigmoidf_(float v) { return __builtin_amdgcn_rcpf(1.0f + __builtin_amdgcn_exp2f(-1.4426950408889634f * v)); }
__device__ __forceinline__ float gelu_tanh(float v) { return v * __builtin_amdgcn_rcpf(1.0f + __builtin_amdgcn_exp2f(-2.3022082f * v * (1.0f + 0.044715f * v * v))); }
__device__ __forceinline__ float wave_sum(float v) {
#pragma unroll
    for (int o = 1; o < 64; o <<= 1) v += __shfl_xor(v, o);
    return v;
}
__device__ __forceinline__ int crow16(int r, int hi) { return (r & 3) + 8 * (r >> 2) + 4 * hi; }

namespace pg8 {
constexpr int BM = 256, BK = 64, HALF = 128, HTB = HALF * BK * 2, NXCD = 8, WGM = 8;
__host__ __device__ __forceinline__ int lds_byte(int r, int c) { const int st = (r >> 4) * 2 + (c >> 5), rr = r & 15, cc = c & 31, ob = rr * 64 + cc * 2; return st * 1024 + (ob ^ (((ob >> 9) & 1) << 5)); }
__host__ __device__ __forceinline__ void stage_rc(int b, int& R, int& C) { const int st = b / 1024, sb = b % 1024, swz = sb ^ (((sb >> 9) & 1) << 5); R = (st >> 1) * 16 + swz / 64; C = (st & 1) * 32 + (swz % 64) / 2; }
__host__ __device__ __forceinline__ int perm32(int rho) { const int n = rho >> 4, i = rho & 15; return 8 * (i >> 2) + 4 * n + (i & 3); }

struct Unit { int pm, pn, e, nv, r0; const char* a; const char* b; };

struct DenseOrder {
    const char* A; const char* Bt; int K, nM, nN, nwg, G, c;
    __device__ __forceinline__ void init(const void* A_, const void* Bt_, int M_, int N_, int K_, int G_, int c_) { A = (const char*)A_; Bt = (const char*)Bt_; K = K_; nM = M_ / BM; nN = N_ / BM; nwg = nM * nN; G = G_; c = c_; }
    __device__ __forceinline__ bool next(int i, Unit& u) const {
        const long L = (long)i * G + c; if (L >= nwg) return false;
        int wgid = (int)L; { const int q = nwg / NXCD, r = nwg % NXCD, xcd = wgid % NXCD, off = wgid / NXCD; wgid = (xcd < r ? xcd * (q + 1) : r * (q + 1) + (xcd - r) * q) + off; }
        const int nig = WGM * nN, gid = wgid / nig, fm = gid * WGM, gsz = (nM - fm) < WGM ? (nM - fm) : WGM;
        u.pm = fm + ((wgid % nig) % gsz); u.pn = (wgid % nig) / gsz; u.e = 0; u.nv = BM; u.r0 = 0;
        u.a = A + (size_t)u.pm * BM * K * 2; u.b = Bt + (size_t)u.pn * BM * K * 2; return true;
    }
    __device__ __forceinline__ void rows(const Unit&, const int (&R)[2], const int (&C)[2], unsigned (&ra)[2][2]) const {
#pragma unroll
        for (int h = 0; h < 2; ++h)
#pragma unroll
            for (int i = 0; i < 2; ++i) ra[h][i] = (unsigned)(((h * HALF + R[i]) * K + C[i]) * 2);
    }
};
template <bool GATHER> struct MoeOrder {
    const char* A; const char* Bt; size_t bstride; int K, G, c; const LAS int* tp; const LAS int* cnt; const int* list;
    __device__ __forceinline__ bool next(int i, Unit& u) const {
        const int L = i * G + c; const int T = __builtin_amdgcn_readfirstlane(tp[NEXP]) * 4; if (L >= T) return false;
        const int rt = L >> 2; int e = 0;
        while (e < NEXP - 1 && __builtin_amdgcn_readfirstlane(tp[e + 1]) <= rt) ++e;
        const int lt = rt - __builtin_amdgcn_readfirstlane(tp[e]); const int rem = __builtin_amdgcn_readfirstlane(cnt[e]) - lt * BM;
        u.pm = rt; u.pn = L & 3; u.e = e; u.nv = rem < BM ? rem : BM; u.r0 = lt * BM;
        u.a = GATHER ? A : A + (size_t)rt * BM * K * 2; u.b = Bt + (size_t)e * bstride + (size_t)u.pn * BM * K * 2; return true;
    }
    __device__ __forceinline__ void rows(const Unit& u, const int (&R)[2], const int (&C)[2], unsigned (&ra)[2][2]) const {
#pragma unroll
        for (int h = 0; h < 2; ++h)
#pragma unroll
            for (int i = 0; i < 2; ++i) {
                if (GATHER) { const int lr = h * HALF + R[i]; const int tok = list[(size_t)u.e * CAP + u.r0 + (lr < u.nv ? lr : 0)]; ra[h][i] = (unsigned)((tok * K + C[i]) * 2); }
                else ra[h][i] = (unsigned)(((h * HALF + R[i]) * K + C[i]) * 2);
            }
    }
};

template <int K, class Epi, class Sched, bool GATHER, bool ALIGN_EPI>
__device__ __forceinline__ void gemm_phase(LAS unsigned char* lds, const Sched& S, const Epi& E) {
    int tid = threadIdx.x; asm volatile("" : "+v"(tid));
    const int wid = __builtin_amdgcn_readfirstlane(tid >> 6), lane = tid & 63, wr = wid >> 2, wc = wid & 3, fr = lane & 15, fq = lane >> 4;
    constexpr int nt = K / BK;
    int R[2], C[2]; unsigned voffB[2];
#pragma unroll
    for (int i = 0; i < 2; ++i) { stage_rc(tid * 16 + i * 8192, R[i], C[i]); const int Rb = Epi::PERM ? ((R[i] & ~31) + perm32(R[i] & 31)) : R[i]; voffB[i] = (unsigned)(Rb * K + C[i]) * 2u; }
    constexpr size_t kstep = (size_t)(BK * 2);
    constexpr size_t hstepB = (size_t)HALF * K * 2;
    const unsigned ldsw = (unsigned)wid * 1024u;
    const int aoff = lds_byte(wr * 64 + fr, fq * 8), boff = lds_byte(wc * 32 + fr, fq * 8);
#define PG8_SA(b, h) (((b) * 2 + (h)) * HTB)
#define PG8_SB(b, h) ((4 + (b) * 2 + (h)) * HTB)
#define PG8_STAGE_B(bufoff, gbase) do { _Pragma("unroll") for (int _i = 0; _i < 2; ++_i) \
        __builtin_amdgcn_global_load_lds((const unsigned*)((const char*)(gbase) + voffB[_i]), (LAS unsigned*)(lds + (bufoff) + ldsw + _i * 8192), 16, 0, 0); } while (0)
#define PG8_STAGE_A(bufoff, gbase, va, h) do { _Pragma("unroll") for (int _i = 0; _i < 2; ++_i) \
        __builtin_amdgcn_global_load_lds((const unsigned*)((const char*)(gbase) + (va)[h][_i]), (LAS unsigned*)(lds + (bufoff) + ldsw + _i * 8192), 16, 0, 0); } while (0)
#define PG8_LDA(dst, b, h) do { _Pragma("unroll") for (int m = 0; m < 4; ++m) _Pragma("unroll") for (int k = 0; k < 2; ++k) dst[m][k] = *(const LAS bf16x8*)(lds + PG8_SA(b, h) + aoff + m * 2048 + k * 1024); } while (0)
#define PG8_LDB(dst, b, h) do { _Pragma("unroll") for (int n = 0; n < 2; ++n) _Pragma("unroll") for (int k = 0; k < 2; ++k) dst[n][k] = *(const LAS bf16x8*)(lds + PG8_SB(b, h) + boff + n * 2048 + k * 1024); } while (0)
#define PG8_MMA(ai, bj, At, Bt) do { __builtin_amdgcn_s_setprio(1); _Pragma("unroll") for (int m = 0; m < 4; ++m) _Pragma("unroll") for (int n = 0; n < 2; ++n) _Pragma("unroll") for (int k = 0; k < 2; ++k) \
        acc[ai][bj][m][n] = __builtin_amdgcn_mfma_f32_16x16x32_bf16(Bt[n][k], At[m][k], acc[ai][bj][m][n], 0, 0, 0); __builtin_amdgcn_s_setprio(0); } while (0)
#define PG8_WAIT_V(n) asm volatile("s_waitcnt vmcnt(" #n ")" ::: "memory")
#define PG8_WAIT_L(n) asm volatile("s_waitcnt lgkmcnt(" #n ")" ::: "memory")
#define PG8_BAR __builtin_amdgcn_s_barrier()
#define PG8_SCHED __builtin_amdgcn_sched_barrier(0)
    Unit cur, nxt; int ui = 0;
    if (!S.next(0, cur)) return;
    unsigned vAc[2][2], vAn[2][2];
    S.rows(cur, R, C, vAc);
    f32x4 acc[2][2][4][2];
#pragma unroll
    for (int a = 0; a < 2; ++a)
#pragma unroll
        for (int b = 0; b < 2; ++b)
#pragma unroll
            for (int m = 0; m < 4; ++m)
#pragma unroll
                for (int n = 0; n < 2; ++n) acc[a][b][m][n] = (f32x4){0.f, 0.f, 0.f, 0.f};
    bf16x8 At[4][2], B0[2][2], B1[2][2];
    const char* cA = cur.a; const char* cB = cur.b;
    PG8_STAGE_B(PG8_SB(0, 0), cB); PG8_STAGE_B(PG8_SB(0, 1), cB + hstepB); PG8_STAGE_A(PG8_SA(0, 0), cA, vAc, 0); PG8_STAGE_A(PG8_SA(0, 1), cA, vAc, 1);
    if (wr == 1) PG8_BAR;
    PG8_WAIT_V(2); PG8_BAR;
    PG8_STAGE_B(PG8_SB(1, 0), cB + kstep); PG8_STAGE_A(PG8_SA(1, 0), cA + kstep, vAc, 0); PG8_STAGE_B(PG8_SB(1, 1), cB + hstepB + kstep);
    PG8_WAIT_V(6); PG8_BAR;
    for (;;) {
        const bool has_next = S.next(ui + 1, nxt);
        if (GATHER) { if (has_next) S.rows(nxt, R, C, vAn); else {
#pragma unroll
            for (int h = 0; h < 2; ++h)
#pragma unroll
                for (int i = 0; i < 2; ++i) vAn[h][i] = vAc[h][i]; } }
        const char* nA = has_next ? nxt.a : cA; const char* nB = has_next ? nxt.b : cB;
        for (int t = 0; t < nt; t += 2) {
            const bool last = (t == nt - 2);
            const char* a1 = cA + (size_t)(t + 1) * kstep;
            const char* a2 = last ? nA : cA + (size_t)(t + 2) * kstep; const char* b2 = last ? nB : cB + (size_t)(t + 2) * kstep;
            const char* a3 = a2 + kstep; const char* b3 = b2 + kstep;
            unsigned va2[2][2];
#pragma unroll
            for (int h = 0; h < 2; ++h)
#pragma unroll
                for (int i = 0; i < 2; ++i) va2[h][i] = (GATHER && last) ? vAn[h][i] : vAc[h][i];
            PG8_LDB(B0, 0, 0); PG8_LDB(B1, 0, 1); PG8_SCHED; PG8_LDA(At, 0, 0); PG8_STAGE_A(PG8_SA(1, 1), a1, vAc, 1);
            PG8_WAIT_V(8); PG8_WAIT_L(0); PG8_BAR; PG8_MMA(0, 0, At, B0); PG8_MMA(0, 1, At, B1); PG8_BAR; PG8_SCHED;
            PG8_LDA(At, 0, 1); PG8_STAGE_B(PG8_SB(0, 0), b2); PG8_STAGE_B(PG8_SB(0, 1), b2 + hstepB); PG8_STAGE_A(PG8_SA(0, 0), a2, va2, 0);
            PG8_WAIT_V(8); PG8_WAIT_L(0); PG8_BAR; PG8_MMA(1, 0, At, B0); PG8_MMA(1, 1, At, B1); PG8_BAR; PG8_SCHED;
            PG8_LDB(B0, 1, 0); PG8_LDB(B1, 1, 1); PG8_SCHED; PG8_LDA(At, 1, 0); PG8_STAGE_A(PG8_SA(0, 1), a2, va2, 1);
            PG8_WAIT_V(8); PG8_WAIT_L(0); PG8_BAR; PG8_MMA(0, 0, At, B0); PG8_MMA(0, 1, At, B1); PG8_BAR; PG8_SCHED;
            PG8_LDA(At, 1, 1); PG8_STAGE_B(PG8_SB(1, 0), b3); PG8_STAGE_B(PG8_SB(1, 1), b3 + hstepB); PG8_STAGE_A(PG8_SA(1, 0), a3, va2, 0);
            PG8_WAIT_V(8); PG8_WAIT_L(0); PG8_BAR; PG8_MMA(1, 0, At, B0); PG8_MMA(1, 1, At, B1); PG8_BAR; PG8_SCHED;
        }
        if constexpr (ALIGN_EPI) { if (wr == 0) PG8_BAR; }
        E(acc, cur, wr, wc, fr, fq);
        if (!has_next) break;
#pragma unroll
        for (int a = 0; a < 2; ++a)
#pragma unroll
            for (int b = 0; b < 2; ++b)
#pragma unroll
                for (int m = 0; m < 4; ++m)
#pragma unroll
                    for (int n = 0; n < 2; ++n) acc[a][b][m][n] = (f32x4){0.f, 0.f, 0.f, 0.f};
        cur = nxt; cA = nA; cB = nB; ++ui;
        if (GATHER) {
#pragma unroll
            for (int h = 0; h < 2; ++h)
#pragma unroll
                for (int i = 0; i < 2; ++i) vAc[h][i] = vAn[h][i]; }
        if constexpr (ALIGN_EPI) { if (wr == 1) PG8_BAR; }
    }
    PG8_WAIT_V(0);
    if constexpr (!ALIGN_EPI) { if (wr == 0) PG8_BAR; }
    PG8_BAR;
#undef PG8_SA
#undef PG8_SB
#undef PG8_STAGE_A
#undef PG8_STAGE_B
#undef PG8_LDA
#undef PG8_LDB
#undef PG8_MMA
#undef PG8_WAIT_V
#undef PG8_WAIT_L
#undef PG8_BAR
#undef PG8_SCHED
}

__device__ __forceinline__ unsigned cvt_pk_bf16(float lo, float hi) { unsigned r; asm volatile("v_cvt_pk_bf16_f32 %0, %1, %2" : "=v"(r) : "v"(lo), "v"(hi)); return r; }
__device__ __forceinline__ u32x4 pack8(const f32x4& v0, const f32x4& v1) { u32x4 w; w.x = cvt_pk_bf16(v0[0], v0[1]); w.y = cvt_pk_bf16(v0[2], v0[3]); w.z = cvt_pk_bf16(v1[0], v1[1]); w.w = cvt_pk_bf16(v1[2], v1[3]); return w; }
__device__ __forceinline__ void unpack8(const u32x4& w, f32x4& v0, f32x4& v1) { v0 = (f32x4){bflo(w.x), bfhi(w.x), bflo(w.y), bfhi(w.y)}; v1 = (f32x4){bflo(w.z), bfhi(w.z), bflo(w.w), bfhi(w.w)}; }
__device__ __forceinline__ u32x4 ld16_sc1(const void* p) { u32x4 v; asm volatile("global_load_dwordx4 %0, %1, off sc1\n\ts_waitcnt vmcnt(0)" : "=v"(v) : "v"(p) : "memory"); return v; }

__device__ __forceinline__ u32x4 ld16_sc1_nw(const void* p) { u32x4 v; asm volatile("global_load_dwordx4 %0, %1, off sc1" : "=v"(v) : "v"(p) : "memory"); return v; }
__device__ __forceinline__ void wait8(u32x4 (&v)[4][2]) { asm volatile("s_waitcnt vmcnt(0)" : "+v"(v[0][0]), "+v"(v[0][1]), "+v"(v[1][0]), "+v"(v[1][1]), "+v"(v[2][0]), "+v"(v[2][1]), "+v"(v[3][0]), "+v"(v[3][1]) :: "memory"); }
struct EpiIn {
    static constexpr bool PERM = true;
    bf16* base; const float* rstd;
    __device__ __forceinline__ void operator()(const f32x4 (&acc)[2][2][4][2], const Unit& u, int wr, int wc, int fr, int fq) const {
        const int t = u.pn >> 2; bf16* O = base + (size_t)t * M * 1024;
        const int row0 = u.pm * BM + wr * 64 + fr, col0 = (u.pn & 3) * BM + wc * 32 + 8 * fq;
        float rs[2][4];
#pragma unroll
        for (int ai = 0; ai < 2; ++ai)
#pragma unroll
            for (int m = 0; m < 4; ++m) rs[ai][m] = rstd[row0 + ai * HALF + m * 16] * (t == 0 ? C2 : 1.0f);
#pragma unroll
        for (int ai = 0; ai < 2; ++ai)
#pragma unroll
            for (int m = 0; m < 4; ++m) { bf16* rowp = O + (size_t)(row0 + ai * HALF + m * 16) * 1024 + col0;
#pragma unroll
                for (int bj = 0; bj < 2; ++bj) { f32x4 v0 = acc[ai][bj][m][0] * rs[ai][m], v1 = acc[ai][bj][m][1] * rs[ai][m];
                    if (t == 4) {
#pragma unroll
                        for (int q = 0; q < 4; ++q) { v0[q] = gelu_tanh(v0[q]); v1[q] = gelu_tanh(v1[q]); } }
                    else if (t >= 5) {
#pragma unroll
                        for (int q = 0; q < 4; ++q) { v0[q] = sigmoidf_(v0[q]); v1[q] = sigmoidf_(v1[q]); } }
                    const u32x4 pk_ = pack8(v0, v1);
                    if (t == 1 || t == 2) {
                        const int row = row0 + ai * HALF + m * 16, b_ = row >> 13, s_ = row & 8191, tile = s_ >> 6, key = s_ & 63, cc = col0 + bj * HALF;
                        size_t off;
                        if (t == 1) off = ((size_t)((b_ * 16 + (cc >> 6)) * 128 + tile)) * 8192 + ((cc & 63) >> 3) * 1024 + key * 16;
                        else off = ((size_t)((b_ * 8 + (cc >> 7)) * 128 + tile)) * 16384 + ((cc & 127) >> 5) * 4096 + key * 64 + ((cc & 31) >> 3) * 16;
                        *(u32x4*)((char*)O + off) = pk_;
                    } else *(u32x4*)(rowp + bj * HALF) = pk_; } }
    }
};
struct EpiBf {
    static constexpr bool PERM = true;
    bf16* O; int ldc;
    __device__ __forceinline__ void operator()(const f32x4 (&acc)[2][2][4][2], const Unit& u, int wr, int wc, int fr, int fq) const {
        const int row0 = u.pm * BM + wr * 64 + fr, col0 = u.pn * BM + wc * 32 + 8 * fq;
#pragma unroll
        for (int ai = 0; ai < 2; ++ai)
#pragma unroll
            for (int m = 0; m < 4; ++m) { bf16* rowp = O + (size_t)(row0 + ai * HALF + m * 16) * ldc + col0;
#pragma unroll
                for (int bj = 0; bj < 2; ++bj) *(u32x4*)(rowp + bj * HALF) = pack8(acc[ai][bj][m][0], acc[ai][bj][m][1]); }
    }
};
template <bool FIRST> struct EpiMix {
    static constexpr bool PERM = true;
    bf16* mixed; const bf16* gate;
    __device__ __forceinline__ void operator()(const f32x4 (&acc)[2][2][4][2], const Unit& u, int wr, int wc, int fr, int fq) const {
        const int row0 = u.pm * BM + wr * 64 + fr, col0 = u.pn * BM + wc * 32 + 8 * fq;
#pragma unroll
        for (int ai = 0; ai < 2; ++ai) {
            u32x4 pw[4][2], gw[4][2];
#pragma unroll
            for (int m = 0; m < 4; ++m)
#pragma unroll
                for (int bj = 0; bj < 2; ++bj) { const size_t ro = (size_t)(row0 + ai * HALF + m * 16) * 1024 + col0 + bj * HALF; gw[m][bj] = *(const u32x4*)(gate + ro); if (!FIRST) pw[m][bj] = ld16_sc1_nw(mixed + ro); }
            if (!FIRST) wait8(pw);
#pragma unroll
            for (int m = 0; m < 4; ++m)
#pragma unroll
                for (int bj = 0; bj < 2; ++bj) { const size_t ro = (size_t)(row0 + ai * HALF + m * 16) * 1024 + col0 + bj * HALF; f32x4 g0, g1; unpack8(gw[m][bj], g0, g1);
                    f32x4 v0 = acc[ai][bj][m][0] * g0, v1 = acc[ai][bj][m][1] * g1;
                    if (!FIRST) { f32x4 p0, p1; unpack8(pw[m][bj], p0, p1); v0 += p0; v1 += p1; }
                    *(u32x4*)(mixed + ro) = pack8(v0, v1); }
        }
    }
};
struct EpiOut {
    static constexpr bool PERM = true;
    const float* x; float* out; bf16* xb;
    __device__ __forceinline__ void operator()(const f32x4 (&acc)[2][2][4][2], const Unit& u, int wr, int wc, int fr, int fq) const {
        const int row0 = u.pm * BM + wr * 64 + fr, col0 = u.pn * BM + wc * 32 + 8 * fq;
#pragma unroll
        for (int ai = 0; ai < 2; ++ai)
#pragma unroll
            for (int m = 0; m < 4; ++m) { const size_t ro = (size_t)(row0 + ai * HALF + m * 16) * 1024 + col0;
#pragma unroll
                for (int bj = 0; bj < 2; ++bj) { const f32x4 x0 = *(const f32x4*)(x + ro + bj * HALF), x1 = *(const f32x4*)(x + ro + bj * HALF + 4);
                    const f32x4 v0 = acc[ai][bj][m][0] + x0, v1 = acc[ai][bj][m][1] + x1;
                    *(f32x4*)(out + ro + bj * HALF) = v0; *(f32x4*)(out + ro + bj * HALF + 4) = v1;
                    *(u32x4*)(xb + ro + bj * HALF) = pack8(v0, v1); } }
    }
};
struct EpiGU {
    static constexpr bool PERM = true;
    bf16* hid; const int* list; const i32x4* tokinfo;
    __device__ __forceinline__ void operator()(const f32x4 (&acc)[2][2][4][2], const Unit& u, int wr, int wc, int fr, int fq) const {
        const int lr0 = wr * 64 + fr, col0 = u.pn * HALF + wc * 32 + 8 * fq;
#pragma unroll
        for (int ai = 0; ai < 2; ++ai)
#pragma unroll
            for (int m = 0; m < 4; ++m) { const int lr = lr0 + ai * HALF + m * 16; const bool valid = lr < u.nv;
                const int tok = list[(size_t)u.e * CAP + u.r0 + (valid ? lr : 0)];
                const i32x4 t0 = tokinfo[tok * 2], t1 = tokinfo[tok * 2 + 1];
                const float cw = (t0.x == u.e) ? __int_as_float(t1.x) : __int_as_float(t1.y), rs = __int_as_float(t1.z);
                f32x4 h0, h1;
#pragma unroll
                for (int q = 0; q < 4; ++q) { const float g0 = acc[ai][0][m][0][q] * rs, u0 = acc[ai][1][m][0][q] * rs, g1 = acc[ai][0][m][1][q] * rs, u1 = acc[ai][1][m][1][q] * rs;
                    h0[q] = cw * g0 * sigmoidf_(g0) * u0; h1[q] = cw * g1 * sigmoidf_(g1) * u1; }
                if (valid) *(u32x4*)(hid + (size_t)(u.pm * BM + lr) * FF + col0) = pack8(h0, h1); }
    }
};
struct EpiPle {
    static constexpr bool PERM = true;
    float* out; const bf16* proj; const float* rstd;
    __device__ __forceinline__ void operator()(const f32x4 (&acc)[2][2][4][2], const Unit& u, int wr, int wc, int fr, int fq) const {
        const int row0 = u.pm * BM + wr * 64 + fr, col0 = u.pn * BM + wc * 32 + 8 * fq;
#pragma unroll
        for (int ai = 0; ai < 2; ++ai) {
            u32x4 pw[4][2]; float rs[4];
#pragma unroll
            for (int m = 0; m < 4; ++m) { rs[m] = rstd[row0 + ai * HALF + m * 16];
#pragma unroll
                for (int bj = 0; bj < 2; ++bj) pw[m][bj] = ld16_sc1_nw(proj + (size_t)(row0 + ai * HALF + m * 16) * 1024 + col0 + bj * HALF); }
            wait8(pw);
#pragma unroll
            for (int m = 0; m < 4; ++m)
#pragma unroll
                for (int bj = 0; bj < 2; ++bj) { const size_t ro = (size_t)(row0 + ai * HALF + m * 16) * 1024 + col0 + bj * HALF; f32x4 p0, p1; unpack8(pw[m][bj], p0, p1);
                    const f32x4 x0 = *(const f32x4*)(out + ro), x1 = *(const f32x4*)(out + ro + 4);
                    f32x4 v0, v1;
#pragma unroll
                    for (int q = 0; q < 4; ++q) { v0[q] = x0[q] + sigmoidf_(acc[ai][bj][m][0][q] * rs[m]) * p0[q]; v1[q] = x1[q] + sigmoidf_(acc[ai][bj][m][1][q] * rs[m]) * p1[q]; }
                    *(f32x4*)(out + ro) = v0; *(f32x4*)(out + ro + 4) = v1; }
        }
    }
};
}

namespace attn3 {
typedef short s16x4 __attribute__((ext_vector_type(4)));
typedef short v4i16_t __attribute__((ext_vector_type(4)));
typedef LAS const unsigned char* lds_cptr;
constexpr int DM = 1024, QB = 256, KVB = 64, KSLOT = 8192, VSLOT = 16384;
constexpr int NKS = 5, NVS = 4;
constexpr int L_K = 0, L_V = NKS * KSLOT, L_WS = L_V + NVS * VSLOT, L_Q = L_WS + 2048, L_END = L_Q + 8 * 4096, L_OST = 0, OSTS = 272;
static_assert(8 * 32 * OSTS <= L_WS, "O staging inside the ring area");
static_assert(L_END <= CTLL_OFF, "attention LDS map");
__device__ __forceinline__ void glds16(const void* gbase  , unsigned voff  , unsigned lds_dst) { unsigned keep;
    asm volatile("s_mov_b32 %0, m0\n\ts_mov_b32 m0, %3\n\ts_nop 0\n\tglobal_load_lds_dwordx4 %1, %2\n\ts_mov_b32 m0, %0" : "=&s"(keep) : "v"(voff), "s"(gbase), "s"(lds_dst) : "memory"); }
__device__ __forceinline__ s16x4 vtr(lds_cptr p) { return __builtin_bit_cast(s16x4, __builtin_amdgcn_ds_read_tr16_b64_v4i16((LAS v4i16_t*)p)); }
__device__ __forceinline__ unsigned cvtpk(float lo, float hi) { typedef float f2 __attribute__((ext_vector_type(2))); typedef __bf16 b2 __attribute__((ext_vector_type(2))); f2 v = {lo, hi}; b2 b = __builtin_convertvector(v, b2); return __builtin_bit_cast(unsigned, b); }
__device__ __forceinline__ int lane_now() { int l; asm volatile("v_mbcnt_lo_u32_b32 %0, -1, 0\n\tv_mbcnt_hi_u32_b32 %0, -1, %0" : "=v"(l)); return l; }
#define A2_WAIT_BAR(N) asm volatile("s_waitcnt vmcnt(" #N ") lgkmcnt(0)\n\ts_barrier" ::: "memory")
#define A2_SB() __builtin_amdgcn_sched_barrier(0)

template <int THRL, bool COMBINE>
__device__ __forceinline__ void unit(long rowbase, int qb, const bf16* Qp, const bf16* Kp, const bf16* Vp, bf16* Op, float lam, LAS unsigned char* shm) {
    int tid = threadIdx.x; asm volatile("" : "+v"(tid));
    const int lane = tid & 63, r32 = lane & 31, hi = lane >> 5; const int wid = __builtin_amdgcn_readfirstlane(tid >> 6), half = wid >> 2;
    const int q0 = qb * QB, NT = (q0 + QB) / KVB;
    const bf16* Qw = Qp + (rowbase + q0 + wid * 32) * DM;
    const char* Kh = (const char*)Kp; const char* Vh = (const char*)Vp;
    const unsigned lds0 = (unsigned)(uintptr_t)shm;
    LAS float* wsf = (LAS float*)(shm + L_WS) + wid * 64;
    const unsigned koff = (unsigned)(wid * 1024 + lane * 16);
    const unsigned voff = koff;
    const unsigned kdst = lds0 + L_K + wid * 1024, vdst = lds0 + L_V + wid * 1024;
#define DMA_K(t, slot) glds16(Kh + (size_t)(t) * KSLOT, koff, (unsigned)__builtin_amdgcn_readfirstlane(kdst + (slot)))
#define DMA_V(t, slot) do { glds16(Vh + (size_t)(t) * VSLOT, voff, (unsigned)__builtin_amdgcn_readfirstlane(vdst + (slot))); glds16(Vh + (size_t)(t) * VSLOT + 8192, voff, (unsigned)__builtin_amdgcn_readfirstlane(vdst + (slot) + 8192)); } while (0)
    const lds_cptr kp0 = shm + L_K + hi * 1024 + r32 * 16;
    const lds_cptr vp0 = shm + L_V + ((lane >> 4) & 1) * 32 + (lane & 3) * 8 + (4 * hi + ((lane & 15) >> 2)) * 64;
    DMA_K(0, 0); DMA_K(1, KSLOT); DMA_K(2, 2 * KSLOT); DMA_K(3, 3 * KSLOT); if (NT > 4) DMA_K(4, 4 * KSLOT); DMA_V(0, 0); DMA_V(1, VSLOT);
    const LAS unsigned char* qst = shm + L_Q + wid * 4096 + hi * 512 + r32 * 16;
    {
#pragma unroll
        for (int d0 = 0; d0 < 4; ++d0) { const bf16x8 q_ = *reinterpret_cast<const bf16x8*>(&Qw[(long)r32 * DM + d0 * 16 + hi * 8]); *(LAS bf16x8*)(shm + L_Q + wid * 4096 + hi * 512 + r32 * 16 + d0 * 1024) = q_; }
    }
    float mhat = 0.f, l_reg = 0.f; float zz_; asm volatile("v_mov_b32 %0, 0" : "=v"(zz_));
    f32x16 o[4];
#pragma unroll
    for (int r = 0; r < 16; ++r) { o[0][r] = zz_; o[1][r] = zz_; o[2][r] = zz_; o[3][r] = zz_; }
    f32x16 SA0, SA1, SB0, SB1; u32x4 PA[4], PB[4];
    f32x16 negm;
#pragma unroll
    for (int r = 0; r < 16; ++r) negm[r] = zz_;
    asm volatile("" : "+v"(negm));
    bool resc = false;
    int ku = 0, vu = 2 * VSLOT;
#define QKT(S0, S1, kslot) do { const lds_cptr kb_ = kp0 + (kslot); \
        _Pragma("unroll") for (int d0 = 0; d0 < 4; ++d0) { const bf16x8 a0_ = *(const LAS bf16x8*)(kb_ + d0 * 2048), a1_ = *(const LAS bf16x8*)(kb_ + d0 * 2048 + 512), q_ = *(const LAS bf16x8*)(qst + d0 * 1024); \
            if (d0 == 0) { S0 = __builtin_amdgcn_mfma_f32_32x32x16_bf16(a0_, q_, (f32x16){}, 0, 0, 0); S1 = __builtin_amdgcn_mfma_f32_32x32x16_bf16(a1_, q_, (f32x16){}, 0, 0, 0); } \
            else { S0 = __builtin_amdgcn_mfma_f32_32x32x16_bf16(a0_, q_, S0, 0, 0, 0); S1 = __builtin_amdgcn_mfma_f32_32x32x16_bf16(a1_, q_, S1, 0, 0, 0); } } } while (0)
#define VFL(f) do { vl_[(f) % 3] = vtr(vb_ + ((f) & 3) * 4096 + ((f) >> 2) * 1024); vh_[(f) % 3] = vtr(vb_ + ((f) & 3) * 4096 + ((f) >> 2) * 1024 + 512); } while (0)
#define PVF(P, f) do { const bf16x8 pa_ = __builtin_bit_cast(bf16x8, P[(f) >> 2]); const bf16x8 vf_ = (bf16x8){vl_[(f) % 3][0], vl_[(f) % 3][1], vl_[(f) % 3][2], vl_[(f) % 3][3], vh_[(f) % 3][0], vh_[(f) % 3][1], vh_[(f) % 3][2], vh_[(f) % 3][3]}; \
        o[(f) & 3] = __builtin_amdgcn_mfma_f32_32x32x16_bf16(pa_, vf_, o[(f) & 3], 0, 0, 0); } while (0)
#define PVSTEP(P, f) do { PVF(P, f); if ((f) + 3 < 16) VFL((f) + 3); A2_SB(); } while (0)
#define PVALL(P) do { PVSTEP(P, 0); PVSTEP(P, 1); PVSTEP(P, 2); PVSTEP(P, 3); PVSTEP(P, 4); PVSTEP(P, 5); PVSTEP(P, 6); PVSTEP(P, 7); PVSTEP(P, 8); PVSTEP(P, 9); PVSTEP(P, 10); PVSTEP(P, 11); PVSTEP(P, 12); PVSTEP(P, 13); PVSTEP(P, 14); PVSTEP(P, 15); } while (0)
#define PVM(P, vslot) do { const lds_cptr vb_ = vp0 + (vslot); s16x4 vl_[3], vh_[3]; VFL(0); VFL(1); VFL(2); A2_SB(); PVALL(P); } while (0)
#define KQL(d0, j) do { kf_[2 * (j)] = *(const LAS bf16x8*)(kb_ + (d0) * 2048); kf_[2 * (j) + 1] = *(const LAS bf16x8*)(kb_ + (d0) * 2048 + 512); qf_[j] = *(const LAS bf16x8*)(qst + (d0) * 1024); } while (0)
#define PIN(x) asm volatile("" : "+v"(x))
#define RESC() do { if (resc) { asm volatile("s_waitcnt lgkmcnt(0)" ::: "memory"); \
        const LAS float* wl_ = wsf + 4 * (lane_now() >> 5); _Pragma("unroll") for (int r = 0; r < 16; ++r) { const float f_ = wl_[crow16(r, 0)]; o[0][r] *= f_; o[1][r] *= f_; o[2][r] *= f_; o[3][r] *= f_; } resc = false; } } while (0)
#define DECIDE(S0, S1, FIRST, JB) do { \
        if ((JB) >= 0) { const int ln_ = lane_now(); const int qrel_ = wid * 32 + (ln_ & 31); const int kb2_ = 64 * (JB) + 4 * (ln_ >> 5); _Pragma("unroll") for (int r = 0; r < 16; ++r) { const int kv_ = kb2_ + (r & 3) + 8 * (r >> 2); if (kv_ > qrel_) S0[r] = -INFINITY; if (kv_ + 32 > qrel_) S1[r] = -INFINITY; } } \
        float rm_; { float a_ = fmaxf(fmaxf(S0[0], S0[1]), S1[0]), b_ = fmaxf(fmaxf(S0[2], S0[3]), S1[1]); a_ = fmaxf(fmaxf(a_, S1[2]), S1[3]); \
            _Pragma("unroll") for (int r = 4; r < 16; r += 4) { a_ = fmaxf(fmaxf(a_, S0[r]), S0[r + 1]); b_ = fmaxf(fmaxf(b_, S0[r + 2]), S0[r + 3]); a_ = fmaxf(fmaxf(a_, S1[r]), S1[r + 1]); b_ = fmaxf(fmaxf(b_, S1[r + 2]), S1[r + 3]); } \
            rm_ = fmaxf(a_, b_); auto rr_ = __builtin_amdgcn_permlane32_swap(__float_as_uint(rm_), __float_as_uint(rm_), false, false); rm_ = fmaxf(__uint_as_float(rr_[0]), __uint_as_float(rr_[1])); } \
        if (FIRST) { mhat = rm_; _Pragma("unroll") for (int r = 0; r < 16; ++r) { S0[r] -= rm_; S1[r] -= rm_; negm[r] = -mhat; } PIN(negm); } \
        else if (__builtin_expect(__any(rm_ > (float)THRL), 0)) { const float dl_ = fmaxf(rm_, 0.f); mhat += dl_; \
            _Pragma("unroll") for (int r = 0; r < 16; ++r) { S0[r] -= dl_; S1[r] -= dl_; negm[r] = -mhat; } PIN(negm); \
            const float f_ = __builtin_amdgcn_exp2f(-dl_); l_reg *= f_; wsf[lane_now() & 31] = f_; resc = true; } \
        sacc = 0.f; } while (0)
#define EXP2S(S, r) do { S[r] = __builtin_amdgcn_exp2f(S[r]); S[(r) + 1] = __builtin_amdgcn_exp2f(S[(r) + 1]); } while (0)
#define EXPSL(S0, S1, f) do { if ((f) < 8) { EXP2S(S0, 2 * (f)); PIN(S0); } else { EXP2S(S1, 2 * ((f) - 8)); PIN(S1); } } while (0)
#define SUMPK(S0, S1, P, g) do { if ((g) < 4) { sacc += (S0[4 * (g)] + S0[4 * (g) + 1]) + (S0[4 * (g) + 2] + S0[4 * (g) + 3]); P[(g) >> 1][2 * ((g) & 1)] = cvtpk(S0[4 * (g)], S0[4 * (g) + 1]); P[(g) >> 1][2 * ((g) & 1) + 1] = cvtpk(S0[4 * (g) + 2], S0[4 * (g) + 3]); } \
        else { sacc += (S1[4 * ((g) - 4)] + S1[4 * ((g) - 4) + 1]) + (S1[4 * ((g) - 4) + 2] + S1[4 * ((g) - 4) + 3]); P[(g) >> 1][2 * ((g) & 1)] = cvtpk(S1[4 * ((g) - 4)], S1[4 * ((g) - 4) + 1]); P[(g) >> 1][2 * ((g) & 1) + 1] = cvtpk(S1[4 * ((g) - 4) + 2], S1[4 * ((g) - 4) + 3]); } \
        PIN(sacc); PIN(P[(g) >> 1]); } while (0)
#define PVX(Pp, Sc0, Sc1, f, HAS_PV) do { if (HAS_PV) { PVF(Pp, f); if ((f) + 3 < 16) VFL((f) + 3); } EXPSL(Sc0, Sc1, f); A2_SB(); } while (0)
#define QKM(Sn0, Sn1, j, first) do { if (first) { Sn0 = __builtin_amdgcn_mfma_f32_32x32x16_bf16(kf_[2 * ((j) & 1)], qf_[(j) & 1], negm, 0, 0, 0); } else { Sn0 = __builtin_amdgcn_mfma_f32_32x32x16_bf16(kf_[2 * ((j) & 1)], qf_[(j) & 1], Sn0, 0, 0, 0); } } while (0)
#define QKM1(Sn0, Sn1, j, first) do { if (first) { Sn1 = __builtin_amdgcn_mfma_f32_32x32x16_bf16(kf_[2 * ((j) & 1) + 1], qf_[(j) & 1], negm, 0, 0, 0); } else { Sn1 = __builtin_amdgcn_mfma_f32_32x32x16_bf16(kf_[2 * ((j) & 1) + 1], qf_[(j) & 1], Sn1, 0, 0, 0); } } while (0)
#define INTERVAL(Sc0, Sc1, Sn0, Sn1, Pp, Pn, ii, HAS_PV, HAS_QK, FIRST, JB, GK, GV, WN) do { \
        if (GK) DMA_K((ii) + 5, kfill_); if (GV) DMA_V((ii) + 2, vfill_); \
        const lds_cptr kb_ = kp0 + ku; const lds_cptr vb_ = vp0 + vu; bf16x8 kf_[4], qf_[2]; s16x4 vl_[3], vh_[3]; float sacc; \
        if (HAS_PV) { VFL(0); VFL(1); VFL(2); } \
        A2_SB(); \
        DECIDE(Sc0, Sc1, FIRST, JB); \
        A2_SB(); \
        PVX(Pp, Sc0, Sc1, 0, HAS_PV); PVX(Pp, Sc0, Sc1, 1, HAS_PV); PVX(Pp, Sc0, Sc1, 2, HAS_PV); PVX(Pp, Sc0, Sc1, 3, HAS_PV); PVX(Pp, Sc0, Sc1, 4, HAS_PV); PVX(Pp, Sc0, Sc1, 5, HAS_PV); PVX(Pp, Sc0, Sc1, 6, HAS_PV); PVX(Pp, Sc0, Sc1, 7, HAS_PV); \
        PVX(Pp, Sc0, Sc1, 8, HAS_PV); PVX(Pp, Sc0, Sc1, 9, HAS_PV); PVX(Pp, Sc0, Sc1, 10, HAS_PV); PVX(Pp, Sc0, Sc1, 11, HAS_PV); PVX(Pp, Sc0, Sc1, 12, HAS_PV); \
        if (HAS_QK) { KQL(0, 0); KQL(1, 1); } \
        PVX(Pp, Sc0, Sc1, 13, HAS_PV); PVX(Pp, Sc0, Sc1, 14, HAS_PV); PVX(Pp, Sc0, Sc1, 15, HAS_PV); \
        if (HAS_QK) { \
            QKM(Sn0, Sn1, 0, true); SUMPK(Sc0, Sc1, Pn, 0); A2_SB(); QKM1(Sn0, Sn1, 0, true); SUMPK(Sc0, Sc1, Pn, 1); A2_SB(); \
            QKM(Sn0, Sn1, 1, false); SUMPK(Sc0, Sc1, Pn, 2); A2_SB(); QKM1(Sn0, Sn1, 1, false); KQL(2, 0); KQL(3, 1); SUMPK(Sc0, Sc1, Pn, 3); A2_SB(); \
            QKM(Sn0, Sn1, 0, false); SUMPK(Sc0, Sc1, Pn, 4); A2_SB(); QKM1(Sn0, Sn1, 0, false); SUMPK(Sc0, Sc1, Pn, 5); A2_SB(); \
            QKM(Sn0, Sn1, 1, false); SUMPK(Sc0, Sc1, Pn, 6); A2_SB(); QKM1(Sn0, Sn1, 1, false); SUMPK(Sc0, Sc1, Pn, 7); A2_SB(); \
        } else { SUMPK(Sc0, Sc1, Pn, 0); SUMPK(Sc0, Sc1, Pn, 1); SUMPK(Sc0, Sc1, Pn, 2); SUMPK(Sc0, Sc1, Pn, 3); SUMPK(Sc0, Sc1, Pn, 4); SUMPK(Sc0, Sc1, Pn, 5); SUMPK(Sc0, Sc1, Pn, 6); SUMPK(Sc0, Sc1, Pn, 7); } \
        l_reg += sacc; \
        A2_WAIT_BAR(WN); RESC(); \
    } while (0)
#define ROT() do { ku = (ku == (NKS - 1) * KSLOT) ? 0 : ku + KSLOT; vu = (vu == (NVS - 1) * VSLOT) ? 0 : vu + VSLOT; } while (0)
#define kfill_ ((ku == 0) ? (NKS - 1) * KSLOT : ku - KSLOT)
#define vfill_ ((vu == 0) ? (NVS - 1) * VSLOT : vu - VSLOT)
    asm volatile("s_waitcnt vmcnt(0)\n\ts_barrier" ::: "memory");
    QKT(SA0, SA1, 0);
    asm volatile("s_waitcnt lgkmcnt(0)\n\ts_barrier" ::: "memory");
    ku = KSLOT; vu = (NVS - 1) * VSLOT;
    { const int jb0 = (NT == 4) ? 0 : -1;
      INTERVAL(SA0, SA1, SB0, SB1, PA, PB, 0, false, true, true, jb0, (NT > 5), true, 2); ROT(); }
    int i = 1;
    if (NT > 4) {
        for (; i + 5 < NT; i += 2) {
            INTERVAL(SB0, SB1, SA0, SA1, PB, PA, i, true, true, false, -1, true, true, 6); ROT();
            INTERVAL(SA0, SA1, SB0, SB1, PA, PB, i + 1, true, true, false, -1, true, true, 6); ROT();
        }
        INTERVAL(SB0, SB1, SA0, SA1, PB, PA, i, true, true, false, -1, false, true, 5); ROT(); ++i;
        INTERVAL(SA0, SA1, SB0, SB1, PA, PB, i, true, true, false, 0, false, true, 4); ROT(); ++i;
    }
    INTERVAL(SB0, SB1, SA0, SA1, PB, PA, i, true, true, false, 1, false, true, 4); ROT(); ++i;
    INTERVAL(SA0, SA1, SB0, SB1, PA, PB, i, true, true, false, 2, false, false, 2); ROT(); ++i;
    INTERVAL(SB0, SB1, SA0, SA1, PB, PA, i, true, false, false, 3, false, false, 0); ROT();
    PVM(PA, vu);
    A2_WAIT_BAR(0);
    { auto rr = __builtin_amdgcn_permlane32_swap(__float_as_uint(l_reg), __float_as_uint(l_reg), false, false); l_reg = __uint_as_float(rr[0]) + __uint_as_float(rr[1]); }
    const int lane_q = lane_now();
    wsf[32 + (lane_q & 31)] = l_reg;
    asm volatile("s_waitcnt lgkmcnt(0)" ::: "memory");
    float rli[16];
#pragma unroll
    for (int r = 0; r < 16; ++r) rli[r] = __builtin_amdgcn_rcpf(wsf[32 + crow16(r, lane_q >> 5)]);
    { const int lane_e = lane_q;
      const int r32e = lane_e & 31, hie = lane_e >> 5;
      bf16* Ow = Op + (rowbase + q0 + wid * 32) * DM;
      LAS unsigned char* stg = shm + L_OST + wid * 32 * OSTS;
#pragma unroll
      for (int r = 0; r < 16; ++r) { const int orow = crow16(r, hie);
#pragma unroll
          for (int dq = 0; dq < 4; ++dq) *(LAS unsigned short*)(stg + orow * OSTS + (dq * 32 + r32e) * 2) = (unsigned short)f2bf(o[dq][r] * rli[r]); }
      asm volatile("s_waitcnt lgkmcnt(0)" ::: "memory");
      if (!COMBINE) {
#pragma unroll
          for (int j = 0; j < 8; ++j) { const int row = j * 4 + (lane_e >> 4), pc = lane_e & 15; const u32x4 v = *(const LAS u32x4*)(stg + row * OSTS + pc * 16); *(u32x4*)(Ow + (long)row * DM + pc * 8) = v; }
      } else {
          const int row = lane_e >> 1, hf = lane_e & 1; bf16* o1p = Ow + (long)row * DM + hf * 64;
          u32x4 a1[8], b2[8];
#pragma unroll
          for (int j = 0; j < 8; ++j) { a1[j] = pg8::ld16_sc1_nw(o1p + 8 * j); b2[j] = *(const LAS u32x4*)(stg + row * OSTS + hf * 128 + j * 16); }
          asm volatile("s_waitcnt vmcnt(0)" : "+v"(a1[0]), "+v"(a1[1]), "+v"(a1[2]), "+v"(a1[3]), "+v"(a1[4]), "+v"(a1[5]), "+v"(a1[6]), "+v"(a1[7]) :: "memory");
          f32x4 ov[16]; float ss = 0.f;
#pragma unroll
          for (int j = 0; j < 8; ++j) { f32x4 x0, x1, y0, y1; pg8::unpack8(a1[j], x0, x1); pg8::unpack8(b2[j], y0, y1); ov[2 * j] = x0 - lam * y0; ov[2 * j + 1] = x1 - lam * y1;
              ss += (ov[2 * j].x * ov[2 * j].x + ov[2 * j].y * ov[2 * j].y) + (ov[2 * j].z * ov[2 * j].z + ov[2 * j].w * ov[2 * j].w) + (ov[2 * j + 1].x * ov[2 * j + 1].x + ov[2 * j + 1].y * ov[2 * j + 1].y) + (ov[2 * j + 1].z * ov[2 * j + 1].z + ov[2 * j + 1].w * ov[2 * j + 1].w); }
          ss += __shfl_xor(ss, 1);
          const float rs = 1.0f / sqrtf(ss * (1.0f / 128.0f) + 1e-5f);
#pragma unroll
          for (int j = 0; j < 8; ++j) *(u32x4*)(o1p + 8 * j) = pg8::pack8(ov[2 * j] * rs, ov[2 * j + 1] * rs);
      } }
    asm volatile("s_waitcnt lgkmcnt(0)\n\ts_barrier" ::: "memory");
#undef DMA_K
#undef DMA_V
#undef QKT
#undef VFL
#undef PVF
#undef PVSTEP
#undef PVALL
#undef KQL
#undef PIN
#undef DECIDE
#undef EXP2S
#undef EXPSL
#undef SUMPK
#undef PVX
#undef QKM
#undef QKM1
#undef PVM
#undef RESC
#undef INTERVAL
#undef ROT
#undef kfill_
#undef vfill_
}
#undef A2_WAIT_BAR
#undef A2_SB
}
#define XB_TMO      128
#define XB_XCNT(j)  (256  + 64 * (j))
#define XB_XSUB(j)  (1280 + 64 * (j))
#define XB_XGEN(j)  (2304 + 64 * (j))
#define XB_TOP      3328
#define XB_TOPGEN   3392
#define XCD_BAR_WORDS 3456
#define XB_SPIN_CAP (1u << 18)

__device__ __forceinline__ unsigned xb_ld(unsigned* p)              { return __hip_atomic_load(p, __ATOMIC_RELAXED, __HIP_MEMORY_SCOPE_AGENT); }
__device__ __forceinline__ unsigned xb_add(unsigned* p, unsigned v) { return __hip_atomic_fetch_add(p, v, __ATOMIC_RELAXED, __HIP_MEMORY_SCOPE_AGENT); }
__device__ __forceinline__ unsigned xb_xcc_id() { return (unsigned)__builtin_amdgcn_s_getreg((3 << 11) | 20) & 0xFu; }
#define XB_SPIN(cond, bar) do { unsigned _sp = 0; while (cond) { __builtin_amdgcn_s_sleep(1); \
    if ((++_sp & 255u) == 0u) { if (xb_ld(&(bar)[XB_TMO])) break; if (_sp > XB_SPIN_CAP) { atomicAdd(&(bar)[XB_TMO], 1u); break; } } } } while (0)

struct XcdBarrier {
    unsigned* bar; unsigned x;
    volatile LAS unsigned* st;
};

__device__ __forceinline__ XcdBarrier xcd_barrier_post(unsigned* bar, volatile LAS unsigned* st) {
    XcdBarrier b; b.bar = bar; b.x = xb_xcc_id(); b.st = st;
    if (threadIdx.x == 0) (void)xb_add(&bar[XB_XCNT(b.x)], 1u);
    return b;
}
__device__ __forceinline__ void xcd_barrier_complete(unsigned* bar, unsigned x, unsigned& nloc, unsigned& nx) {
    const unsigned G = gridDim.x * gridDim.y * gridDim.z;
    unsigned sum, cnt, mine, sp = 0u;
    for (;;) {
        sum = 0u; cnt = 0u; mine = 0u;
#pragma unroll
        for (unsigned j = 0; j < 16; ++j) { const unsigned c = xb_ld(&bar[XB_XCNT(j)]); sum += c; cnt += (c > 0u) ? 1u : 0u; mine = (j == x) ? c : mine; }
        if (sum == G) break;
        __builtin_amdgcn_s_sleep(1);
        if ((++sp & 255u) == 0u) { if (xb_ld(&bar[XB_TMO])) break; if (sp > XB_SPIN_CAP) { atomicAdd(&bar[XB_TMO], 1u); break; } }
    }
    nloc = mine > 0u ? mine : 1u; nx = cnt > 0u ? cnt : 1u;
}

__device__ __forceinline__ void xcd_barrier(const XcdBarrier& b) {
    asm volatile("s_waitcnt vmcnt(0)" ::: "memory");
    __syncthreads();
    if (threadIdx.x == 0) {
        unsigned* bar = b.bar;
        __builtin_amdgcn_s_waitcnt(0);
        unsigned nloc = b.st[0], nx = b.st[1];
        if (nloc == 0u) { xcd_barrier_complete(bar, b.x, nloc, nx); b.st[0] = nloc; b.st[1] = nx; }
        const unsigned old = xb_add(&bar[XB_XSUB(b.x)], 1u);
        const unsigned gen = old / nloc;
        if (old + 1u == (gen + 1u) * nloc) {
            __builtin_amdgcn_fence(__ATOMIC_RELEASE, "agent");
            asm volatile("s_waitcnt vmcnt(0)" ::: "memory");
            const unsigned og = xb_add(&bar[XB_TOP], 1u);
            const unsigned tg = og / nx;
            if (og + 1u == (tg + 1u) * nx) xb_add(&bar[XB_TOPGEN], 1u);
            else XB_SPIN(xb_ld(&bar[XB_TOPGEN]) == tg, bar);
            __builtin_amdgcn_fence(__ATOMIC_ACQUIRE, "agent");
            xb_add(&bar[XB_XGEN(b.x)], 1u);
            asm volatile("s_waitcnt vmcnt(0)" ::: "memory");
        } else {
            XB_SPIN(xb_ld(&bar[XB_XGEN(b.x)]) == gen, bar);
            __builtin_amdgcn_fence(__ATOMIC_ACQUIRE, "agent");
            asm volatile("s_waitcnt vmcnt(0)" ::: "memory");
        }
    }
    __syncthreads();
}

__device__ __forceinline__ int lane_id_v() { int l; asm volatile("v_mbcnt_lo_u32_b32 %0, -1, 0\n\tv_mbcnt_hi_u32_b32 %0, -1, %0" : "=v"(l)); return l; }
struct Ctx {
    LAS unsigned char* lds; int tid, lane, wave, vcu, G, gw, NGW;
};

struct TrDesc { const float* W; bf16* WT; const float* ksc; int K, N, kmask, mode, item; float kmul; };
struct TrRegs { f32x4 v[8]; float sc[8]; };
__device__ __forceinline__ void tr_load(const TrDesc& d, TrRegs& r, int lane) {
    const int nblk = d.N / 32, kb = d.item / nblk, nb = d.item % nblk, k0 = 64 * kb, n0 = 32 * nb;
#pragma unroll
    for (int i = 0; i < 8; ++i) { const int kk = 8 * i + (lane >> 3); r.v[i] = *(const f32x4*)(d.W + (size_t)(k0 + kk) * d.N + n0 + 4 * (lane & 7)); r.sc[i] = d.ksc ? d.ksc[(k0 + kk) & d.kmask] * d.kmul : 1.0f; }
}
__device__ __forceinline__ void tr_finish(const TrDesc& d, const TrRegs& r, LAS float* scr, int lane) {
    const int nblk = d.N / 32, kb = d.item / nblk, nb = d.item % nblk, k0 = 64 * kb, n0 = 32 * nb;
#pragma unroll
    for (int i = 0; i < 8; ++i) { const int kk = 8 * i + (lane >> 3); LAS float* p = scr + kk * 33 + 4 * (lane & 7); const f32x4 v = r.v[i] * r.sc[i]; p[0] = v.x; p[1] = v.y; p[2] = v.z; p[3] = v.w; }
    LDS_WAIT(); asm volatile("" ::: "memory");
    const int c = lane & 7;
#pragma unroll
    for (int j = 0; j < 4; ++j) { const int n = (lane >> 3) + 8 * j; const LAS float* s = scr + (8 * c) * 33 + n;
        u32x4 o; o.x = pk2(s[0 * 33], s[1 * 33]); o.y = pk2(s[2 * 33], s[3 * 33]); o.z = pk2(s[4 * 33], s[5 * 33]); o.w = pk2(s[6 * 33], s[7 * 33]);
        const int nn = n0 + n; const int dr = d.mode == 0 ? nn : ((nn >> 7) * 256 + (nn & 127) + (d.mode == 2 ? 128 : 0));
        *(GAS u32x4*)(d.WT + (size_t)dr * d.K + k0 + 8 * c) = o; }
    LDS_WAIT(); asm volatile("" ::: "memory");
}

struct Args { const float* in[31]; float* out; unsigned char* ws; int ph_lo, ph_hi; };
#define AS4 __attribute__((address_space(4)))
struct KA { const AS4 char* p;
    __device__ __forceinline__ const float* in(int i) const { return *(const float* const AS4*)(p + 8 * i); }
    __device__ __forceinline__ float* out() const { return *(float* const AS4*)(p + 8 * 31); }
    __device__ __forceinline__ unsigned char* ws() const { return *(unsigned char* const AS4*)(p + 8 * 32); }
    __device__ __forceinline__ int lo() const { return *(const int AS4*)(p + 8 * 33); }
    __device__ __forceinline__ int hi() const { return *(const int AS4*)(p + 8 * 33 + 4); }
};
__device__ __forceinline__ KA ka_get() { const AS4 char* p = (const AS4 char*)__builtin_amdgcn_kernarg_segment_ptr(); asm volatile("" : "+s"(p)); return KA{p}; }

__device__ __forceinline__ void p0_prologue(const Ctx& F, const KA& a) {
    unsigned char* ws = a.ws();
    LAS float* scr = (LAS float*)(F.lds + RING_OFF + F.wave * 16384);
    constexpr int I_IN = (D / 64) * (NIN / 32), I_SQ = (D / 64) * (D / 32), I_PP = (PLE / 64) * (D / 32);
    constexpr int NITEMS = I_IN + 4 * I_SQ + I_PP;
    auto dec0 = [&](int it, TrDesc& d) { int r = it; d.kmul = 1.0f; d.mode = 0; d.ksc = nullptr; d.kmask = 0;
        if (r < I_IN) { d.W = a.in(3); d.K = D; d.N = NIN; d.WT = (bf16*)(ws + WS_WIN); d.ksc = a.in(2); d.kmask = 1023; d.item = r; return; } r -= I_IN;
        if (r < I_SQ) { d.W = a.in(16); d.K = D; d.N = D; d.WT = (bf16*)(ws + WS_WA); d.ksc = a.in(8); d.kmask = 127; d.kmul = 1.0f - LAM_INIT; d.item = r; return; } r -= I_SQ;
        if (r < I_SQ) { d.W = a.in(17); d.K = D; d.N = D; d.WT = (bf16*)(ws + WS_WL); d.item = r; return; } r -= I_SQ;
        if (r < I_SQ) { d.W = a.in(18); d.K = D; d.N = D; d.WT = (bf16*)(ws + WS_WO); d.item = r; return; } r -= I_SQ;
        if (r < I_SQ) { d.W = a.in(28); d.K = D; d.N = D; d.WT = (bf16*)(ws + WS_WPG); d.ksc = a.in(27); d.kmask = 1023; d.item = r; return; } r -= I_SQ;
        d.W = a.in(29); d.K = PLE; d.N = D; d.WT = (bf16*)(ws + WS_WPP); d.item = r; };
    { int it = F.gw; TrDesc dc, dn; TrRegs rc, rn;
      if (it < NITEMS) { dec0(it, dc); tr_load(dc, rc, F.lane); }
      while (it < NITEMS) { const int itn = it + F.NGW; if (itn < NITEMS) { dec0(itn, dn); tr_load(dn, rn, F.lane); }
          tr_finish(dc, rc, scr, F.lane); dc = dn; rc = rn; it = itn; } }
    const int gt = F.gw * 64 + F.lane, NGT = F.NGW * 64;
    { float* Wr = (float*)(ws + WS_WR); const float* gm = a.in(19);
      for (int i = gt; i < 36 * 1024; i += NGT) { const int j = i >> 10, k = i & 1023; const float w = j < 32 ? a.in(22)[(size_t)((j >> 3) * 1024 + k) * 8 + (j & 7)] : a.in(20)[k * 4 + (j - 32)]; Wr[i] = w * gm[k]; } }
    { bf16* Wl = (bf16*)(ws + WS_WLRU);
      for (int i = gt; i < 2 * 65536; i += NGT) { const int gate = i >> 16, n = (i >> 12) & 15, v = (i >> 6) & 63, w = i & 63; const float* src = gate ? a.in(13) : a.in(11); Wl[i] = (bf16)f2bf(src[(n * 64 + w) * 64 + v]); } }
    { const float* x = a.in(0); bf16* xb = (bf16*)(ws + WS_U0); float* rstd0 = (float*)(ws + WS_RSTD0);
      for (int m0 = F.gw; m0 < M; m0 += 4 * F.NGW) { f32x4 v[4][4]; float s[4];
#pragma unroll
          for (int r = 0; r < 4; ++r) { const int m = m0 + r * F.NGW; if (m < M) { const GAS f32x4* xr = (const GAS f32x4*)(x + (size_t)m * D) + F.lane;
#pragma unroll
              for (int j = 0; j < 4; ++j) v[r][j] = xr[64 * j]; } }
#pragma unroll
          for (int r = 0; r < 4; ++r) { s[r] = 0.f;
#pragma unroll
              for (int j = 0; j < 4; ++j) s[r] += (v[r][j].x * v[r][j].x + v[r][j].y * v[r][j].y) + (v[r][j].z * v[r][j].z + v[r][j].w * v[r][j].w); }
#pragma unroll
          for (int o = 1; o < 64; o <<= 1) {
#pragma unroll
              for (int r = 0; r < 4; ++r) s[r] += __shfl_xor(s[r], o); }
#pragma unroll
          for (int r = 0; r < 4; ++r) { const int m = m0 + r * F.NGW; if (m < M) { if (F.lane == 0) rstd0[m] = 1.0f / sqrtf(s[r] * (1.0f / D) + 1e-6f);
              GAS u32x2* o8 = (GAS u32x2*)(xb + (size_t)m * D) + F.lane;
#pragma unroll
              for (int j = 0; j < 4; ++j) o8[64 * j] = (u32x2){pk2(v[r][j].x, v[r][j].y), pk2(v[r][j].z, v[r][j].w)}; } } } }
    { const f32x4* p4 = (const f32x4*)a.in(1); u32x2* pb = (u32x2*)(ws + WS_PB);
      for (int i = gt; i < M * PLE / 4; i += NGT) { const f32x4 v = p4[i]; pb[i] = (u32x2){pk2(v.x, v.y), pk2(v.z, v.w)}; } }
}

template <bool FINAL>
__device__ __forceinline__ void lru_pass(const Ctx& F, const bf16* xr, bf16* gl, float* summ, const bf16* Wlru, const float* w_conv, const float* b_conv, const float* b_rg, const float* b_ig, const float* lam) {
    const int tid = F.tid, lane = F.lane, wave = F.wave, r32 = lane & 31, hi = lane >> 5;
    constexpr int XRS = 144;
    LAS unsigned char* XR = F.lds; LAS unsigned char* XC = F.lds + 37376; LAS unsigned char* GR = F.lds + 74240;
    LAS float* WS = (LAS float*)(F.lds + 111104); LAS float* WCV = (LAS float*)(F.lds + 115200); LAS unsigned char* WG = F.lds + 116480;
    for (int uu = F.vcu; uu < 256; uu += F.G) {
        const int bn = uu >> 3, b = bn >> 4, n = bn & 15, c0 = (uu & 7) * 4;
        const size_t rowb = (size_t)b * SEQ;
        __syncthreads();
        if (tid < 320) { const int j = tid >> 6, c = tid & 63; WCV[tid] = (j < 4) ? w_conv[j * 1024 + 64 * n + c] : b_conv[64 * n + c]; }
        for (int idx = tid; idx < 2 * 64 * 8; idx += 512) { const int gate = idx >> 9, v = (idx >> 3) & 63, pc = idx & 7;
            *(LAS u32x4*)(WG + (gate * 64 + v) * XRS + pc * 16) = *(const u32x4*)(Wlru + ((size_t)(gate * 16 + n) * 64 + v) * 64 + pc * 8); }
        float brg[2], big[2], cdec[2], hc[2], Arun[2];
#pragma unroll
        for (int hf = 0; hf < 2; ++hf) { const int oc = 64 * n + 32 * hf + r32; brg[hf] = b_rg[oc]; big[hf] = b_ig[oc]; cdec[hf] = -8.0f * log1pf(expf(-lam[oc])) * 1.4426950408889634f; hc[hf] = 0.f; Arun[hf] = 1.f;
            if (FINAL) for (int u2 = uu & ~7; u2 < uu; ++u2) { const float A = summ[(u2 * 64 + 32 * hf + r32) * 2], B = summ[(u2 * 64 + 32 * hf + r32) * 2 + 1]; hc[hf] = A * hc[hf] + B; } }
        u32x4 st[5];
#pragma unroll
        for (int k = 0; k < 5; ++k) { const int idx = tid + 512 * k, row = idx >> 3, pc = idx & 7, t = c0 * 256 - 3 + row; st[k] = (u32x4){0u, 0u, 0u, 0u};
            if (idx < 259 * 8 && t >= 0) st[k] = *(const u32x4*)(xr + (rowb + t) * 1024 + 64 * n + 8 * pc); }
        for (int ci = 0; ci < 4; ++ci) {
            const int t0 = (c0 + ci) * 256;
#pragma unroll
            for (int k = 0; k < 5; ++k) { const int idx = tid + 512 * k, row = idx >> 3, pc = idx & 7; if (idx < 259 * 8) *(LAS u32x4*)(XR + row * XRS + pc * 16) = st[k]; }
            bf16* gw_ = gl + (rowb + t0 + 32 * wave) * 1024 + 64 * n;
            LAS unsigned char* GRw = GR + 32 * wave * XRS;
            if (FINAL) {
#pragma unroll
                for (int i = 0; i < 4; ++i) { const int row = (lane >> 3) + 8 * i, pc = lane & 7; *(LAS u32x4*)(GRw + row * XRS + pc * 16) = *(const u32x4*)(gw_ + (size_t)row * 1024 + 8 * pc); } }
            __syncthreads();
            if (ci < 3) {
#pragma unroll
                for (int k = 0; k < 5; ++k) { const int idx = tid + 512 * k, row = idx >> 3, pc = idx & 7, t = t0 + 256 - 3 + row;
                    if (idx < 259 * 8) st[k] = *(const u32x4*)(xr + (rowb + t) * 1024 + 64 * n + 8 * pc); } }
            const int trow = 32 * wave + r32;
            bf16x8 av8[4];
#pragma unroll
            for (int ks = 0; ks < 4; ++ks) { const int c8 = 16 * ks + 8 * hi;
                f32x4 x0 = *(const LAS f32x4*)(WCV + 256 + c8), x1 = *(const LAS f32x4*)(WCV + 256 + c8 + 4);
#pragma unroll
                for (int j = 0; j < 4; ++j) { const u32x4 xv = *(const LAS u32x4*)(XR + (trow + j) * XRS + c8 * 2);
                    const f32x4 w0 = *(const LAS f32x4*)(WCV + j * 64 + c8), w1 = *(const LAS f32x4*)(WCV + j * 64 + c8 + 4);
                    x0 += w0 * (f32x4){bflo(xv.x), bfhi(xv.x), bflo(xv.y), bfhi(xv.y)}; x1 += w1 * (f32x4){bflo(xv.z), bfhi(xv.z), bflo(xv.w), bfhi(xv.w)}; }
                const u32x4 pk = (u32x4){pk2(x0[0], x0[1]), pk2(x0[2], x0[3]), pk2(x1[0], x1[1]), pk2(x1[2], x1[3])};
                av8[ks] = __builtin_bit_cast(bf16x8, pk);
                *(LAS u32x4*)(XC + trow * XRS + c8 * 2) = pk; }
            float av[2][16], uv[2][16], pA[2][4], pB[2][4];
#pragma unroll
            for (int hf = 0; hf < 2; ++hf) {
                f32x16 aR = {}, aI = {};
#pragma unroll
                for (int ks = 0; ks < 4; ++ks) { const bf16x8 bR = *(const LAS bf16x8*)(WG + (0 * 64 + 32 * hf + r32) * XRS + (16 * ks + 8 * hi) * 2), bI = *(const LAS bf16x8*)(WG + (1 * 64 + 32 * hf + r32) * XRS + (16 * ks + 8 * hi) * 2);
                    aR = __builtin_amdgcn_mfma_f32_32x32x16_bf16(av8[ks], bR, aR, 0, 0, 0); aI = __builtin_amdgcn_mfma_f32_32x32x16_bf16(av8[ks], bI, aI, 0, 0, 0); }
#pragma unroll
                for (int r = 0; r < 16; ++r) { const int row = 32 * wave + crow16(r, hi);
                    const float xcv = __uint_as_float((unsigned)(*(const LAS unsigned short*)(XC + row * XRS + (32 * hf + r32) * 2)) << 16);
                    const float rg = sigmoidf_(aR[r] + brg[hf]), ig = sigmoidf_(aI[r] + big[hf]);
                    const float a_ = __builtin_amdgcn_exp2f(cdec[hf] * rg); const float mult = __builtin_amdgcn_sqrtf(fmaxf(1.0f - a_ * a_, 0.f));
                    av[hf][r] = a_; uv[hf][r] = mult * ig * xcv; }
                float AW = 1.f, BW = 0.f, gA[4], gB[4];
#pragma unroll
                for (int j = 0; j < 4; ++j) { float A = 1.f, B = 0.f;
#pragma unroll
                    for (int i = 0; i < 4; ++i) { B = av[hf][4 * j + i] * B + uv[hf][4 * j + i]; A *= av[hf][4 * j + i]; }
                    gA[j] = A; gB[j] = B; pA[hf][j] = __shfl_xor(A, 32); pB[hf][j] = __shfl_xor(B, 32); }
#pragma unroll
                for (int j = 0; j < 4; ++j) { const float fA = hi ? pA[hf][j] : gA[j], fB = hi ? pB[hf][j] : gB[j], sA = hi ? gA[j] : pA[hf][j], sB = hi ? gB[j] : pB[hf][j];
                    BW = fA * BW + fB; AW *= fA; BW = sA * BW + sB; AW *= sA; }
                if (hi == 0) { WS[(wave * 64 + 32 * hf + r32) * 2] = AW; WS[(wave * 64 + 32 * hf + r32) * 2 + 1] = BW; }
            }
            __syncthreads();
#pragma unroll
            for (int hf = 0; hf < 2; ++hf) {
                float h = hc[hf], hin = hc[hf], Ar = Arun[hf];
#pragma unroll
                for (int w = 0; w < 8; ++w) { const float A = WS[(w * 64 + 32 * hf + r32) * 2], B = WS[(w * 64 + 32 * hf + r32) * 2 + 1]; h = A * h + B; Ar *= A; if (w + 1 == wave) hin = h; }
                hc[hf] = h; Arun[hf] = Ar;
                if (FINAL) {
                    h = hin;
#pragma unroll
                    for (int j = 0; j < 4; ++j) { float hh = hi ? pA[hf][j] * h + pB[hf][j] : h;
#pragma unroll
                        for (int i = 0; i < 4; ++i) { hh = av[hf][4 * j + i] * hh + uv[hf][4 * j + i]; uv[hf][4 * j + i] = hh; }
                        h = hi ? hh : pA[hf][j] * hh + pB[hf][j]; }
#pragma unroll
                    for (int r = 0; r < 16; ++r) { LAS unsigned short* g = (LAS unsigned short*)(GRw + crow16(r, hi) * XRS + (32 * hf + r32) * 2);
                        *g = (unsigned short)f2bf(uv[hf][r] * __uint_as_float((unsigned)(*g) << 16)); }
                }
            }
            if (FINAL) {
#pragma unroll
                for (int i = 0; i < 4; ++i) { const int row = (lane >> 3) + 8 * i, pc = lane & 7; *(u32x4*)(gw_ + (size_t)row * 1024 + 8 * pc) = *(const LAS u32x4*)(GRw + row * XRS + pc * 16); } }
        }
        if (!FINAL && hi == 0) {
#pragma unroll
            for (int hf = 0; hf < 2; ++hf) { summ[(uu * 64 + 32 * hf + r32) * 2] = Arun[hf]; summ[(uu * 64 + 32 * hf + r32) * 2 + 1] = hc[hf]; } }
    }
}

__device__ __forceinline__ void p_expert_conv(const Ctx& F, const KA& a) {
    unsigned char* ws = a.ws();
    LAS float* scr = (LAS float*)(F.lds + RING_OFF + F.wave * 16384);
    constexpr int I_GU = (D / 64) * (FF / 32), I_DN = (FF / 64) * (D / 32);
    auto dec4 = [&](int it, TrDesc& d) { const int e = it / (2 * I_GU + I_DN); int r = it % (2 * I_GU + I_DN); d.kmul = 1.0f; d.ksc = nullptr; d.kmask = 0;
        if (r < I_GU) { d.W = a.in(24) + (size_t)e * D * FF; d.K = D; d.N = FF; d.WT = (bf16*)(ws + WS_WGU) + (size_t)e * 1024 * 1024; d.ksc = a.in(19); d.kmask = 1023; d.mode = 1; d.item = r; return; } r -= I_GU;
        if (r < I_GU) { d.W = a.in(25) + (size_t)e * D * FF; d.K = D; d.N = FF; d.WT = (bf16*)(ws + WS_WGU) + (size_t)e * 1024 * 1024; d.ksc = a.in(19); d.kmask = 1023; d.mode = 2; d.item = r; return; } r -= I_GU;
        d.W = a.in(26) + (size_t)e * FF * D; d.K = FF; d.N = D; d.WT = (bf16*)(ws + WS_WD) + (size_t)e * 1024 * 512; d.mode = 0; d.item = r; };
    { constexpr int NIT = NEXP * (2 * I_GU + I_DN); int it = F.gw; TrDesc dc, dn; TrRegs rc, rn;
      if (it < NIT) { dec4(it, dc); tr_load(dc, rc, F.lane); }
      while (it < NIT) { const int itn = it + F.NGW; if (itn < NIT) { dec4(itn, dn); tr_load(dn, rn, F.lane); }
          tr_finish(dc, rc, scr, F.lane); dc = dn; rc = rn; it = itn; } }
}

__device__ __forceinline__ void p7_router(const Ctx& F, const KA& a) {
    unsigned char* ws = a.ws();
    const float* x1 = a.out(); const float* Wr = (const float*)(ws + WS_WR);
    LAS float* WL = (LAS float*)F.lds;
    for (int i = F.tid; i < 36 * 256; i += NWAVES * 64) ((LAS f32x4*)WL)[i] = ((const f32x4*)Wr)[i];
    __syncthreads();
    int* list = (int*)(ws + WS_LIST); unsigned* cnt = (unsigned*)(ws + WS_CTL) + CW_CNT; i32x4* tokinfo = (i32x4*)(ws + WS_TOKINFO);
    const float* bg = a.in(21); const float* bfe = a.in(23);
    for (int m0 = F.gw; m0 < M; m0 += 2 * F.NGW) {
        f32x4 v[2][4]; float s[2], gl[2][4], fl[2][8]; int gi[2];
#pragma unroll
        for (int r = 0; r < 2; ++r) { const int m = (m0 + r * F.NGW < M) ? m0 + r * F.NGW : m0; const GAS f32x4* xr = (const GAS f32x4*)(x1 + (size_t)m * D) + F.lane;
#pragma unroll
            for (int j = 0; j < 4; ++j) v[r][j] = xr[64 * j]; }
#pragma unroll
        for (int r = 0; r < 2; ++r) { s[r] = 0.f;
#pragma unroll
            for (int j = 0; j < 4; ++j) s[r] += (v[r][j].x * v[r][j].x + v[r][j].y * v[r][j].y) + (v[r][j].z * v[r][j].z + v[r][j].w * v[r][j].w); }
#pragma unroll
        for (int g = 0; g < 4; ++g) { gl[0][g] = 0.f; gl[1][g] = 0.f;
#pragma unroll
            for (int j = 0; j < 4; ++j) { const f32x4 w = *(const LAS f32x4*)(WL + (32 + g) * 1024 + 4 * F.lane + 256 * j);
#pragma unroll
                for (int r = 0; r < 2; ++r) gl[r][g] += (v[r][j].x * w.x + v[r][j].y * w.y) + (v[r][j].z * w.z + v[r][j].w * w.w); } }
#pragma unroll
        for (int o = 1; o < 64; o <<= 1) {
#pragma unroll
            for (int r = 0; r < 2; ++r) { s[r] += __shfl_xor(s[r], o);
#pragma unroll
                for (int g = 0; g < 4; ++g) gl[r][g] += __shfl_xor(gl[r][g], o); } }
        float rstd[2], gwt[2];
#pragma unroll
        for (int r = 0; r < 2; ++r) { rstd[r] = 1.0f / sqrtf(s[r] * (1.0f / D) + 1e-6f);
#pragma unroll
            for (int g = 0; g < 4; ++g) gl[r][g] = gl[r][g] * rstd[r] + bg[g];
            int gg = 0; float gmax = gl[r][0];
#pragma unroll
            for (int g = 1; g < 4; ++g) if (gl[r][g] > gmax) { gmax = gl[r][g]; gg = g; }
            float gs = 0.f;
#pragma unroll
            for (int g = 0; g < 4; ++g) gs += expf(gl[r][g] - gmax);
            gwt[r] = 1.0f / gs; gi[r] = __builtin_amdgcn_readfirstlane(gg); }
#pragma unroll
        for (int r = 0; r < 2; ++r)
#pragma unroll
            for (int e = 0; e < 8; ++e) { float d = 0.f;
#pragma unroll
                for (int j = 0; j < 4; ++j) { const f32x4 w = *(const LAS f32x4*)(WL + (gi[r] * 8 + e) * 1024 + 4 * F.lane + 256 * j); d += (v[r][j].x * w.x + v[r][j].y * w.y) + (v[r][j].z * w.z + v[r][j].w * w.w); }
                fl[r][e] = d; }
#pragma unroll
        for (int o = 1; o < 64; o <<= 1) {
#pragma unroll
            for (int r = 0; r < 2; ++r)
#pragma unroll
                for (int e = 0; e < 8; ++e) fl[r][e] += __shfl_xor(fl[r][e], o); }
#pragma unroll
        for (int r = 0; r < 2; ++r) { const int m = m0 + r * F.NGW; if (m < M) {
#pragma unroll
            for (int e = 0; e < 8; ++e) fl[r][e] = fl[r][e] * rstd[r] + bfe[gi[r] * 8 + e];
            int i0 = 0; float l0 = fl[r][0];
#pragma unroll
            for (int e = 1; e < 8; ++e) if (fl[r][e] > l0) { l0 = fl[r][e]; i0 = e; }
            int i1 = -1; float l1 = -INFINITY;
#pragma unroll
            for (int e = 0; e < 8; ++e) if (e != i0 && fl[r][e] > l1) { l1 = fl[r][e]; i1 = e; }
            const float ex = expf(l1 - l0), w0 = 1.0f / (1.0f + ex), w1 = ex * w0;
            if (F.lane == 0) { const int e0 = gi[r] * 8 + i0, e1 = gi[r] * 8 + i1;
                const int p0 = (int)atomicAdd(cnt + e0, 1u), p1 = (int)atomicAdd(cnt + e1, 1u);
                list[(size_t)e0 * CAP + p0] = m; list[(size_t)e1 * CAP + p1] = m;
                tokinfo[m * 2] = (i32x4){e0, e1, p0, p1}; tokinfo[m * 2 + 1] = (i32x4){__float_as_int(gwt[r] * w0), __float_as_int(gwt[r] * w1), __float_as_int(rstd[r]), 0}; } } }
    }
}

__device__ __forceinline__ void moe_tables(const Ctx& F, const unsigned* cnt) {
    LAS int* tp = (LAS int*)(F.lds + CTLL_OFF + 64); LAS int* cn = (LAS int*)(F.lds + CTLL_OFF + 256);
    if (F.tid == 0) { int acc = 0; for (int e = 0; e < NEXP; ++e) { const int c = (int)__hip_atomic_load(cnt + e, RLX_AGENT); cn[e] = c; tp[e] = acc; acc += (c + 255) >> 8; } tp[NEXP] = acc; }
    __syncthreads();
}

__device__ __forceinline__ void p10_combine(const Ctx& F, const KA& a) {
    unsigned char* ws = a.ws();
    const LAS int* tp = (const LAS int*)(F.lds + CTLL_OFF + 64);
    const i32x4* tokinfo = (const i32x4*)(ws + WS_TOKINFO); const bf16* Y = (const bf16*)(ws + WS_Y); bf16* x2b = (bf16*)(ws + WS_U0); float* rstd2 = (float*)(ws + WS_RSTD2);
    for (int m0 = F.gw; m0 < M; m0 += 4 * F.NGW) {
        i32x4 t0[4]; f32x4 v[4][4]; u32x2 py[4][4], qy[4][4]; float s[4];
#pragma unroll
        for (int r = 0; r < 4; ++r) { const int m = m0 + r * F.NGW; if (m < M) t0[r] = tokinfo[m * 2]; }
#pragma unroll
        for (int r = 0; r < 4; ++r) { const int m = m0 + r * F.NGW; if (m < M) {
            const int s0 = tp[t0[r].x] * 256 + t0[r].z, s1 = tp[t0[r].y] * 256 + t0[r].w;
            const GAS f32x4* xr = (const GAS f32x4*)(a.out() + (size_t)m * D) + F.lane; const u32x2* y0 = (const u32x2*)(Y + (size_t)s0 * D) + F.lane; const u32x2* y1 = (const u32x2*)(Y + (size_t)s1 * D) + F.lane;
#pragma unroll
            for (int j = 0; j < 4; ++j) { v[r][j] = xr[64 * j]; py[r][j] = y0[64 * j]; qy[r][j] = y1[64 * j]; } } }
#pragma unroll
        for (int r = 0; r < 4; ++r) { s[r] = 0.f;
#pragma unroll
            for (int j = 0; j < 4; ++j) { const u32x2 p = py[r][j], q = qy[r][j];
                v[r][j].x += bflo(p.x) + bflo(q.x); v[r][j].y += bfhi(p.x) + bfhi(q.x); v[r][j].z += bflo(p.y) + bflo(q.y); v[r][j].w += bfhi(p.y) + bfhi(q.y);
                s[r] += (v[r][j].x * v[r][j].x + v[r][j].y * v[r][j].y) + (v[r][j].z * v[r][j].z + v[r][j].w * v[r][j].w); } }
#pragma unroll
        for (int o = 1; o < 64; o <<= 1) {
#pragma unroll
            for (int r = 0; r < 4; ++r) s[r] += __shfl_xor(s[r], o); }
#pragma unroll
        for (int r = 0; r < 4; ++r) { const int m = m0 + r * F.NGW; if (m < M) { if (F.lane == 0) rstd2[m] = 1.0f / sqrtf(s[r] * (1.0f / D) + 1e-6f);
            GAS f32x4* xr = (GAS f32x4*)(a.out() + (size_t)m * D) + F.lane; GAS u32x2* o8 = (GAS u32x2*)(x2b + (size_t)m * D) + F.lane;
#pragma unroll
            for (int j = 0; j < 4; ++j) { xr[64 * j] = v[r][j]; o8[64 * j] = (u32x2){pk2(v[r][j].x, v[r][j].y), pk2(v[r][j].z, v[r][j].w)}; } } }
    }
}

__device__ __forceinline__ void p12_final(const Ctx& F, const KA& a) {
    const f32x4* g4 = (const f32x4*)a.in(30);
    f32x4 g[4];
#pragma unroll
    for (int j = 0; j < 4; ++j) g[j] = g4[F.lane + 64 * j];
    for (int m0 = F.gw; m0 < M; m0 += 4 * F.NGW) { f32x4 v[4][4]; float s[4];
#pragma unroll
        for (int r = 0; r < 4; ++r) { const int m = m0 + r * F.NGW; if (m < M) { const GAS f32x4* xr = (const GAS f32x4*)(a.out() + (size_t)m * D) + F.lane;
#pragma unroll
            for (int j = 0; j < 4; ++j) v[r][j] = xr[64 * j]; } }
#pragma unroll
        for (int r = 0; r < 4; ++r) { s[r] = 0.f;
#pragma unroll
            for (int j = 0; j < 4; ++j) s[r] += (v[r][j].x * v[r][j].x + v[r][j].y * v[r][j].y) + (v[r][j].z * v[r][j].z + v[r][j].w * v[r][j].w); }
#pragma unroll
        for (int o = 1; o < 64; o <<= 1) {
#pragma unroll
            for (int r = 0; r < 4; ++r) s[r] += __shfl_xor(s[r], o); }
#pragma unroll
        for (int r = 0; r < 4; ++r) { const int m = m0 + r * F.NGW; if (m < M) { const float rs = 1.0f / sqrtf(s[r] * (1.0f / D) + 1e-6f); GAS f32x4* xr = (GAS f32x4*)(a.out() + (size_t)m * D) + F.lane;
#pragma unroll
            for (int j = 0; j < 4; ++j) xr[64 * j] = v[r][j] * rs * g[j]; } }
    }
}

#ifndef MK_N_LAUNCHES
#define MK_N_LAUNCHES 1
#endif
constexpr int NPH = 13;
constexpr int N_LAUNCHES = MK_N_LAUNCHES;

__global__ void __launch_bounds__(NWAVES * 64, 2) mega_fwd(Args args) {
    extern __shared__ __attribute__((aligned(16))) unsigned char lds[];
#define MKCTX() Ctx F; F.lds = (LAS unsigned char*)lds; F.tid = threadIdx.x; F.lane = lane_id_v(); F.wave = __builtin_amdgcn_readfirstlane(F.tid >> 6); \
    F.G = gridDim.x; { const int bx = blockIdx.x; F.vcu = (F.G % 8 == 0) ? (bx % 8) * (F.G / 8) + bx / 8 : bx; } F.gw = F.vcu * NWAVES + F.wave; F.NGW = F.G * NWAVES
    const KA ka0 = ka_get();
    unsigned char* ws = ka0.ws();
    gu32* ctl = (gu32*)(ws + WS_CTL);
    for (int u = threadIdx.x; u < (LDS_BYTES - CTLL_OFF) / 4; u += NWAVES * 64) ((LAS unsigned*)((LAS unsigned char*)lds + CTLL_OFF))[u] = 0u;
    __syncthreads();
    XcdBarrier bar = xcd_barrier_post((unsigned*)ctl + CW_BAR, (volatile LAS unsigned*)((LAS unsigned char*)lds + CTLL_OFF));
#define GRID_BAR() xcd_barrier(bar)
    bf16* U0 = (bf16*)(ws + WS_U0);

    { MKCTX(); p0_prologue(F, ka_get()); }
    GRID_BAR();

    {   pg8::DenseOrder S; S.init(ws + WS_U0, ws + WS_WIN, M, NIN, D, gridDim.x, (int)blockIdx.x);
        pg8::EpiIn E{(bf16*)(ws + WS_U0 + 1 * USZ), (const float*)(ws + WS_RSTD0)};
        pg8::gemm_phase<D, pg8::EpiIn, pg8::DenseOrder, false, true>((LAS unsigned char*)lds + RING_OFF, S, E); }
    GRID_BAR();

    { MKCTX(); const KA ka = ka_get();
      lru_pass<false>(F, (const bf16*)(ws + WS_U0 + 4 * USZ), (bf16*)(ws + WS_U0 + 5 * USZ), (float*)(ws + WS_SUMM), (const bf16*)(ws + WS_WLRU), ka.in(9), ka.in(10), ka.in(12), ka.in(14), ka.in(15)); }
    GRID_BAR();

    { MKCTX(); const KA ka = ka_get();
      lru_pass<true>(F, (const bf16*)(ws + WS_U0 + 4 * USZ), (bf16*)(ws + WS_U0 + 5 * USZ), (float*)(ws + WS_SUMM), (const bf16*)(ws + WS_WLRU), ka.in(9), ka.in(10), ka.in(12), ka.in(14), ka.in(15)); }
    __syncthreads();
    {   const bf16* Q = (const bf16*)(ws + WS_U0 + 1 * USZ); const char* Kb = (const char*)(ws + WS_U0 + 2 * USZ); const char* Vb = (const char*)(ws + WS_U0 + 3 * USZ);
        float lam;
        { const KA ka = ka_get(); const int ln = lane_id_v(); const float s1 = wave_sum(ka.in(4)[ln] * ka.in(5)[ln]), s2 = wave_sum(ka.in(6)[ln] * ka.in(7)[ln]); lam = expf(s1) - expf(s2) + LAM_INIT; }
        const int G = gridDim.x, bx = blockIdx.x, vcu = (G % 8 == 0) ? (bx % 8) * (G / 8) + bx / 8 : bx;
        for (int k = vcu; k < 512; k += G) {
            const int v = k & 255, j = k >> 8, xc = v >> 5, jc = v & 31, bh = 2 * xc + j, qb = j ? 31 - jc : jc;
            const int b = bh >> 3, h = bh & 7;
            const bf16* Vp = (const bf16*)(Vb + (size_t)(bh * 128) * 16384);
            attn3::unit<8, false>((long)b * SEQ, qb, Q + 128 * h, (const bf16*)(Kb + (size_t)((bh * 2 + 0) * 128) * 8192), Vp, U0 + 128 * h, lam, (LAS unsigned char*)lds);
            attn3::unit<8, true>((long)b * SEQ, qb, Q + 128 * h + 64, (const bf16*)(Kb + (size_t)((bh * 2 + 1) * 128) * 8192), Vp, U0 + 128 * h, lam, (LAS unsigned char*)lds);
        } }
    GRID_BAR();

    {   bf16* mixed = (bf16*)(ws + WS_U0 + 4 * USZ);
        { pg8::DenseOrder S; S.init(ws + WS_U0, ws + WS_WA, M, D, D, gridDim.x, (int)blockIdx.x);
          pg8::EpiMix<true> E{mixed, (const bf16*)(ws + WS_U0 + 6 * USZ)};
          pg8::gemm_phase<D, pg8::EpiMix<true>, pg8::DenseOrder, false, false>((LAS unsigned char*)lds + RING_OFF, S, E); }
        { pg8::DenseOrder S; S.init(ws + WS_U0 + 5 * USZ, ws + WS_WL, M, D, D, gridDim.x, (int)blockIdx.x);
          pg8::EpiMix<false> E{mixed, (const bf16*)(ws + WS_U0 + 7 * USZ)};
          pg8::gemm_phase<D, pg8::EpiMix<false>, pg8::DenseOrder, false, false>((LAS unsigned char*)lds + RING_OFF, S, E); } }
    GRID_BAR();

    {   pg8::DenseOrder S; S.init(ws + WS_U0 + 4 * USZ, ws + WS_WO, M, D, D, gridDim.x, (int)blockIdx.x);
        const KA ka = ka_get(); pg8::EpiOut E{ka.in(0), ka.out(), U0};
        pg8::gemm_phase<D, pg8::EpiOut, pg8::DenseOrder, false, false>((LAS unsigned char*)lds + RING_OFF, S, E); }
    GRID_BAR();

    { MKCTX(); p7_router(F, ka_get()); __syncthreads(); p_expert_conv(F, ka_get()); }
    GRID_BAR();

    {   MKCTX(); moe_tables(F, (const unsigned*)ctl + CW_CNT);
        pg8::MoeOrder<true> S{(const char*)U0, (const char*)(ws + WS_WGU), (size_t)1024 * 1024 * 2, D, F.G, F.vcu, (const LAS int*)(F.lds + CTLL_OFF + 64), (const LAS int*)(F.lds + CTLL_OFF + 256), (const int*)(ws + WS_LIST)};
        pg8::EpiGU E{(bf16*)(ws + WS_HID), (const int*)(ws + WS_LIST), (const i32x4*)(ws + WS_TOKINFO)};
        pg8::gemm_phase<D, pg8::EpiGU, pg8::MoeOrder<true>, true, false>(F.lds + RING_OFF, S, E); }
    GRID_BAR();

    {   MKCTX(); moe_tables(F, (const unsigned*)ctl + CW_CNT);
        pg8::MoeOrder<false> S{(const char*)(ws + WS_HID), (const char*)(ws + WS_WD), (size_t)1024 * 512 * 2, FF, F.G, F.vcu, (const LAS int*)(F.lds + CTLL_OFF + 64), (const LAS int*)(F.lds + CTLL_OFF + 256), (const int*)(ws + WS_LIST)};
        pg8::EpiBf E{(bf16*)(ws + WS_Y), D};
        pg8::gemm_phase<FF, pg8::EpiBf, pg8::MoeOrder<false>, false, false>(F.lds + RING_OFF, S, E); }
    GRID_BAR();

    { MKCTX(); moe_tables(F, (const unsigned*)ctl + CW_CNT); p10_combine(F, ka_get()); }
    GRID_BAR();

    {   { pg8::DenseOrder S; S.init(ws + WS_PB, ws + WS_WPP, M, D, PLE, gridDim.x, (int)blockIdx.x);
          pg8::EpiBf E{(bf16*)(ws + WS_PROJ), D};
          pg8::gemm_phase<PLE, pg8::EpiBf, pg8::DenseOrder, false, false>((LAS unsigned char*)lds + RING_OFF, S, E); }
        { pg8::DenseOrder S; S.init(ws + WS_U0, ws + WS_WPG, M, D, D, gridDim.x, (int)blockIdx.x);
          const KA ka = ka_get(); pg8::EpiPle E{ka.out(), (const bf16*)(ws + WS_PROJ), (const float*)(ws + WS_RSTD2)};
          pg8::gemm_phase<D, pg8::EpiPle, pg8::DenseOrder, false, false>((LAS unsigned char*)lds + RING_OFF, S, E); } }
    GRID_BAR();

    { MKCTX(); p12_final(F, ka_get()); }
}

extern "C" void kernel_launch(void* const* d_in, const int* in_sizes, int n_in, void* d_out, int out_size, void* d_ws, size_t ws_size, hipStream_t stream) {
    static int grid = 0;
    if (grid == 0) {
        if (n_in != 31 || in_sizes[0] != M * D || out_size != M * D || ws_size < WS_END) { fprintf(stderr, "kernel_launch: unexpected shapes (n_in %d, in0 %d, out %d, ws %zu < %zu); nothing launched\n", n_in, n_in > 0 ? in_sizes[0] : -1, out_size, ws_size, (size_t)WS_END); grid = -1; return; }
        int dev = 0, cus = 0, per_cu = 0;
        if (hipGetDevice(&dev) != hipSuccess || hipDeviceGetAttribute(&cus, hipDeviceAttributeMultiprocessorCount, dev) != hipSuccess) { grid = -1; return; }
        if (hipFuncSetAttribute((const void*)mega_fwd, hipFuncAttributeMaxDynamicSharedMemorySize, LDS_BYTES) != hipSuccess) { fprintf(stderr, "kernel_launch: hipFuncSetAttribute failed\n"); grid = -1; return; }
        if (hipOccupancyMaxActiveBlocksPerMultiprocessor(&per_cu, (const void*)mega_fwd, NWAVES * 64, LDS_BYTES) != hipSuccess || per_cu < 1)
            fprintf(stderr, "kernel_launch: note: occupancy query reports %d workgroups per CU\n", per_cu);
        (void)hipGetLastError();
        grid = cus;
    }
    if (grid < 0) return;
    if (hipMemsetAsync((char*)d_ws + WS_CTL, 0, CTL_ZERO_BYTES, stream) != hipSuccess) return;
    Args a{};
    for (int i = 0; i < 31; ++i) a.in[i] = (const float*)d_in[i];
    a.out = (float*)d_out; a.ws = (unsigned char*)d_ws;
    a.ph_lo = 0; a.ph_hi = 0;
    hipLaunchKernelGGL(mega_fwd, dim3(grid), dim3(NWAVES * 64), LDS_BYTES, stream, a);
    const hipError_t le = hipPeekAtLastError();
    if (le != hipSuccess) fprintf(stderr, "kernel_launch: launch failed: %s\n", hipGetErrorName(le));
}
```
